# Optimizing an MI355X kernel written in HIP

```python
import math
import jax, jax.numpy as jnp
from jax import lax
import numpy as np

D_MODEL = 1024
BATCH = 4
SEQ = 8192
DEPTH = 1

HEAD_DIM = 64
N_ATTN_HEADS = 8
N_KV_HEADS = 2
GQA_RATIO = N_ATTN_HEADS // N_KV_HEADS
ATTN_WIDTH = N_ATTN_HEADS * HEAD_DIM
KV_WIDTH = N_KV_HEADS * HEAD_DIM
CONV_GROUPS = 8
CONV_WIDTH = D_MODEL - ATTN_WIDTH
CONV_K = 3
CMP_BLOCK = 32
CMP_STRIDE = 16
CMP_HIDDEN = 256
SEL_BLOCK = 64
N_SELECT = 16
WINDOW = 512
Q_BLOCK = 64
SEL_FORCE = 1.0e6
REL_BUCKETS = 32
REL_MAX_DIST = 1024
D_FF = 4 * D_MODEL
N_MOD = 6
EPS = 1e-6
NEG = -1e30
IN_SIZES = [ATTN_WIDTH] + [KV_WIDTH] * 6 + [3 * N_ATTN_HEADS] + [CONV_WIDTH] * 3
IN_COLS = sum(IN_SIZES)
IN_OFFSETS = [int(v) for v in np.cumsum(IN_SIZES)[:-1]]

kernel_name = "hymba_nsa_shortconv_adaln_layer"


def rms_norm(x, g):
    x32 = x.astype(jnp.float32)
    y = x32 * lax.rsqrt(jnp.mean(x32 * x32, axis=-1, keepdims=True) + EPS)
    return (y * g.astype(jnp.float32)).astype(x.dtype)


def rel_bucket(dist):
    n = jnp.maximum(dist, 0)
    max_exact = REL_BUCKETS // 2
    nf = jnp.maximum(n, max_exact).astype(jnp.float32)
    large = max_exact + (jnp.log(nf / max_exact) / math.log(REL_MAX_DIST / max_exact)
                         * (REL_BUCKETS - max_exact)).astype(jnp.int32)
    large = jnp.minimum(large, REL_BUCKETS - 1)
    return jnp.where(n < max_exact, n, large)


def masked_softmax(s, mask):
    s = jnp.where(mask, s.astype(jnp.float32), NEG)
    s = s - jnp.max(s, axis=-1, keepdims=True)
    e = jnp.exp(s) * mask
    den = jnp.sum(e, axis=-1, keepdims=True)
    return e / jnp.where(den > 0, den, 1.0)


def compress(blocks, pe, w1, w2):
    b, n = blocks.shape[:2]
    h = blocks + pe[None, None, :, None, :]
    h = jnp.moveaxis(h, 3, 2).reshape(b, n, N_KV_HEADS, CMP_BLOCK * HEAD_DIM)
    return jax.nn.gelu(h @ w1) @ w2


def nsa_attention(q, kc, vc, ks, vs, kw, vw, gates, rel_bias):
    b, t = q.shape[:2]
    G, R = N_KV_HEADS, GQA_RATIO
    n_cmp = kc.shape[1]
    n_sb = t // SEL_BLOCK
    top_n = min(N_SELECT, n_sb)
    span_w = WINDOW + Q_BLOCK
    scale = HEAD_DIM ** -0.5
    cmp_end = jnp.arange(n_cmp) * CMP_STRIDE + CMP_BLOCK - 1
    c_start = np.arange(n_cmp)[:, None] * CMP_STRIDE
    s_start = np.arange(n_sb)[None, :] * SEL_BLOCK
    ov = np.clip(np.minimum(c_start + CMP_BLOCK, s_start + SEL_BLOCK) - np.maximum(c_start, s_start), 0, None)
    overlap = jnp.asarray(ov / CMP_BLOCK, dtype=jnp.float32)
    ks_blocks = ks.reshape(b, n_sb, SEL_BLOCK, G, HEAD_DIM).transpose(0, 3, 1, 2, 4)
    vs_blocks = vs.reshape(b, n_sb, SEL_BLOCK, G, HEAD_DIM).transpose(0, 3, 1, 2, 4)
    kw_pad = jnp.pad(kw, ((0, 0), (WINDOW, 0), (0, 0), (0, 0)))
    vw_pad = jnp.pad(vw, ((0, 0), (WINDOW, 0), (0, 0), (0, 0)))
    bias_gr = rel_bias.reshape(REL_BUCKETS, G, R)
    bi = jnp.arange(b)[:, None, None, None]
    gi = jnp.arange(G)[None, :, None, None]
    gi5 = jnp.arange(G)[None, :, None, None, None]
    jb = jnp.arange(n_sb)

    def block_fn(ci):
        t0 = ci * Q_BLOCK
        tpos = t0 + jnp.arange(Q_BLOCK)
        qc = lax.dynamic_slice_in_dim(q, t0, Q_BLOCK, 1).reshape(b, Q_BLOCK, G, R, HEAD_DIM)
        gc = lax.dynamic_slice_in_dim(gates, t0, Q_BLOCK, 1).reshape(b, Q_BLOCK, G, R, 3)
        dist_c = tpos[:, None] - cmp_end[None, :]
        bias_c = rel_bias[rel_bucket(dist_c)].reshape(Q_BLOCK, n_cmp, G, R).transpose(2, 3, 0, 1)
        s_c = jnp.einsum('bqgrd,bngd->bgrqn', qc, kc).astype(jnp.float32) * scale + bias_c
        p_c = masked_softmax(s_c, dist_c >= 0)
        o_c = jnp.einsum('bgrqn,bngd->bqgrd', p_c.astype(vc.dtype), vc)
        imp = jnp.einsum('bgrqn,nj->bgqj', p_c, overlap)
        cur = tpos // SEL_BLOCK
        valid = jb[None, :] <= cur[:, None]
        forced = (jb[None, :] == 0) | (jb[None, :] == cur[:, None]) | (jb[None, :] == cur[:, None] - 1)
        score = jnp.where(valid, jnp.where(forced, SEL_FORCE, imp), -1.0)
        _, idx = lax.top_k(score, top_n)
        ks_sel = ks_blocks[bi, gi, idx]
        vs_sel = vs_blocks[bi, gi, idx]
        kpos = idx[..., None] * SEL_BLOCK + jnp.arange(SEL_BLOCK)
        dist_s = tpos[:, None, None] - kpos
        bias_s = jnp.moveaxis(bias_gr[rel_bucket(dist_s), gi5], -1, 2)
        s_s = jnp.einsum('bqgrd,bgqnld->bgrqnl', qc, ks_sel).astype(jnp.float32) * scale + bias_s
        p_s = masked_softmax(s_s.reshape(b, G, R, Q_BLOCK, top_n * SEL_BLOCK),
                             (dist_s >= 0).reshape(b, G, 1, Q_BLOCK, top_n * SEL_BLOCK))
        o_s = jnp.einsum('bgrqnl,bgqnld->bqgrd', p_s.reshape(s_s.shape).astype(vs.dtype), vs_sel)
        kwc = lax.dynamic_slice_in_dim(kw_pad, t0, span_w, 1)
        vwc = lax.dynamic_slice_in_dim(vw_pad, t0, span_w, 1)
        kpos_w = t0 - WINDOW + jnp.arange(span_w)
        dist_w = tpos[:, None] - kpos_w[None, :]
        mask_w = (dist_w >= 0) & (dist_w < WINDOW) & (kpos_w >= 0)[None, :]
        bias_w = rel_bias[rel_bucket(dist_w)].reshape(Q_BLOCK, span_w, G, R).transpose(2, 3, 0, 1)
        s_w = jnp.einsum('bqgrd,bsgd->bgrqs', qc, kwc).astype(jnp.float32) * scale + bias_w
        p_w = masked_softmax(s_w, mask_w)
        o_w = jnp.einsum('bgrqs,bsgd->bqgrd', p_w.astype(vw.dtype), vwc)
        o = gc[..., 0:1] * o_c + gc[..., 1:2] * o_s + gc[..., 2:3] * o_w
        return o.reshape(b, Q_BLOCK, ATTN_WIDTH)

    out = lax.map(block_fn, jnp.arange(t // Q_BLOCK))
    return out.transpose(1, 0, 2, 3).reshape(b, t, ATTN_WIDTH)


def hybrid_layer(x, c, w_in, q_norm, k_norm, cmp_pe_k, cmp_w1_k, cmp_w2_k, cmp_pe_v, cmp_w1_v, cmp_w2_v,
                 rel_bias, conv_w, w_out, norm1, norm2, w_ada, b_ada, w_ff1, w_ff2):
    b, t, d = x.shape
    G = N_KV_HEADS
    mod = (jax.nn.silu(c) @ w_ada + b_ada).reshape(b, N_MOD, 1, d)
    shift1, scale1, gate1, shift2, scale2, gate2 = (mod[:, i] for i in range(N_MOD))
    h = rms_norm(x, norm1) * (1 + scale1) + shift1
    proj = h @ w_in
    q, kc_raw, vc_raw, ks, vs, kw, vw, g, cgate, bgate, u = jnp.split(proj, IN_OFFSETS, axis=-1)
    q = rms_norm(q.reshape(b, t, N_ATTN_HEADS, HEAD_DIM), q_norm)
    ks = rms_norm(ks.reshape(b, t, G, HEAD_DIM), k_norm)
    kw = rms_norm(kw.reshape(b, t, G, HEAD_DIM), k_norm)
    vs = vs.reshape(b, t, G, HEAD_DIM)
    vw = vw.reshape(b, t, G, HEAD_DIM)
    n_cmp = (t - CMP_BLOCK) // CMP_STRIDE + 1
    cidx = (jnp.arange(n_cmp) * CMP_STRIDE)[:, None] + jnp.arange(CMP_BLOCK)[None, :]
    kc_blocks = kc_raw.reshape(b, t, G, HEAD_DIM)[:, cidx]
    vc_blocks = vc_raw.reshape(b, t, G, HEAD_DIM)[:, cidx]
    kc = rms_norm(compress(kc_blocks, cmp_pe_k, cmp_w1_k, cmp_w2_k), k_norm)
    vc = compress(vc_blocks, cmp_pe_v, cmp_w1_v, cmp_w2_v)
    gates = jax.nn.sigmoid(g).reshape(b, t, N_ATTN_HEADS, 3)
    attn_out = nsa_attention(q, kc, vc, ks, vs, kw, vw, gates, rel_bias)
    z = cgate * u
    zc = lax.conv_general_dilated(z, conv_w.reshape(CONV_K, 1, CONV_WIDTH).astype(z.dtype),
                                  window_strides=(1,), padding=[(CONV_K - 1, 0)],
                                  dimension_numbers=('NWC', 'WIO', 'NWC'),
                                  feature_group_count=CONV_WIDTH)
    conv_out = bgate * zc
    mix = jnp.concatenate([attn_out, conv_out], axis=-1) @ w_out
    x = x + gate1 * mix
    h2 = rms_norm(x, norm2) * (1 + scale2) + shift2
    ff = jnp.square(jax.nn.relu(h2 @ w_ff1)) @ w_ff2
    return x + gate2 * ff


def setup_inputs(seed: int = 0) -> dict:
    key = jax.random.key(seed)
    ks = jax.random.split(key, 24)
    L = DEPTH

    def nrm(k, shape, s):
        return jax.random.normal(k, shape, jnp.float32) * s

    return {
        "x": nrm(ks[0], (BATCH, SEQ, D_MODEL), 1.0),
        "c": nrm(ks[1], (BATCH, D_MODEL), 1.0),
        "w_in": nrm(ks[2], (L, D_MODEL, IN_COLS), D_MODEL ** -0.5),
        "q_norm": 1.0 + nrm(ks[3], (L, HEAD_DIM), 0.02),
        "k_norm": 1.0 + nrm(ks[4], (L, HEAD_DIM), 0.02),
        "cmp_pe_k": nrm(ks[5], (L, CMP_BLOCK, HEAD_DIM), 0.1),
        "cmp_w1_k": nrm(ks[6], (L, CMP_BLOCK * HEAD_DIM, CMP_HIDDEN), (CMP_BLOCK * HEAD_DIM) ** -0.5),
        "cmp_w2_k": nrm(ks[7], (L, CMP_HIDDEN, HEAD_DIM), CMP_HIDDEN ** -0.5),
        "cmp_pe_v": nrm(ks[8], (L, CMP_BLOCK, HEAD_DIM), 0.1),
        "cmp_w1_v": nrm(ks[9], (L, CMP_BLOCK * HEAD_DIM, CMP_HIDDEN), (CMP_BLOCK * HEAD_DIM) ** -0.5),
        "cmp_w2_v": nrm(ks[10], (L, CMP_HIDDEN, HEAD_DIM), CMP_HIDDEN ** -0.5),
        "rel_bias": nrm(ks[11], (REL_BUCKETS, N_ATTN_HEADS), 0.2),
        "conv_w": nrm(ks[12], (L, CONV_K, CONV_WIDTH), CONV_K ** -0.5),
        "w_out": nrm(ks[13], (L, D_MODEL, D_MODEL), D_MODEL ** -0.5),
        "norm1": 1.0 + nrm(ks[14], (L, D_MODEL), 0.02),
        "norm2": 1.0 + nrm(ks[15], (L, D_MODEL), 0.02),
        "w_ada": nrm(ks[16], (L, D_MODEL, N_MOD * D_MODEL), 0.5 * D_MODEL ** -0.5),
        "b_ada": nrm(ks[17], (L, N_MOD * D_MODEL), 0.02),
        "w_ff1": nrm(ks[18], (L, D_MODEL, D_FF), D_MODEL ** -0.5),
        "w_ff2": nrm(ks[19], (L, D_FF, D_MODEL), D_FF ** -0.5),
    }


def reference(x, c, w_in, q_norm, k_norm, cmp_pe_k, cmp_w1_k, cmp_w2_k, cmp_pe_v, cmp_w1_v, cmp_w2_v,
              rel_bias, conv_w, w_out, norm1, norm2, w_ada, b_ada, w_ff1, w_ff2):
    for l in range(DEPTH):
        x = hybrid_layer(x, c, w_in[l], q_norm[l], k_norm[l], cmp_pe_k[l], cmp_w1_k[l], cmp_w2_k[l],
                         cmp_pe_v[l], cmp_w1_v[l], cmp_w2_v[l], rel_bias, conv_w[l], w_out[l],
                         norm1[l], norm2[l], w_ada[l], b_ada[l], w_ff1[l], w_ff2[l])
    return x
```

```cpp
#include <hip/hip_runtime.h>
#include <hip/hip_bf16.h>
#include <cstdio>
#include <cstdint>
#include <cmath>
namespace pg8 {
#define PG8_LAS __attribute__((address_space(3)))
typedef unsigned short bf16_t;
typedef short bf16x8 __attribute__((ext_vector_type(8)));
typedef float f32x4 __attribute__((ext_vector_type(4)));
typedef unsigned u32x4 __attribute__((ext_vector_type(4)));
constexpr int BM = 256, BK = 64, HALF = 128, HTB = HALF * BK * 2  , STAGE_BYTES = 8 * HTB, NXCD = 8, WGM = 8;

__host__ __device__ __forceinline__ int lds_byte(int r, int c) { const int st = (r >> 4) * 2 + (c >> 5), rr = r & 15, cc = c & 31, ob = rr * 64 + cc * 2; return st * 1024 + (ob ^ (((ob >> 9) & 1) << 5)); }
__host__ __device__ __forceinline__ void stage_rc(int b, int& R, int& C) { const int st = b / 1024, sb = b % 1024, swz = sb ^ (((sb >> 9) & 1) << 5); R = (st >> 1) * 16 + swz / 64; C = (st & 1) * 32 + (swz % 64) / 2; }
__host__ __device__ __forceinline__ int perm32(int rho) { const int n = rho >> 4, i = rho & 15; return 8 * (i >> 2) + 4 * n + (i & 3); }

struct Unit { int pm, pn; };
struct Gemm { const bf16_t* A; const bf16_t* Bt; int M, N, K; };

struct StaticOrder {
    int nM, nN, nwg, G, c;
    __host__ __device__ void init(int M, int N, int G_, int c_) { nM = M / BM; nN = N / BM; nwg = nM * nN; G = G_; c = c_; }
    __host__ __device__ bool next(int i, Unit& u) const {
        const long L = (long)i * G + c; if (L >= nwg) return false;
        int wgid = (int)L; { const int q = nwg / NXCD, r = nwg % NXCD, xcd = wgid % NXCD, off = wgid / NXCD; wgid = (xcd < r ? xcd * (q + 1) : r * (q + 1) + (xcd - r) * q) + off; }
        const int nig = WGM * nN, gid = wgid / nig, fm = gid * WGM, gsz = (nM - fm) < WGM ? (nM - fm) : WGM;
        u.pm = fm + ((wgid % nig) % gsz); u.pn = (wgid % nig) / gsz; return true;
    }
    __device__ __forceinline__ void a_ready(const Unit&) const {}
    __device__ __forceinline__ void done(const Unit&) const {}
};

__device__ __forceinline__ unsigned cvt_pk_bf16(float lo, float hi) { unsigned r; asm volatile("v_cvt_pk_bf16_f32 %0, %1, %2" : "=v"(r) : "v"(lo), "v"(hi)); return r; }
typedef float f32x2 __attribute__((ext_vector_type(2)));
template <class Epi, class Sched, bool ALIGN_EPI = false, bool SP2 = false>
__device__ __forceinline__ void gemm_phase(PG8_LAS unsigned char* lds, const Gemm g, const Sched& S, const Epi& E) {
    const int tid = threadIdx.x, wid = __builtin_amdgcn_readfirstlane(tid >> 6), lane = tid & 63, wr = wid >> 2, wc = wid & 3, fr = lane & 15, fq = lane >> 4;
    const int K = g.K, nt = K / BK;
    unsigned voffA[2], voffB[2];
#pragma unroll
    for (int i = 0; i < 2; ++i) { int R, C; stage_rc(tid * 16 + i * 8192, R, C); const int Rb = Epi::PERM ? ((R & ~31) + perm32(R & 31)) : R;
        voffA[i] = (unsigned)(R * K + C) * 2u; voffB[i] = (unsigned)(Rb * K + C) * 2u; }
    const size_t kstep = (size_t)(BK * 2);
    const size_t hstep = (size_t)HALF * K * 2;
    const size_t tstep = 2 * hstep;
    const unsigned ldsw = (unsigned)wid * 1024u;
    const int aoff = lds_byte(wr * 64 + fr, fq * 8), boff = lds_byte(wc * 32 + fr, fq * 8);
#define PG8_SA(b, h) (((b) * 2 + (h)) * HTB)
#define PG8_SB(b, h) ((4 + (b) * 2 + (h)) * HTB)
#define PG8_STAGE(bufoff, gbase, voff) do { _Pragma("unroll") for (int _i = 0; _i < 2; ++_i) \
        __builtin_amdgcn_global_load_lds((const unsigned*)((const char*)(gbase) + (voff)[_i]), (PG8_LAS unsigned*)(lds + (bufoff) + ldsw + _i * 8192), 16, 0, 0); } while (0)
#define PG8_LDA(dst, b, h) do { _Pragma("unroll") for (int m = 0; m < 4; ++m) _Pragma("unroll") for (int k = 0; k < 2; ++k) dst[m][k] = *(const PG8_LAS bf16x8*)(lds + PG8_SA(b, h) + aoff + m * 2048 + k * 1024); } while (0)
#define PG8_LDB(dst, b, h) do { _Pragma("unroll") for (int n = 0; n < 2; ++n) _Pragma("unroll") for (int k = 0; k < 2; ++k) dst[n][k] = *(const PG8_LAS bf16x8*)(lds + PG8_SB(b, h) + boff + n * 2048 + k * 1024); } while (0)
#define PG8_MMA(ai, bj, At, Bt) do { __builtin_amdgcn_s_setprio(1); _Pragma("unroll") for (int m = 0; m < 4; ++m) _Pragma("unroll") for (int n = 0; n < 2; ++n) _Pragma("unroll") for (int k = 0; k < 2; ++k) \
        acc[ai][bj][m][n] = __builtin_amdgcn_mfma_f32_16x16x32_bf16(Bt[n][k], At[m][k], acc[ai][bj][m][n], 0, 0, 0); __builtin_amdgcn_s_setprio(0); } while (0)
#define PG8_WAIT_V(n) asm volatile("s_waitcnt vmcnt(" #n ")" ::: "memory")
#define PG8_WAIT_L(n) asm volatile("s_waitcnt lgkmcnt(" #n ")" ::: "memory")
#define PG8_BAR __builtin_amdgcn_s_barrier()
#define PG8_SCHED __builtin_amdgcn_sched_barrier(0)
    Unit cur, nxt; int ui = 0;
    if (!S.next(0, cur)) return;
    f32x4 acc[2][2][4][2];
#pragma unroll
    for (int a = 0; a < 2; ++a)
#pragma unroll
        for (int b = 0; b < 2; ++b)
#pragma unroll
            for (int m = 0; m < 4; ++m)
#pragma unroll
                for (int n = 0; n < 2; ++n) acc[a][b][m][n] = (f32x4){0.f, 0.f, 0.f, 0.f};
    bf16x8 At[4][2], B0[2][2], B1[2][2];
    const char* cA = (const char*)g.A + (size_t)cur.pm * tstep; const char* cB = (const char*)g.Bt + (size_t)cur.pn * tstep;
    S.a_ready(cur);
    if constexpr (SP2) {
        PG8_STAGE(PG8_SB(0, 0), cB, voffB); PG8_STAGE(PG8_SB(0, 1), cB + hstep, voffB); PG8_STAGE(PG8_SA(0, 0), cA, voffA); PG8_STAGE(PG8_SA(0, 1), cA + hstep, voffA);
        if (wr == 1) PG8_BAR;
        PG8_WAIT_V(2); PG8_BAR;
        PG8_STAGE(PG8_SB(1, 0), cB + kstep, voffB); PG8_STAGE(PG8_SA(1, 0), cA + kstep, voffA); PG8_STAGE(PG8_SB(1, 1), cB + hstep + kstep, voffB);
        PG8_WAIT_V(6); PG8_BAR;
    } else {
        PG8_STAGE(PG8_SB(0, 0), cB, voffB); PG8_STAGE(PG8_SA(0, 0), cA, voffA); PG8_STAGE(PG8_SB(0, 1), cB + hstep, voffB); PG8_STAGE(PG8_SA(0, 1), cA + hstep, voffA);
        if (wr == 1) PG8_BAR;
        PG8_WAIT_V(4); PG8_BAR;
        PG8_STAGE(PG8_SB(1, 0), cB + kstep, voffB); PG8_STAGE(PG8_SA(1, 0), cA + kstep, voffA); PG8_STAGE(PG8_SB(1, 1), cB + hstep + kstep, voffB);
        PG8_WAIT_V(6); PG8_BAR;
    }
    for (;;) {
        const bool has_next = S.next(ui + 1, nxt);
        const char* nA = has_next ? (const char*)g.A + (size_t)nxt.pm * tstep : cA; const char* nB = has_next ? (const char*)g.Bt + (size_t)nxt.pn * tstep : cB;
        for (int t = 0; t < nt; t += 2) {
            const bool last = (t == nt - 2);
            const char* a1 = cA + (size_t)(t + 1) * kstep;
            const char* a2 = last ? nA : cA + (size_t)(t + 2) * kstep; const char* b2 = last ? nB : cB + (size_t)(t + 2) * kstep;
            const char* a3 = a2 + kstep; const char* b3 = b2 + kstep;
            if (last && has_next) S.a_ready(nxt);
            if constexpr (SP2) {
            PG8_LDB(B0, 0, 0); PG8_LDB(B1, 0, 1); PG8_SCHED; PG8_LDA(At, 0, 0); PG8_STAGE(PG8_SA(1, 1), a1 + hstep, voffA);
            PG8_WAIT_V(8); PG8_WAIT_L(0); PG8_BAR; PG8_MMA(0, 0, At, B0); PG8_MMA(0, 1, At, B1); PG8_BAR; PG8_SCHED;
            PG8_LDA(At, 0, 1); PG8_STAGE(PG8_SB(0, 0), b2, voffB); PG8_STAGE(PG8_SB(0, 1), b2 + hstep, voffB); PG8_STAGE(PG8_SA(0, 0), a2, voffA);
            PG8_WAIT_V(8); PG8_WAIT_L(0); PG8_BAR; PG8_MMA(1, 0, At, B0); PG8_MMA(1, 1, At, B1); PG8_BAR; PG8_SCHED;
            PG8_LDB(B0, 1, 0); PG8_LDB(B1, 1, 1); PG8_SCHED; PG8_LDA(At, 1, 0); PG8_STAGE(PG8_SA(0, 1), a2 + hstep, voffA);
            PG8_WAIT_V(8); PG8_WAIT_L(0); PG8_BAR; PG8_MMA(0, 0, At, B0); PG8_MMA(0, 1, At, B1); PG8_BAR; PG8_SCHED;
            PG8_LDA(At, 1, 1); PG8_STAGE(PG8_SB(1, 0), b3, voffB); PG8_STAGE(PG8_SB(1, 1), b3 + hstep, voffB); PG8_STAGE(PG8_SA(1, 0), a3, voffA);
            PG8_WAIT_V(8); PG8_WAIT_L(0); PG8_BAR; PG8_MMA(1, 0, At, B0); PG8_MMA(1, 1, At, B1); PG8_BAR; PG8_SCHED;
            } else {
            PG8_LDB(B0, 0, 0); PG8_SCHED; PG8_LDA(At, 0, 0); PG8_STAGE(PG8_SA(1, 1), a1 + hstep, voffA);
            PG8_WAIT_L(8); PG8_BAR; PG8_WAIT_L(0); PG8_MMA(0, 0, At, B0); PG8_BAR; PG8_SCHED;
            PG8_LDB(B1, 0, 1); PG8_STAGE(PG8_SB(0, 0), b2, voffB);
            PG8_BAR; PG8_WAIT_L(0); PG8_MMA(0, 1, At, B1); PG8_BAR;
            PG8_LDA(At, 0, 1); PG8_STAGE(PG8_SA(0, 0), a2, voffA);
            PG8_BAR; PG8_WAIT_L(0); PG8_MMA(1, 0, At, B0); PG8_BAR; PG8_SCHED;
            PG8_STAGE(PG8_SB(0, 1), b2 + hstep, voffB);
            PG8_WAIT_V(6); PG8_BAR; PG8_MMA(1, 1, At, B1); PG8_BAR;
            PG8_LDB(B0, 1, 0); PG8_SCHED; PG8_LDA(At, 1, 0); PG8_STAGE(PG8_SA(0, 1), a2 + hstep, voffA);
            PG8_WAIT_L(8); PG8_BAR; PG8_WAIT_L(0); PG8_MMA(0, 0, At, B0); PG8_BAR; PG8_SCHED;
            PG8_LDB(B1, 1, 1); PG8_STAGE(PG8_SB(1, 0), b3, voffB);
            PG8_BAR; PG8_WAIT_L(0); PG8_MMA(0, 1, At, B1); PG8_BAR;
            PG8_LDA(At, 1, 1); PG8_STAGE(PG8_SA(1, 0), a3, voffA);
            PG8_BAR; PG8_WAIT_L(0); PG8_MMA(1, 0, At, B0); PG8_BAR; PG8_SCHED;
            PG8_STAGE(PG8_SB(1, 1), b3 + hstep, voffB);
            PG8_WAIT_V(6); PG8_BAR; PG8_MMA(1, 1, At, B1); PG8_BAR;
            }
        }
        if constexpr (ALIGN_EPI) { if (wr == 0) PG8_BAR; }
        if constexpr (!Epi::AFTER_DRAIN) { E(acc, cur, wr, wc, fr, fq); S.done(cur); }
        if (!has_next) break;
#pragma unroll
        for (int a = 0; a < 2; ++a)
#pragma unroll
            for (int b = 0; b < 2; ++b)
#pragma unroll
                for (int m = 0; m < 4; ++m)
#pragma unroll
                    for (int n = 0; n < 2; ++n) acc[a][b][m][n] = (f32x4){0.f, 0.f, 0.f, 0.f};
        cur = nxt; cA = nA; cB = nB; ++ui;
        if constexpr (ALIGN_EPI) { if (wr == 1) PG8_BAR; }
    }
    PG8_WAIT_V(0);
    if constexpr (!ALIGN_EPI) { if (wr == 0) PG8_BAR; }
    PG8_BAR;
    if constexpr (Epi::AFTER_DRAIN) { E.fused(acc, cur, wr, wc, fr, fq, lds, wid, lane); S.done(cur); }
#undef PG8_SA
#undef PG8_SB
#undef PG8_STAGE
#undef PG8_LDA
#undef PG8_LDB
#undef PG8_MMA
#undef PG8_WAIT_V
#undef PG8_WAIT_L
#undef PG8_BAR
#undef PG8_SCHED
}
}
namespace pg8 {
__device__ __forceinline__ u32x4 pack8(const f32x4 a, const f32x4 b) { u32x4 w; w.x = cvt_pk_bf16(a[0], a[1]); w.y = cvt_pk_bf16(a[2], a[3]); w.z = cvt_pk_bf16(b[0], b[1]); w.w = cvt_pk_bf16(b[2], b[3]); return w; }

struct EpiInProj {
    static constexpr bool PERM = true, AFTER_DRAIN = false;
    bf16_t* Q; bf16_t* KV; bf16_t* Z; bf16_t* BG; float* G; const float* qn; const float* kn;
    __device__ __forceinline__ void operator()(const f32x4 (&acc)[2][2][4][2], const Unit& u, int wr, int wc, int fr, int fq) const {
        const int pn = u.pn; const int row0 = u.pm * BM + wr * 64 + fr;
        if (pn <= 4) {
            const bool donorm = (pn < 2) || (pn >= 3 && wc < 2);
            const float* nw = (pn < 2) ? qn : kn;
            const float sc = (pn < 2) ? (0.125f * 1.4426950408889634f) : 1.0f;
            f32x4 w4[2][2];
#pragma unroll
            for (int bj = 0; bj < 2; ++bj)
#pragma unroll
                for (int n = 0; n < 2; ++n) { f32x4 t = *(const f32x4*)(nw + 32 * bj + 8 * fq + 4 * n); w4[bj][n] = donorm ? t * sc : (f32x4){1.f, 1.f, 1.f, 1.f}; }
            bf16_t* base; size_t rstride;
            if (pn < 2) { base = Q + (4 * pn + wc) * 64 + 8 * fq; rstride = 512; }
            else { const int ti = (pn - 2) * 2 + (wc >> 1), g = wc & 1; base = KV + (size_t)ti * ((size_t)4 * 2 * 8192 * 64) + 8 * fq; rstride = 64;
                   base += (size_t)g * 8192 * 64; }
#pragma unroll
            for (int ai = 0; ai < 2; ++ai)
#pragma unroll
                for (int m = 0; m < 4; ++m) {
                    const int r = row0 + ai * HALF + m * 16;
                    float rs = 1.f;
                    if (donorm) {
                        float ss = 0.f;
#pragma unroll
                        for (int bj = 0; bj < 2; ++bj)
#pragma unroll
                            for (int n = 0; n < 2; ++n) { const f32x4 x = acc[ai][bj][m][n]; ss += (x[0] * x[0] + x[1] * x[1]) + (x[2] * x[2] + x[3] * x[3]); }
                        ss += __shfl_xor(ss, 16); ss += __shfl_xor(ss, 32);
                        rs = 1.0f / sqrtf(ss * (1.0f / 64.0f) + 1e-6f);
                    }
                    size_t off;
                    if (pn < 2) off = (size_t)r * 512;
                    else { const int b = r >> 13, t = r & 8191; off = ((size_t)(b * 2) * 8192 + t) * 64; }
#pragma unroll
                    for (int bj = 0; bj < 2; ++bj) {
                        const f32x4 v0 = acc[ai][bj][m][0] * rs * w4[bj][0], v1 = acc[ai][bj][m][1] * rs * w4[bj][1];
                        *(u32x4*)(base + off + 32 * bj) = pack8(v0, v1);
                    }
                }
        } else if (pn <= 8) {
            bf16_t* base = Z + 128 * (pn - 5) + 32 * wc + 8 * fq;
#pragma unroll
            for (int ai = 0; ai < 2; ++ai)
#pragma unroll
                for (int m = 0; m < 4; ++m) {
                    const int r = row0 + ai * HALF + m * 16;
                    const f32x4 v0 = acc[ai][0][m][0] * acc[ai][1][m][0], v1 = acc[ai][0][m][1] * acc[ai][1][m][1];
                    *(u32x4*)(base + (size_t)r * 512) = pack8(v0, v1);
                }
        } else if (pn <= 10) {
            bf16_t* base = BG + 256 * (pn - 9) + 32 * wc + 8 * fq;
#pragma unroll
            for (int ai = 0; ai < 2; ++ai)
#pragma unroll
                for (int m = 0; m < 4; ++m) {
                    const int r = row0 + ai * HALF + m * 16;
#pragma unroll
                    for (int bj = 0; bj < 2; ++bj) *(u32x4*)(base + (size_t)r * 512 + 128 * bj) = pack8(acc[ai][bj][m][0], acc[ai][bj][m][1]);
                }
        } else {
            if (wc == 0 && fq < 3) {
#pragma unroll
                for (int ai = 0; ai < 2; ++ai)
#pragma unroll
                    for (int m = 0; m < 4; ++m) {
                        const int r = row0 + ai * HALF + m * 16;
#pragma unroll
                        for (int n = 0; n < 2; ++n) { const f32x4 x = acc[ai][0][m][n]; f32x4 s;
#pragma unroll
                            for (int e = 0; e < 4; ++e) s[e] = 1.0f / (1.0f + __expf(-x[e]));
                            *(f32x4*)(G + (size_t)r * 32 + 8 * fq + 4 * n) = s; }
                    }
            }
        }
    }
};

struct EpiOutProj {
    static constexpr bool PERM = true, AFTER_DRAIN = false;
    const float* x; float* out; bf16_t* A2; float* RSS; const float* mod; const float* n2;
    __device__ __forceinline__ void operator()(const f32x4 (&acc)[2][2][4][2], const Unit& u, int wr, int wc, int fr, int fq) const {
        const int row0 = u.pm * BM + wr * 64 + fr; const int b = (u.pm * BM) >> 13;
        const int col0 = u.pn * BM + wc * 32 + 8 * fq;
        f32x4 g1[2][2], a2[2][2];
#pragma unroll
        for (int bj = 0; bj < 2; ++bj)
#pragma unroll
            for (int n = 0; n < 2; ++n) { const int c = col0 + 128 * bj + 4 * n;
                g1[bj][n] = *(const f32x4*)(mod + (size_t)b * 6144 + 2 * 1024 + c);
                const f32x4 s2 = *(const f32x4*)(mod + (size_t)b * 6144 + 4 * 1024 + c), nn = *(const f32x4*)(n2 + c);
                a2[bj][n] = nn * (s2 + 1.0f); }
#pragma unroll
        for (int ai = 0; ai < 2; ++ai)
#pragma unroll
            for (int m = 0; m < 4; ++m) {
                const int r = row0 + ai * HALF + m * 16; float ss = 0.f;
#pragma unroll
                for (int bj = 0; bj < 2; ++bj) {
                    const size_t off = (size_t)r * 1024 + col0 + 128 * bj;
                    const f32x4 xa = *(const f32x4*)(x + off), xb = *(const f32x4*)(x + off + 4);
                    const f32x4 ya = xa + g1[bj][0] * acc[ai][bj][m][0], yb = xb + g1[bj][1] * acc[ai][bj][m][1];
                    *(f32x4*)(out + off) = ya; *(f32x4*)(out + off + 4) = yb;
                    ss += (ya[0] * ya[0] + ya[1] * ya[1]) + (ya[2] * ya[2] + ya[3] * ya[3]) + (yb[0] * yb[0] + yb[1] * yb[1]) + (yb[2] * yb[2] + yb[3] * yb[3]);
                    *(u32x4*)(A2 + off) = pack8(ya * a2[bj][0], yb * a2[bj][1]);
                }
                ss += __shfl_xor(ss, 16); ss += __shfl_xor(ss, 32);
                if (fq == 0) RSS[(size_t)r * 16 + u.pn * 4 + wc] = ss;
            }
    }
};

struct EpiFF1 {
    static constexpr bool PERM = true, AFTER_DRAIN = false;
    bf16_t* HID; const float* RSS; const float* bff1;
    __device__ __forceinline__ void operator()(const f32x4 (&acc)[2][2][4][2], const Unit& u, int wr, int wc, int fr, int fq) const {
        const int row0 = u.pm * BM + wr * 64 + fr; const int b = (u.pm * BM) >> 13;
        const int col0 = u.pn * BM + wc * 32 + 8 * fq;
        f32x4 bv[2][2];
#pragma unroll
        for (int bj = 0; bj < 2; ++bj)
#pragma unroll
            for (int n = 0; n < 2; ++n) bv[bj][n] = *(const f32x4*)(bff1 + (size_t)b * 4096 + col0 + 128 * bj + 4 * n);
#pragma unroll
        for (int ai = 0; ai < 2; ++ai)
#pragma unroll
            for (int m = 0; m < 4; ++m) {
                const int r = row0 + ai * HALF + m * 16;
                const f32x4 s0 = *(const f32x4*)(RSS + (size_t)r * 16), s1 = *(const f32x4*)(RSS + (size_t)r * 16 + 4), s2 = *(const f32x4*)(RSS + (size_t)r * 16 + 8), s3 = *(const f32x4*)(RSS + (size_t)r * 16 + 12);
                const f32x4 st = (s0 + s1) + (s2 + s3);
                const float rs = 1.0f / sqrtf(((st[0] + st[1]) + (st[2] + st[3])) * (1.0f / 1024.0f) + 1e-6f);
#pragma unroll
                for (int bj = 0; bj < 2; ++bj) {
                    f32x4 h0 = acc[ai][bj][m][0] * rs + bv[bj][0], h1 = acc[ai][bj][m][1] * rs + bv[bj][1];
#pragma unroll
                    for (int e = 0; e < 4; ++e) { const float a = fmaxf(h0[e], 0.f), c = fmaxf(h1[e], 0.f); h0[e] = a * a; h1[e] = c * c; }
                    *(u32x4*)(HID + (size_t)r * 4096 + col0 + 128 * bj) = pack8(h0, h1);
                }
            }
    }
};

struct EpiFF2 {
    static constexpr bool PERM = true, AFTER_DRAIN = false;
    float* out; const float* mod;
    __device__ __forceinline__ void operator()(const f32x4 (&acc)[2][2][4][2], const Unit& u, int wr, int wc, int fr, int fq) const {
        const int row0 = u.pm * BM + wr * 64 + fr; const int b = (u.pm * BM) >> 13;
        const int col0 = u.pn * BM + wc * 32 + 8 * fq;
        f32x4 g2[2][2];
#pragma unroll
        for (int bj = 0; bj < 2; ++bj)
#pragma unroll
            for (int n = 0; n < 2; ++n) g2[bj][n] = *(const f32x4*)(mod + (size_t)b * 6144 + 5 * 1024 + col0 + 128 * bj + 4 * n);
#pragma unroll
        for (int ai = 0; ai < 2; ++ai)
#pragma unroll
            for (int m = 0; m < 4; ++m) {
                const int r = row0 + ai * HALF + m * 16;
#pragma unroll
                for (int bj = 0; bj < 2; ++bj) {
                    const size_t off = (size_t)r * 1024 + col0 + 128 * bj;
                    const f32x4 xa = *(const f32x4*)(out + off), xb = *(const f32x4*)(out + off + 4);
                    *(f32x4*)(out + off) = xa + g2[bj][0] * acc[ai][bj][m][0]; *(f32x4*)(out + off + 4) = xb + g2[bj][1] * acc[ai][bj][m][1];
                }
            }
    }
};
}

#ifndef MK_N_LAUNCHES
#define MK_N_LAUNCHES 1
#endif
constexpr int NWAVES = 8;
constexpr int N_PHASES = 8;
constexpr int BATCH = 4, T = 8192, D = 1024, M = BATCH * T, FF = 4096, NIN = 3072, INCOLS = 2840;
constexpr int NCMP = 511;
constexpr float LOG2E = 1.4426950408889634f;
constexpr size_t MiB = 1u << 20;
constexpr size_t WS_CTL = 0, CTL_ZERO_BYTES = 1 * MiB;
constexpr size_t WS_MOD = 1 * MiB;
constexpr size_t WS_BFF1 = 1 * MiB + 128 * 1024;
constexpr size_t WS_PEP = 1 * MiB + 256 * 1024;
constexpr size_t WS_RSS = 2 * MiB;
constexpr size_t WS_G = 4 * MiB;
constexpr size_t WS_WIN = 8 * MiB;
constexpr size_t WS_WOUT = 14 * MiB;
constexpr size_t WS_W1 = 16 * MiB;
constexpr size_t WS_W2 = 24 * MiB;
constexpr size_t WS_CW1K = 32 * MiB, WS_CW1V = 33 * MiB;
constexpr size_t WS_CW2K = 34 * MiB, WS_CW2V = 34 * MiB + 64 * 1024;
constexpr size_t WS_KC = 35 * MiB, WS_VC = 35 * MiB + 512 * 1024;
constexpr size_t WS_A2 = 36 * MiB;
constexpr size_t WS_H = 100 * MiB;
constexpr size_t WS_Q = 164 * MiB;
constexpr size_t WS_KV = 196 * MiB;
constexpr size_t KV_TENS = (size_t)4 * 2 * 8192 * 64;
constexpr size_t WS_Z = 244 * MiB;
constexpr size_t WS_BG = 276 * MiB;
constexpr size_t WS_MIX = 308 * MiB;
constexpr size_t WS_HID = 100 * MiB;
constexpr size_t WS_END = 372 * MiB;
constexpr int CW_BAR = 4096;

constexpr int RING_BYTES = 131072;
constexpr int LDSCTL_OFF = RING_BYTES, MISC_OFF = LDSCTL_OFF + 320;
constexpr int LDS_BYTES = 147456;

#define GAS __attribute__((address_space(1)))
#define LAS __attribute__((address_space(3)))
typedef unsigned short bf16;
typedef unsigned v4u __attribute__((ext_vector_type(4)));
typedef float f32x4 __attribute__((ext_vector_type(4)));
typedef float f32x16 __attribute__((ext_vector_type(16)));
typedef short bf16x8 __attribute__((ext_vector_type(8)));
typedef short s16x4 __attribute__((ext_vector_type(4)));
typedef GAS unsigned gu32;
#define RLX_AGENT __ATOMIC_RELAXED, __HIP_MEMORY_SCOPE_AGENT
#define LDS_WAIT() asm volatile("s_waitcnt lgkmcnt(0)" ::: "memory")
#define VM_WAIT() asm volatile("s_waitcnt vmcnt(0)" ::: "memory")
__device__ __forceinline__ unsigned f2bf(float f) { unsigned u = __builtin_bit_cast(unsigned, f); return (u + 0x7fffu + ((u >> 16) & 1u)) >> 16; }
__device__ __forceinline__ unsigned pk2(float lo, float hi) { return f2bf(lo) | (f2bf(hi) << 16); }
__device__ __forceinline__ float bf2f(unsigned short h) { return __builtin_bit_cast(float, (unsigned)h << 16); }
#define XB_TMO      128
#define XB_XCNT(j)  (256  + 64 * (j))
#define XB_XSUB(j)  (1280 + 64 * (j))
#define XB_XGEN(j)  (2304 + 64 * (j))
#define XB_TOP      3328
#define XB_TOPGEN   3392
#define XCD_BAR_WORDS 3456
#define XB_SPIN_CAP (1u << 18)

__device__ __forceinline__ unsigned xb_ld(unsigned* p)              { return __hip_atomic_load(p, __ATOMIC_RELAXED, __HIP_MEMORY_SCOPE_AGENT); }
__device__ __forceinline__ unsigned xb_add(unsigned* p, unsigned v) { return __hip_atomic_fetch_add(p, v, __ATOMIC_RELAXED, __HIP_MEMORY_SCOPE_AGENT); }
__device__ __forceinline__ unsigned xb_xcc_id() { return (unsigned)__builtin_amdgcn_s_getreg((3 << 11) | 20) & 0xFu; }
#define XB_SPIN(cond, bar) do { unsigned _sp = 0; while (cond) { __builtin_amdgcn_s_sleep(1); \
    if ((++_sp & 255u) == 0u) { if (xb_ld(&(bar)[XB_TMO])) break; if (_sp > XB_SPIN_CAP) { atomicAdd(&(bar)[XB_TMO], 1u); break; } } } } while (0)

struct XcdBarrier {
    unsigned* bar; unsigned x;
    volatile LAS unsigned* st;
};

__device__ __forceinline__ XcdBarrier xcd_barrier_post(unsigned* bar, volatile LAS unsigned* st) {
    XcdBarrier b; b.bar = bar; b.x = xb_xcc_id(); b.st = st;
    if (threadIdx.x == 0) (void)xb_add(&bar[XB_XCNT(b.x)], 1u);
    return b;
}
__device__ __forceinline__ void xcd_barrier_complete(unsigned* bar, unsigned x, unsigned& nloc, unsigned& nx) {
    const unsigned G = gridDim.x * gridDim.y * gridDim.z;
    unsigned sum, cnt, mine, sp = 0u;
    for (;;) {
        sum = 0u; cnt = 0u; mine = 0u;
#pragma unroll
        for (unsigned j = 0; j < 16; ++j) { const unsigned c = xb_ld(&bar[XB_XCNT(j)]); sum += c; cnt += (c > 0u) ? 1u : 0u; mine = (j == x) ? c : mine; }
        if (sum == G) break;
        __builtin_amdgcn_s_sleep(1);
        if ((++sp & 255u) == 0u) { if (xb_ld(&bar[XB_TMO])) break; if (sp > XB_SPIN_CAP) { atomicAdd(&bar[XB_TMO], 1u); break; } }
    }
    nloc = mine > 0u ? mine : 1u; nx = cnt > 0u ? cnt : 1u;
}

__device__ __forceinline__ void xcd_barrier(const XcdBarrier& b) {
    asm volatile("s_waitcnt vmcnt(0)" ::: "memory");
    __syncthreads();
    if (threadIdx.x == 0) {
        unsigned* bar = b.bar;
        __builtin_amdgcn_s_waitcnt(0);
        unsigned nloc = b.st[0], nx = b.st[1];
        if (nloc == 0u) { xcd_barrier_complete(bar, b.x, nloc, nx); b.st[0] = nloc; b.st[1] = nx; }
        const unsigned old = xb_add(&bar[XB_XSUB(b.x)], 1u);
        const unsigned gen = old / nloc;
        if (old + 1u == (gen + 1u) * nloc) {
            __builtin_amdgcn_fence(__ATOMIC_RELEASE, "agent");
            asm volatile("s_waitcnt vmcnt(0)" ::: "memory");
            const unsigned og = xb_add(&bar[XB_TOP], 1u);
            const unsigned tg = og / nx;
            if (og + 1u == (tg + 1u) * nx) xb_add(&bar[XB_TOPGEN], 1u);
            else XB_SPIN(xb_ld(&bar[XB_TOPGEN]) == tg, bar);
            __builtin_amdgcn_fence(__ATOMIC_ACQUIRE, "agent");
            xb_add(&bar[XB_XGEN(b.x)], 1u);
            asm volatile("s_waitcnt vmcnt(0)" ::: "memory");
        } else {
            XB_SPIN(xb_ld(&bar[XB_XGEN(b.x)]) == gen, bar);
            __builtin_amdgcn_fence(__ATOMIC_ACQUIRE, "agent");
            asm volatile("s_waitcnt vmcnt(0)" ::: "memory");
        }
    }
    __syncthreads();
}

struct Frame {
    LAS unsigned char* lds;
    volatile LAS unsigned* MISC;
    gu32* ctl;
    int tid, lane, wave;
    int vcu, G;
    const float* in[20];
    float* out;
    unsigned char* ws;
};
__device__ __forceinline__ float wave_sum(float v) {
#pragma unroll
    for (int o = 1; o < 64; o <<= 1) v += __shfl_xor(v, o);
    return v;
}

__device__ __forceinline__ void p0_transpose_item(const float* W, int K, int N, int nsrc0, int nvalid, bf16* WT, int drow0, int kb, LAS float* scr, int lane) {
    const int k0 = 64 * kb; const int nl = lane & 31;
#pragma unroll 8
    for (int i = 0; i < 32; ++i) { const int kk = 2 * i + (lane >> 5); scr[kk * 33 + nl] = (nl < nvalid) ? W[(size_t)(k0 + kk) * N + nsrc0 + nl] : 0.f; }
    LDS_WAIT(); asm volatile("" ::: "memory");
    const int c = lane & 7;
#pragma unroll
    for (int j = 0; j < 4; ++j) { const int n = (lane >> 3) + 8 * j; const LAS float* s = scr + (8 * c) * 33 + n;
        v4u o; o.x = pk2(s[0 * 33], s[1 * 33]); o.y = pk2(s[2 * 33], s[3 * 33]); o.z = pk2(s[4 * 33], s[5 * 33]); o.w = pk2(s[6 * 33], s[7 * 33]);
        *(GAS v4u*)(WT + (size_t)(drow0 + n) * K + k0 + 8 * c) = o; }
    LDS_WAIT(); asm volatile("" ::: "memory");
}
__device__ __forceinline__ void win_src(int rb, int& src0, int& nvalid) {
    const int pn = rb >> 3, q = rb & 7, bj = q >> 2, wc = q & 3; nvalid = 32;
    if (pn < 2) src0 = (4 * pn + wc) * 64 + 32 * bj;
    else if (pn < 5) src0 = 512 + (pn - 2) * 256 + (wc >> 1) * 128 + (wc & 1) * 64 + 32 * bj;
    else if (pn < 9) src0 = (bj == 0 ? 1304 : 2328) + 128 * (pn - 5) + 32 * wc;
    else if (pn < 11) src0 = 1816 + 256 * (pn - 9) + 32 * q;
    else { src0 = 1280; nvalid = (q == 0) ? 24 : 0; }
}
__device__ __forceinline__ void p0_phase(Frame& F) {
    const int bid = blockIdx.x;
    for (int it = bid; it < 224; it += F.G) {
      if (it < 192) {
        const int cb = it;
        LAS float* sc = (LAS float*)(F.lds);
        LAS float* red = (LAS float*)(F.lds + 16384);
        const float* c = F.in[1];
        for (int i = F.tid; i < 4096; i += 512) { const float v = c[i]; sc[i] = v / (1.0f + __expf(-v)); }
        __syncthreads();
        const float* wa = F.in[16]; const int col = 32 * cb + (F.lane & 31), kpar = F.lane >> 5;
        float a0 = 0.f, a1 = 0.f, a2 = 0.f, a3 = 0.f;
#pragma unroll 8
        for (int i = 0; i < 64; ++i) { const int k = 128 * F.wave + 2 * i + kpar; const float w = wa[(size_t)k * 6144 + col];
            a0 += sc[k] * w; a1 += sc[1024 + k] * w; a2 += sc[2048 + k] * w; a3 += sc[3072 + k] * w; }
        a0 += __shfl_xor(a0, 32); a1 += __shfl_xor(a1, 32); a2 += __shfl_xor(a2, 32); a3 += __shfl_xor(a3, 32);
        if (F.lane < 32) { red[(F.wave * 4 + 0) * 32 + F.lane] = a0; red[(F.wave * 4 + 1) * 32 + F.lane] = a1; red[(F.wave * 4 + 2) * 32 + F.lane] = a2; red[(F.wave * 4 + 3) * 32 + F.lane] = a3; }
        __syncthreads();
        if (F.tid < 128) { const int b = F.tid >> 5, cc = F.tid & 31; float s = F.in[17][32 * cb + cc];
#pragma unroll
            for (int w = 0; w < 8; ++w) s += red[(w * 4 + b) * 32 + cc];
            ((float*)(F.ws + WS_MOD))[b * 6144 + 32 * cb + cc] = s; }
        __syncthreads();
      } else {
        const int kv = (it - 192) >> 4, kc = (it - 192) & 15; const float* pe = F.in[kv ? 8 : 5]; const float* w1 = F.in[kv ? 9 : 6];
        if (F.tid < 256) { float s = 0.f;
#pragma unroll 8
            for (int k = 128 * kc; k < 128 * kc + 128; ++k) s += pe[k] * w1[(size_t)k * 256 + F.tid];
            ((float*)(F.ws + WS_PEP))[(kv * 16 + kc) * 256 + F.tid] = s; }
      }
    }
    __syncthreads();
    LAS float* scr = (LAS float*)(F.lds + F.wave * 16384);
    const int gw = F.vcu * NWAVES + F.wave, NGW = F.G * NWAVES;
    constexpr int I_IN = 96 * 16, I_OUT = 32 * 16, I_1 = 128 * 16, I_2 = 32 * 64, I_C1 = 8 * 32, I_C2 = 2 * 4;
    constexpr int NITEMS = I_IN + I_OUT + I_1 + I_2 + 2 * I_C1 + 2 * I_C2;
    for (int it = gw; it < NITEMS; it += NGW) {
        int r = it;
        if (r < I_IN) { const int rb = r >> 4, kb = r & 15; int s0, nv; win_src(rb, s0, nv); p0_transpose_item(F.in[2], D, INCOLS, s0, nv, (bf16*)(F.ws + WS_WIN), 32 * rb, kb, scr, F.lane); continue; } r -= I_IN;
        if (r < I_OUT) { const int rb = r >> 4, kb = r & 15; p0_transpose_item(F.in[13], D, D, 32 * rb, 32, (bf16*)(F.ws + WS_WOUT), 32 * rb, kb, scr, F.lane); continue; } r -= I_OUT;
        if (r < I_1) { const int rb = r >> 4, kb = r & 15; p0_transpose_item(F.in[18], D, FF, 32 * rb, 32, (bf16*)(F.ws + WS_W1), 32 * rb, kb, scr, F.lane); continue; } r -= I_1;
        if (r < I_2) { const int rb = r >> 6, kb = r & 63; p0_transpose_item(F.in[19], FF, D, 32 * rb, 32, (bf16*)(F.ws + WS_W2), 32 * rb, kb, scr, F.lane); continue; } r -= I_2;
        if (r < I_C1) { const int rb = r >> 5, kb = r & 31; p0_transpose_item(F.in[6], 2048, 256, 32 * rb, 32, (bf16*)(F.ws + WS_CW1K), 32 * rb, kb, scr, F.lane); continue; } r -= I_C1;
        if (r < I_C1) { const int rb = r >> 5, kb = r & 31; p0_transpose_item(F.in[9], 2048, 256, 32 * rb, 32, (bf16*)(F.ws + WS_CW1V), 32 * rb, kb, scr, F.lane); continue; } r -= I_C1;
        if (r < I_C2) { const int rb = r >> 2, kb = r & 3; p0_transpose_item(F.in[7], 256, 64, 32 * rb, 32, (bf16*)(F.ws + WS_CW2K), 32 * rb, kb, scr, F.lane); continue; } r -= I_C2;
        { const int rb = r >> 2, kb = r & 3; p0_transpose_item(F.in[10], 256, 64, 32 * rb, 32, (bf16*)(F.ws + WS_CW2V), 32 * rb, kb, scr, F.lane); }
    }
}

__device__ __forceinline__ void p1_phase(Frame& F) {
    const int gw = F.vcu * NWAVES + F.wave, NGW = F.G * NWAVES;
    const float* mod = (const float*)(F.ws + WS_MOD);
    const float* x = F.in[0]; const float* n1 = F.in[14];
    bf16* H = (bf16*)(F.ws + WS_H);
    for (int chunk = gw; chunk < M / 16; chunk += NGW) {
        const int r0 = chunk * 16, b = r0 >> 13;
        f32x4 ca[4], cb[4];
#pragma unroll
        for (int j = 0; j < 4; ++j) { const int c = 4 * (F.lane + 64 * j);
            const f32x4 nn = *(const f32x4*)(n1 + c), s1 = *(const f32x4*)(mod + (size_t)b * 6144 + 1024 + c);
            ca[j] = nn * (s1 + 1.0f); cb[j] = *(const f32x4*)(mod + (size_t)b * 6144 + c); }
        for (int rr = 0; rr < 16; ++rr) {
            const GAS f32x4* xr = (const GAS f32x4*)(x + (size_t)(r0 + rr) * D) + F.lane;
            f32x4 v[4]; float s = 0.f;
#pragma unroll
            for (int j = 0; j < 4; ++j) { v[j] = xr[64 * j]; s += (v[j].x * v[j].x + v[j].y * v[j].y) + (v[j].z * v[j].z + v[j].w * v[j].w); }
            const float rs = 1.0f / sqrtf(wave_sum(s) * (1.0f / D) + 1e-6f);
            GAS unsigned long long* o8 = (GAS unsigned long long*)(H + (size_t)(r0 + rr) * D) + F.lane;
#pragma unroll
            for (int j = 0; j < 4; ++j) { const f32x4 h = v[j] * rs * ca[j] + cb[j];
                o8[64 * j] = (unsigned long long)pk2(h.x, h.y) | ((unsigned long long)pk2(h.z, h.w) << 32); }
        }
    }
    const bf16* W1t = (const bf16*)(F.ws + WS_W1);
    float* bff1 = (float*)(F.ws + WS_BFF1);
    for (int n = gw; n < FF; n += NGW) {
        float a[4] = {0.f, 0.f, 0.f, 0.f};
#pragma unroll
        for (int j = 0; j < 2; ++j) { const int k0 = 8 * F.lane + 512 * j;
            const v4u wv = *(const GAS v4u*)(W1t + (size_t)n * D + k0);
            float w[8]; w[0] = bf2f(wv.x & 0xffff); w[1] = bf2f(wv.x >> 16); w[2] = bf2f(wv.y & 0xffff); w[3] = bf2f(wv.y >> 16); w[4] = bf2f(wv.z & 0xffff); w[5] = bf2f(wv.z >> 16); w[6] = bf2f(wv.w & 0xffff); w[7] = bf2f(wv.w >> 16);
#pragma unroll
            for (int b = 0; b < 4; ++b) { const f32x4 s0 = *(const f32x4*)(mod + (size_t)b * 6144 + 3 * 1024 + k0), s1 = *(const f32x4*)(mod + (size_t)b * 6144 + 3 * 1024 + k0 + 4);
                a[b] += (w[0] * s0[0] + w[1] * s0[1]) + (w[2] * s0[2] + w[3] * s0[3]) + (w[4] * s1[0] + w[5] * s1[1]) + (w[6] * s1[2] + w[7] * s1[3]); } }
#pragma unroll
        for (int b = 0; b < 4; ++b) { const float s = wave_sum(a[b]); if (F.lane == 0) bff1[b * 4096 + n] = s; }
    }
}

__device__ __forceinline__ float gelu_tanh(float x) {
    const float u = 0.7978845608028654f * (x + 0.044715f * x * x * x);
    const float e = __expf(2.0f * u);
    const float th = 1.0f - 2.0f / (1.0f + e);
    return 0.5f * x * (1.0f + th);
}
__device__ __forceinline__ void p3_phase(Frame& F) {
    constexpr int AIMG = 0, GSTR = 2064, HIDO = 68224, HSTR = 528, OUTO = 85120, OSTR = 65;
    const int lane = F.lane, w = F.wave, r32 = lane & 31, hi = lane >> 5;
    for (int item = blockIdx.x; item < 256; item += F.G) {
        const int prob = item >> 4, mt = item & 15, kv = prob >> 3, b = (prob >> 1) & 3, g = prob & 1, n0 = 32 * mt;
        const bf16* raw = (const bf16*)(F.ws + WS_KV) + (size_t)kv * KV_TENS + (size_t)(b * 2 + g) * 8192 * 64;
        for (int idx = F.tid; idx < 33 * 128; idx += 512) { const int gl = idx >> 7, ch = idx & 127, gi = n0 + gl;
            v4u v = (v4u){0u, 0u, 0u, 0u}; if (gi < 512) v = *(const GAS v4u*)(raw + (size_t)gi * 1024 + ch * 8);
            *(LAS v4u*)(F.lds + AIMG + gl * GSTR + ch * 16) = v; }
        __syncthreads();
        const bf16* W1t = (const bf16*)(F.ws + (kv ? WS_CW1V : WS_CW1K));
        const bf16* bp = W1t + (size_t)(32 * w + r32) * 2048 + 8 * hi;
        const LAS unsigned char* ap = F.lds + AIMG + r32 * GSTR + hi * 16;
        f32x16 acc = {};
#pragma unroll 1
        for (int s0 = 0; s0 < 128; s0 += 8) {
            bf16x8 bfr[8];
#pragma unroll
            for (int j = 0; j < 8; ++j) bfr[j] = *(const GAS bf16x8*)(bp + 16 * (s0 + j));
            const LAS unsigned char* aq = ap + (s0 >= 64 ? GSTR + (s0 - 64) * 32 : s0 * 32);
#pragma unroll
            for (int j = 0; j < 8; ++j) { const bf16x8 af = *(const LAS bf16x8*)(aq + j * 32); acc = __builtin_amdgcn_mfma_f32_32x32x16_bf16(af, bfr[j], acc, 0, 0, 0); }
        }
        { const float* pp = (const float*)(F.ws + WS_PEP) + kv * 16 * 256 + 32 * w + r32; float pb = 0.f;
#pragma unroll
          for (int kc = 0; kc < 16; ++kc) pb += pp[kc * 256];
#pragma unroll
          for (int i = 0; i < 16; ++i) { const int row = (i & 3) + 8 * (i >> 2) + 4 * hi; const float h = gelu_tanh(acc[i] + pb);
              *(LAS unsigned short*)(F.lds + HIDO + row * HSTR + (32 * w + r32) * 2) = (unsigned short)f2bf(h); } }
        __syncthreads();
        if (w < 2) {
            const bf16* W2t = (const bf16*)(F.ws + (kv ? WS_CW2V : WS_CW2K));
            const bf16* bp2 = W2t + (size_t)(32 * w + r32) * 256 + 8 * hi;
            const LAS unsigned char* ap2 = F.lds + HIDO + r32 * HSTR + hi * 16;
            f32x16 a2 = {};
#pragma unroll
            for (int s = 0; s < 16; ++s) { const bf16x8 bf_ = *(const GAS bf16x8*)(bp2 + 16 * s); const bf16x8 af = *(const LAS bf16x8*)(ap2 + s * 32); a2 = __builtin_amdgcn_mfma_f32_32x32x16_bf16(af, bf_, a2, 0, 0, 0); }
#pragma unroll
            for (int i = 0; i < 16; ++i) { const int row = (i & 3) + 8 * (i >> 2) + 4 * hi; *(LAS float*)(F.lds + OUTO + (row * OSTR + 32 * w + r32) * 4) = a2[i]; }
        }
        __syncthreads();
        { const int row = F.tid >> 4, c4 = (F.tid & 15) * 4; const LAS float* op = (const LAS float*)(F.lds + OUTO) + row * OSTR + c4;
          float v0 = op[0], v1 = op[1], v2 = op[2], v3 = op[3];
          if (kv == 0) { float ss = (v0 * v0 + v1 * v1) + (v2 * v2 + v3 * v3); ss += __shfl_xor(ss, 1); ss += __shfl_xor(ss, 2); ss += __shfl_xor(ss, 4); ss += __shfl_xor(ss, 8);
              const float rs = 1.0f / sqrtf(ss * (1.0f / 64.0f) + 1e-6f); const f32x4 kn = *(const f32x4*)(F.in[4] + c4); v0 *= rs * kn[0]; v1 *= rs * kn[1]; v2 *= rs * kn[2]; v3 *= rs * kn[3]; }
          const int n = n0 + row; if (n >= NCMP) { v0 = v1 = v2 = v3 = 0.f; }
          bf16* dst = (bf16*)(F.ws + (kv ? WS_VC : WS_KC)) + ((size_t)(b * 2 + g) * 512 + n) * 64 + c4;
          *(GAS unsigned long long*)dst = (unsigned long long)pk2(v0, v1) | ((unsigned long long)pk2(v2, v3) << 32); }
        __syncthreads();
    }
}

namespace att {
constexpr int BUF0 = 0, BUF1 = 16384;
constexpr int L_IMP = 32768, IMP_STR = 132;
constexpr int L_OACC = 32768;
constexpr int L_BTAB = L_OACC + 65536;
constexpr int NBT = 800;
constexpr int L_WSF = L_BTAB + 4 * NBT * 4;
constexpr int L_SELM = L_WSF + 2048;
constexpr int L_UNI = L_SELM + 1024;
constexpr int L_END = L_UNI + 128;
static_assert(L_END <= RING_BYTES, "attention LDS map");
constexpr float NEG_INF = -INFINITY;
constexpr float THR = 8.0f;

__device__ __forceinline__ int t5_bucket(int n) {
    if (n < 16) return n;
    int b = 16;
    b += (n >= 21); b += (n >= 27); b += (n >= 35); b += (n >= 46); b += (n >= 59); b += (n >= 77); b += (n >= 99); b += (n >= 128);
    b += (n >= 166); b += (n >= 216); b += (n >= 280); b += (n >= 363); b += (n >= 470); b += (n >= 609); b += (n >= 790);
    return b;
}
__device__ __forceinline__ s16x4 vtr(const LAS unsigned char* p) { typedef short v4i16_t __attribute__((ext_vector_type(4))); return __builtin_bit_cast(s16x4, __builtin_amdgcn_ds_read_tr16_b64_v4i16((LAS v4i16_t*)p)); }
__device__ __forceinline__ unsigned cvtpk(float lo, float hi) { typedef float f2 __attribute__((ext_vector_type(2))); typedef __bf16 b2 __attribute__((ext_vector_type(2))); f2 v = {lo, hi}; b2 b = __builtin_convertvector(v, b2); return __builtin_bit_cast(unsigned, b); }
__device__ __forceinline__ float xhalf(float v) { return __shfl_xor(v, 32); }

struct TileRegs { v4u k, v; };
__device__ __forceinline__ void tile_issue(TileRegs& R, const bf16* Kt, const bf16* Vt, bool hasV, int w, int lane) {
    R.k = *(const GAS v4u*)(Kt + lane * 64 + w * 8);
    if (hasV) R.v = *(const GAS v4u*)(Vt + (16 * (w & 3) + (lane >> 2)) * 64 + (w >> 2) * 32 + (lane & 3) * 8);
}
__device__ __forceinline__ void tile_commit(const TileRegs& R, LAS unsigned char* buf, bool hasV, int tid) {
    *(LAS v4u*)(buf + tid * 16) = R.k;
    if (hasV) *(LAS v4u*)(buf + 8192 + tid * 16) = R.v;
}
__device__ __forceinline__ void qk_tile(const LAS unsigned char* buf, const bf16x8 (&qf)[4], float cinit, f32x16& p0, f32x16& p1, int r32, int hi) {
    const LAS unsigned char* kp = buf + hi * 1024 + r32 * 16;
#pragma unroll
    for (int i = 0; i < 16; ++i) { p0[i] = cinit; p1[i] = cinit; }
#pragma unroll
    for (int s = 0; s < 4; ++s) {
        const bf16x8 k0 = *(const LAS bf16x8*)(kp + s * 2048), k1 = *(const LAS bf16x8*)(kp + s * 2048 + 512);
        p0 = __builtin_amdgcn_mfma_f32_32x32x16_bf16(k0, qf[s], p0, 0, 0, 0);
        p1 = __builtin_amdgcn_mfma_f32_32x32x16_bf16(k1, qf[s], p1, 0, 0, 0);
    }
}
template <int KSTEP>
__device__ __forceinline__ void bias_mask(f32x16& p0, f32x16& p1, const LAS float* bt, int dbase, int wlim, int hi) {
#pragma unroll
    for (int i = 0; i < 16; ++i) {
        const int kl = (i & 3) + 8 * (i >> 2) + 4 * hi;
        const int d0 = dbase - KSTEP * kl, d1 = d0 - KSTEP * 32;
        const int i0 = min(max(d0, 0), NBT - 1), i1 = min(max(d1, 0), NBT - 1);
        const float b0 = bt[i0], b1 = bt[i1];
        p0[i] = (d0 >= 0 && d0 < wlim) ? p0[i] + b0 : NEG_INF;
        p1[i] = (d1 >= 0 && d1 < wlim) ? p1[i] + b1 : NEG_INF;
    }
}
__device__ __forceinline__ float rowmax32(const f32x16& p0, const f32x16& p1) {
    float a = fmaxf(p0[0], p1[0]);
#pragma unroll
    for (int i = 1; i < 16; ++i) a = fmaxf(a, fmaxf(p0[i], p1[i]));
    return fmaxf(a, xhalf(a));
}
__device__ __forceinline__ void pv_tile(const LAS unsigned char* buf, const f32x16& p0, const f32x16& p1, f32x16 (&o)[2], int lane, int hi) {
    bf16x8 pa[4];
#pragma unroll
    for (int s = 0; s < 2; ++s) {
        v4u a, c;
        a.x = cvtpk(p0[8 * s + 0], p0[8 * s + 1]); a.y = cvtpk(p0[8 * s + 2], p0[8 * s + 3]); a.z = cvtpk(p0[8 * s + 4], p0[8 * s + 5]); a.w = cvtpk(p0[8 * s + 6], p0[8 * s + 7]);
        c.x = cvtpk(p1[8 * s + 0], p1[8 * s + 1]); c.y = cvtpk(p1[8 * s + 2], p1[8 * s + 3]); c.z = cvtpk(p1[8 * s + 4], p1[8 * s + 5]); c.w = cvtpk(p1[8 * s + 6], p1[8 * s + 7]);
        pa[s] = __builtin_bit_cast(bf16x8, a); pa[2 + s] = __builtin_bit_cast(bf16x8, c);
    }
    const LAS unsigned char* vp = buf + 8192 + ((lane >> 4) & 1) * 32 + (lane & 3) * 8 + (4 * hi + ((lane & 15) >> 2)) * 64;
#pragma unroll
    for (int d0 = 0; d0 < 2; ++d0)
#pragma unroll
        for (int ks = 0; ks < 4; ++ks) {
            const s16x4 lo = vtr(vp + d0 * 4096 + ks * 1024), hh = vtr(vp + d0 * 4096 + ks * 1024 + 512);
            const bf16x8 vf = (bf16x8){lo[0], lo[1], lo[2], lo[3], hh[0], hh[1], hh[2], hh[3]};
            o[d0] = __builtin_amdgcn_mfma_f32_32x32x16_bf16(pa[ks], vf, o[d0], 0, 0, 0);
        }
}
__device__ __forceinline__ void row_to_regs(LAS float* wsf, float v, float (&f)[16], int r32, int hi) {
    if (hi == 0) wsf[r32] = v;
#pragma unroll
    for (int u = 0; u < 4; ++u) { const f32x4 t = *(const LAS f32x4*)(wsf + 8 * u + 4 * hi); f[4 * u] = t[0]; f[4 * u + 1] = t[1]; f[4 * u + 2] = t[2]; f[4 * u + 3] = t[3]; }
}
__device__ __forceinline__ void softmax_pv(const LAS unsigned char* buf, f32x16& p0, f32x16& p1, float& m, float& l, f32x16 (&o)[2], LAS float* wsf, int lane, int r32, int hi) {
    const float mx = rowmax32(p0, p1);
    if (__any(mx > m + THR)) {
        const float mn = fmaxf(m, mx); const float alpha = __builtin_amdgcn_exp2f(m - mn); l *= alpha; m = mn;
        float f[16]; row_to_regs(wsf, alpha, f, r32, hi);
#pragma unroll
        for (int i = 0; i < 16; ++i) { o[0][i] *= f[i]; o[1][i] *= f[i]; }
    }
    float s = 0.f;
#pragma unroll
    for (int i = 0; i < 16; ++i) { p0[i] = __builtin_amdgcn_exp2f(p0[i] - m); p1[i] = __builtin_amdgcn_exp2f(p1[i] - m); s += p0[i] + p1[i]; }
    l += s;
    pv_tile(buf, p0, p1, o, lane, hi);
}

__device__ __forceinline__ void attn_item(Frame& F, int b, int g, int qb) {
    const int tid = F.tid, lane = F.lane, w = F.wave, r32 = lane & 31, hi = lane >> 5, qi = r32 >> 2, r = r32 & 3;
    const int t0 = qb * 64, tl = 8 * w + qi, tpos = t0 + tl;
    LAS unsigned char* lds = F.lds;
    LAS float* imp = (LAS float*)(lds + L_IMP);
    LAS float* btab = (LAS float*)(lds + L_BTAB);
    LAS float* wsf = (LAS float*)(lds + L_WSF) + w * 64;
    LAS unsigned* selm = (LAS unsigned*)(lds + L_SELM);
    LAS unsigned* uni = (LAS unsigned*)(lds + L_UNI);
    const bf16* KVb = (const bf16*)(F.ws + WS_KV);
    const size_t bgoff = (size_t)(b * 2 + g) * 8192 * 64;
    const bf16* ksb = KVb + 2 * KV_TENS + bgoff; const bf16* vsb = KVb + 3 * KV_TENS + bgoff;
    const bf16* kwb = KVb + 4 * KV_TENS + bgoff; const bf16* vwb = KVb + 5 * KV_TENS + bgoff;
    const bf16* kcb = (const bf16*)(F.ws + WS_KC) + (size_t)(b * 2 + g) * 512 * 64;
    const bf16* vcb = (const bf16*)(F.ws + WS_VC) + (size_t)(b * 2 + g) * 512 * 64;
    { const float* rb = F.in[11];
      for (int i = tid; i < 4 * NBT; i += 512) { const int rr = i / NBT, d = i - rr * NBT; btab[i] = rb[t5_bucket(d) * 8 + 4 * g + rr] * LOG2E; } }
    for (int i = lane; i < 8 * IMP_STR; i += 64) imp[8 * w * IMP_STR + i] = 0.f;
    bf16x8 qf[4];
    { const bf16* Qp = (const bf16*)(F.ws + WS_Q) + ((size_t)(b * 8192 + tpos) * 512 + (4 * g + r) * 64 + 8 * hi);
#pragma unroll
      for (int s = 0; s < 4; ++s) qf[s] = *(const GAS bf16x8*)(Qp + 16 * s); }
    float gate[3];
    { const float* gp = (const float*)(F.ws + WS_G) + (size_t)(b * 8192 + tpos) * 32 + (4 * g + r) * 3; gate[0] = gp[0]; gate[1] = gp[1]; gate[2] = gp[2]; }
    const float bfar = F.in[11][31 * 8 + 4 * g + r] * LOG2E;
    const LAS float* bt = btab + r * NBT;
    LAS float* oaccp = (LAS float*)(lds + L_OACC) + w * 2048 + lane;
    __syncthreads();

    TileRegs R;
    const int nct = (4 * qb + 3 + 63) >> 6;
    const int dcb = tpos - 31;
    float mc = -1e30f, lc = 0.f;
    tile_issue(R, kcb, vcb, false, w, lane); tile_commit(R, lds + BUF0, false, tid); __syncthreads();
    for (int c = 0; c < nct; ++c) {
        LAS unsigned char* cur = lds + ((c & 1) ? BUF1 : BUF0); LAS unsigned char* nxt = lds + ((c & 1) ? BUF0 : BUF1);
        if (c + 1 < nct) tile_issue(R, kcb + (size_t)(c + 1) * 64 * 64, vcb, false, w, lane);
        f32x16 p0, p1; qk_tile(cur, qf, 0.f, p0, p1, r32, hi);
        bias_mask<16>(p0, p1, bt, dcb - 1024 * c, 1 << 30, hi);
        const float mx = rowmax32(p0, p1); const float mn = fmaxf(mc, mx);
        float s = 0.f;
#pragma unroll
        for (int i = 0; i < 16; ++i) s += __builtin_amdgcn_exp2f(p0[i] - mn) + __builtin_amdgcn_exp2f(p1[i] - mn);
        lc = lc * __builtin_amdgcn_exp2f(mc - mn) + s; mc = mn;
        if (c + 1 < nct) tile_commit(R, nxt, false, tid);
        __syncthreads();
    }
    lc += xhalf(lc);
    const float ilc = lc > 0.f ? 1.0f / lc : 0.f;
    f32x16 oc[2]; oc[0] = f32x16{}; oc[1] = f32x16{};
    {
        tile_issue(R, kcb, vcb, true, w, lane); tile_commit(R, lds + BUF0, true, tid); __syncthreads();
        for (int c = 0; c < nct; ++c) {
            LAS unsigned char* cur = lds + ((c & 1) ? BUF1 : BUF0); LAS unsigned char* nxt = lds + ((c & 1) ? BUF0 : BUF1);
            if (c + 1 < nct) tile_issue(R, kcb + (size_t)(c + 1) * 64 * 64, vcb + (size_t)(c + 1) * 64 * 64, true, w, lane);
            f32x16 p0, p1; qk_tile(cur, qf, 0.f, p0, p1, r32, hi);
            bias_mask<16>(p0, p1, bt, dcb - 1024 * c, 1 << 30, hi);
#pragma unroll
            for (int i = 0; i < 16; ++i) { p0[i] = __builtin_amdgcn_exp2f(p0[i] - mc) * ilc; p1[i] = __builtin_amdgcn_exp2f(p1[i] - mc) * ilc; }
#pragma unroll
            for (int a = 0; a < 2; ++a)
#pragma unroll
                for (int u = 0; u < 4; ++u) {
                    const float x0 = a ? p1[4 * u] : p0[4 * u], x1 = a ? p1[4 * u + 1] : p0[4 * u + 1], x2 = a ? p1[4 * u + 2] : p0[4 * u + 2], x3 = a ? p1[4 * u + 3] : p0[4 * u + 3];
                    float mainv = (x0 + x1) + (x2 + 0.5f * x3), spill = 0.5f * x3;
                    mainv += __shfl_xor(mainv, 1); mainv += __shfl_xor(mainv, 2); spill += __shfl_xor(spill, 1); spill += __shfl_xor(spill, 2);
                    const int j = 16 * c + 8 * a + 2 * u + hi;
                    if (r == 0) { (void)__hip_atomic_fetch_add(&imp[(8 * w + qi) * IMP_STR + j], mainv, __ATOMIC_RELAXED, __HIP_MEMORY_SCOPE_WORKGROUP); if (j + 1 < 128) (void)__hip_atomic_fetch_add(&imp[(8 * w + qi) * IMP_STR + j + 1], spill, __ATOMIC_RELAXED, __HIP_MEMORY_SCOPE_WORKGROUP); }
                }
            pv_tile(cur, p0, p1, oc, lane, hi);
            if (c + 1 < nct) tile_commit(R, nxt, true, tid);
            __syncthreads();
        }
    }
    unsigned wu0 = 0u, wu1 = 0u, wu2 = 0u, wu3 = 0u;
    for (int qq = 0; qq < 8; ++qq) {
        const int q = 8 * w + qq;
        const float v0 = imp[q * IMP_STR + lane], v1 = imp[q * IMP_STR + 64 + lane];
        const int j0 = lane, j1 = 64 + lane;
        const bool val0 = j0 <= qb, val1 = j1 <= qb;
        const bool fo0 = (j0 == 0) || (j0 == qb) || (j0 == qb - 1), fo1 = (j1 == qb) || (j1 == qb - 1);
        const unsigned k0 = !val0 ? 0u : (fo0 ? 0x7f000000u : __float_as_uint(v0) + 1u);
        const unsigned k1 = !val1 ? 0u : (fo1 ? 0x7f000000u : __float_as_uint(v1) + 1u);
        unsigned Tt = 0u;
        for (int bit = 30; bit >= 0; --bit) {
            const unsigned cand = Tt | (1u << bit);
            const int cnt = __popcll(__ballot(k0 >= cand)) + __popcll(__ballot(k1 >= cand));
            if (cnt >= 16) Tt = cand;
        }
        const bool gt0 = k0 > Tt, gt1 = k1 > Tt, eq0 = k0 == Tt, eq1 = k1 == Tt;
        const unsigned long long e0 = __ballot(eq0), e1 = __ballot(eq1);
        const int ngt = __popcll(__ballot(gt0)) + __popcll(__ballot(gt1)); const int need = 16 - ngt;
        const unsigned long long below = (1ull << lane) - 1ull;
        const int pre0 = __popcll(e0 & below), pre1 = __popcll(e0) + __popcll(e1 & below);
        const bool s0 = val0 && (gt0 || (eq0 && pre0 < need)), s1 = val1 && (gt1 || (eq1 && pre1 < need));
        const unsigned long long m0 = __ballot(s0), m1 = __ballot(s1);
        const unsigned a0 = (unsigned)m0, a1 = (unsigned)(m0 >> 32), a2 = (unsigned)m1, a3 = (unsigned)(m1 >> 32);
        if (lane == 0) { selm[q * 4 + 0] = a0; selm[q * 4 + 1] = a1; selm[q * 4 + 2] = a2; selm[q * 4 + 3] = a3; }
        wu0 |= a0; wu1 |= a1; wu2 |= a2; wu3 |= a3;
    }
    if (lane == 0) { uni[w * 4 + 0] = wu0; uni[w * 4 + 1] = wu1; uni[w * 4 + 2] = wu2; uni[w * 4 + 3] = wu3; }
    __syncthreads();
    { float f[16]; row_to_regs(wsf, gate[0], f, r32, hi);
#pragma unroll
      for (int i = 0; i < 16; ++i) { oaccp[i * 64] = oc[0][i] * f[i]; oaccp[(16 + i) * 64] = oc[1][i] * f[i]; } }
    unsigned mym[4], bu[4] = {0u, 0u, 0u, 0u};
#pragma unroll
    for (int k = 0; k < 4; ++k) { mym[k] = selm[(8 * w + qi) * 4 + k];
#pragma unroll
        for (int ww = 0; ww < 8; ++ww) bu[k] |= uni[ww * 4 + k]; }
    unsigned wuv[4] = {wu0, wu1, wu2, wu3};
#pragma unroll
    for (int k = 0; k < 4; ++k) { bu[k] = __builtin_amdgcn_readfirstlane(bu[k]); wuv[k] = __builtin_amdgcn_readfirstlane(wuv[k]); }
    {
        f32x16 o[2]; o[0] = f32x16{}; o[1] = f32x16{}; float ms = -1e30f, ls = 0.f;
        int cur_j = -1;
        for (int j = 0; j <= qb; ++j) if ((bu[j >> 5] >> (j & 31)) & 1u) { cur_j = j; break; }
        int par = 0;
        if (cur_j >= 0) { tile_issue(R, ksb + (size_t)cur_j * 4096, vsb + (size_t)cur_j * 4096, true, w, lane); tile_commit(R, lds + BUF0, true, tid); }
        __syncthreads();
        while (cur_j >= 0) {
            int nxt_j = -1;
            for (int j = cur_j + 1; j <= qb; ++j) if ((bu[j >> 5] >> (j & 31)) & 1u) { nxt_j = j; break; }
            LAS unsigned char* cur = lds + (par ? BUF1 : BUF0); LAS unsigned char* nxt = lds + (par ? BUF0 : BUF1);
            if (nxt_j >= 0) tile_issue(R, ksb + (size_t)nxt_j * 4096, vsb + (size_t)nxt_j * 4096, true, w, lane);
            if ((wuv[cur_j >> 5] >> (cur_j & 31)) & 1u) {
                const bool mine = (mym[cur_j >> 5] >> (cur_j & 31)) & 1u;
                f32x16 p0, p1;
                if (qb - cur_j >= 14) { qk_tile(cur, qf, mine ? bfar : NEG_INF, p0, p1, r32, hi); }
                else { qk_tile(cur, qf, mine ? 0.f : NEG_INF, p0, p1, r32, hi); bias_mask<1>(p0, p1, bt, tpos - 64 * cur_j, 1 << 30, hi); }
                softmax_pv(cur, p0, p1, ms, ls, o, wsf, lane, r32, hi);
            }
            if (nxt_j >= 0) tile_commit(R, nxt, true, tid);
            __syncthreads();
            cur_j = nxt_j; par ^= 1;
        }
        ls += xhalf(ls);
        float f[16]; row_to_regs(wsf, ls > 0.f ? gate[1] / ls : 0.f, f, r32, hi);
#pragma unroll
        for (int i = 0; i < 16; ++i) { oaccp[i * 64] += o[0][i] * f[i]; oaccp[(16 + i) * 64] += o[1][i] * f[i]; }
    }
    {
        f32x16 o[2]; o[0] = f32x16{}; o[1] = f32x16{}; float mw = -1e30f, lw = 0.f;
        const int j0 = qb >= 8 ? qb - 8 : 0;
        tile_issue(R, kwb + (size_t)j0 * 4096, vwb + (size_t)j0 * 4096, true, w, lane); tile_commit(R, lds + BUF0, true, tid); __syncthreads();
        for (int j = j0; j <= qb; ++j) {
            const int par = (j - j0) & 1;
            LAS unsigned char* cur = lds + (par ? BUF1 : BUF0); LAS unsigned char* nxt = lds + (par ? BUF0 : BUF1);
            if (j < qb) tile_issue(R, kwb + (size_t)(j + 1) * 4096, vwb + (size_t)(j + 1) * 4096, true, w, lane);
            f32x16 p0, p1; qk_tile(cur, qf, 0.f, p0, p1, r32, hi);
            bias_mask<1>(p0, p1, bt, tpos - 64 * j, 512, hi);
            softmax_pv(cur, p0, p1, mw, lw, o, wsf, lane, r32, hi);
            if (j < qb) tile_commit(R, nxt, true, tid);
            __syncthreads();
        }
        lw += xhalf(lw);
        float f[16]; row_to_regs(wsf, lw > 0.f ? gate[2] / lw : 0.f, f, r32, hi);
#pragma unroll
        for (int i = 0; i < 16; ++i) { o[0][i] = oaccp[i * 64] + o[0][i] * f[i]; o[1][i] = oaccp[(16 + i) * 64] + o[1][i] * f[i]; }
        asm volatile("" ::: "memory");
        LAS unsigned short* stg = (LAS unsigned short*)(lds + L_OACC + w * 8192);
#pragma unroll
        for (int i = 0; i < 16; ++i) { const int orow = (i & 3) + 8 * (i >> 2) + 4 * hi;
            stg[orow * 64 + r32] = (unsigned short)f2bf(o[0][i]); stg[orow * 64 + 32 + r32] = (unsigned short)f2bf(o[1][i]); }
        LDS_WAIT();
        bf16* MIX = (bf16*)(F.ws + WS_MIX);
#pragma unroll
        for (int i = 0; i < 4; ++i) { const int row = i * 8 + (lane >> 3), ch = lane & 7; const v4u v = *(const LAS v4u*)(stg + row * 64 + ch * 8);
            *(GAS v4u*)(MIX + (size_t)(b * 8192 + t0 + 8 * w + (row >> 2)) * 1024 + (4 * g + (row & 3)) * 64 + ch * 8) = v; }
    }
    __syncthreads();
}
}

__device__ __forceinline__ void p4_phase(Frame& F) {
    {
        const bf16* Z = (const bf16*)(F.ws + WS_Z); const bf16* BG = (const bf16*)(F.ws + WS_BG); bf16* MIX = (bf16*)(F.ws + WS_MIX);
        const float* cw = F.in[12];
        const int ch = F.tid & 63, rsub = F.tid >> 6;
        f32x4 w0a = *(const f32x4*)(cw + 8 * ch), w0b = *(const f32x4*)(cw + 8 * ch + 4), w1a = *(const f32x4*)(cw + 512 + 8 * ch), w1b = *(const f32x4*)(cw + 512 + 8 * ch + 4), w2a = *(const f32x4*)(cw + 1024 + 8 * ch), w2b = *(const f32x4*)(cw + 1024 + 8 * ch + 4);
        for (int rb = blockIdx.x; rb < M / 8; rb += F.G) {
            const int row = 8 * rb + rsub, t = row & 8191;
            const v4u z2 = *(const GAS v4u*)(Z + (size_t)row * 512 + 8 * ch);
            v4u z1 = (v4u){0u, 0u, 0u, 0u}, z0 = (v4u){0u, 0u, 0u, 0u};
            if (t >= 1) z1 = *(const GAS v4u*)(Z + (size_t)(row - 1) * 512 + 8 * ch);
            if (t >= 2) z0 = *(const GAS v4u*)(Z + (size_t)(row - 2) * 512 + 8 * ch);
            const v4u bg = *(const GAS v4u*)(BG + (size_t)row * 512 + 8 * ch);
            float o[8];
#define CV(k, comp, sh, wa, wi) o[k] = bf2f((unsigned short)((bg.comp >> sh) & 0xffff)) * (w0##wa[wi] * bf2f((unsigned short)((z0.comp >> sh) & 0xffff)) + w1##wa[wi] * bf2f((unsigned short)((z1.comp >> sh) & 0xffff)) + w2##wa[wi] * bf2f((unsigned short)((z2.comp >> sh) & 0xffff)))
            CV(0, x, 0, a, 0); CV(1, x, 16, a, 1); CV(2, y, 0, a, 2); CV(3, y, 16, a, 3); CV(4, z, 0, b, 0); CV(5, z, 16, b, 1); CV(6, w, 0, b, 2); CV(7, w, 16, b, 3);
#undef CV
            v4u ov; ov.x = pk2(o[0], o[1]); ov.y = pk2(o[2], o[3]); ov.z = pk2(o[4], o[5]); ov.w = pk2(o[6], o[7]);
            *(GAS v4u*)(MIX + (size_t)row * 1024 + 512 + 8 * ch) = ov;
        }
    }
    for (int rd = 0; rd * F.G < 1024; ++rd) {
        const int pos = (rd & 1) ? (F.G - 1 - (int)blockIdx.x) : (int)blockIdx.x;
        const int k = rd * F.G + pos; if (k >= 1024) continue;
        const int qb = 127 - (k >> 3), bg = k & 7;
        att::attn_item(F, bg >> 1, bg & 1, qb);
    }
}

struct Args { const float* in[20]; float* out; unsigned char* ws; int ph_lo, ph_hi; };
__global__ void __launch_bounds__(NWAVES * 64, 2) mk_fwd(Args args) {
    extern __shared__ __attribute__((aligned(16))) unsigned char lds[];
    Frame F;
    F.lds = (LAS unsigned char*)lds;
    F.MISC = (volatile LAS unsigned*)(F.lds + MISC_OFF);
    F.tid = threadIdx.x; F.lane = F.tid & 63; F.wave = __builtin_amdgcn_readfirstlane(F.tid >> 6);
    F.G = gridDim.x; { const int bx = blockIdx.x; F.vcu = (F.G % 8 == 0) ? (bx % 8) * (F.G / 8) + bx / 8 : bx; }
    F.ws = args.ws; F.out = args.out; F.ctl = (gu32*)(args.ws + WS_CTL);
#pragma unroll
    for (int i = 0; i < 20; ++i) F.in[i] = args.in[i];
    for (int u = F.tid; u < (LDS_BYTES - LDSCTL_OFF) / 4; u += NWAVES * 64) ((LAS unsigned*)(F.lds + LDSCTL_OFF))[u] = 0u;
    __syncthreads();
    const int lo = args.ph_lo, hi = args.ph_hi;
    const bool one = (hi - lo) > 1;
    XcdBarrier bar; bar.bar = (unsigned*)(F.ctl + CW_BAR); bar.x = 0; bar.st = nullptr;
    if (one) bar = xcd_barrier_post((unsigned*)(F.ctl + CW_BAR), F.MISC + 8);
#ifdef ONLY_PHASE
#define IN(k) ((k) == ONLY_PHASE && lo <= (k) && (k) < hi)
#else
#define IN(k) (lo <= (k) && (k) < hi)
#endif
#define SEAM(k) do { if (IN(k) && IN((k) + 1)) xcd_barrier(bar); } while (0)
    unsigned char* ws = args.ws;
    if (IN(0)) { p0_phase(F); SEAM(0); }
    if (IN(1)) { p1_phase(F); SEAM(1); }
    if (IN(2)) {
        pg8::Gemm g{(const pg8::bf16_t*)(ws + WS_H), (const pg8::bf16_t*)(ws + WS_WIN), M, NIN, D}; pg8::StaticOrder S; S.init(M, NIN, F.G, (int)blockIdx.x);
        pg8::EpiInProj E{(pg8::bf16_t*)(ws + WS_Q), (pg8::bf16_t*)(ws + WS_KV), (pg8::bf16_t*)(ws + WS_Z), (pg8::bf16_t*)(ws + WS_BG), (float*)(ws + WS_G), F.in[3], F.in[4]};
        pg8::gemm_phase<pg8::EpiInProj, pg8::StaticOrder, true, true>(F.lds, g, S, E);
        SEAM(2);
    }
    if (IN(3)) { p3_phase(F); SEAM(3); }
    if (IN(4)) { p4_phase(F); SEAM(4); }
    if (IN(5)) {
        pg8::Gemm g{(const pg8::bf16_t*)(ws + WS_MIX), (const pg8::bf16_t*)(ws + WS_WOUT), M, D, D}; pg8::StaticOrder S; S.init(M, D, F.G, (int)blockIdx.x);
        pg8::EpiOutProj E{F.in[0], F.out, (pg8::bf16_t*)(ws + WS_A2), (float*)(ws + WS_RSS), (const float*)(ws + WS_MOD), F.in[15]};
        pg8::gemm_phase<pg8::EpiOutProj, pg8::StaticOrder, true, true>(F.lds, g, S, E);
        SEAM(5);
    }
    if (IN(6)) {
        pg8::Gemm g{(const pg8::bf16_t*)(ws + WS_A2), (const pg8::bf16_t*)(ws + WS_W1), M, FF, D}; pg8::StaticOrder S; S.init(M, FF, F.G, (int)blockIdx.x);
        pg8::EpiFF1 E{(pg8::bf16_t*)(ws + WS_HID), (const float*)(ws + WS_RSS), (const float*)(ws + WS_BFF1)};
        pg8::gemm_phase<pg8::EpiFF1, pg8::StaticOrder, true, true>(F.lds, g, S, E);
        SEAM(6);
    }
    if (IN(7)) {
        pg8::Gemm g{(const pg8::bf16_t*)(ws + WS_HID), (const pg8::bf16_t*)(ws + WS_W2), M, D, FF}; pg8::StaticOrder S; S.init(M, D, F.G, (int)blockIdx.x);
        pg8::EpiFF2 E{F.out, (const float*)(ws + WS_MOD)};
        pg8::gemm_phase<pg8::EpiFF2, pg8::StaticOrder, true, true>(F.lds, g, S, E);
    }
#undef IN
#undef SEAM
}

extern "C" void kernel_launch(void* const* d_in, const int* in_sizes, int n_in, void* d_out, int out_size, void* d_ws, size_t ws_size, hipStream_t stream) {
    static int grid = 0;
    if (grid == 0) {
        if (n_in != 20 || in_sizes[0] != M * D || out_size != M * D || ws_size < WS_END) { fprintf(stderr, "kernel_launch: unexpected problem shape (n_in %d, in0 %d, out %d, ws %zu)\n", n_in, n_in > 0 ? in_sizes[0] : -1, out_size, ws_size); grid = -1; return; }
        int dev = 0, cus = 0, per_cu = 0;
        if (hipGetDevice(&dev) != hipSuccess || hipDeviceGetAttribute(&cus, hipDeviceAttributeMultiprocessorCount, dev) != hipSuccess) { grid = -1; return; }
        if (hipFuncSetAttribute((const void*)mk_fwd, hipFuncAttributeMaxDynamicSharedMemorySize, LDS_BYTES) != hipSuccess) { fprintf(stderr, "kernel_launch: hipFuncSetAttribute failed\n"); grid = -1; return; }
        if (hipOccupancyMaxActiveBlocksPerMultiprocessor(&per_cu, (const void*)mk_fwd, NWAVES * 64, LDS_BYTES) != hipSuccess || per_cu < 1) { fprintf(stderr, "kernel_launch: occupancy query says %d blocks per CU\n", per_cu); (void)hipGetLastError(); per_cu = 1; }
        grid = cus * 1;
        if (per_cu < 1) grid = -1;
    }
    if (grid < 0) return;
    (void)hipMemsetAsync((char*)d_ws + WS_CTL, 0, CTL_ZERO_BYTES, stream);
    Args a{};
    for (int i = 0; i < 20; ++i) a.in[i] = (const float*)d_in[i];
    a.out = (float*)d_out; a.ws = (unsigned char*)d_ws;
    if (MK_N_LAUNCHES == 1) {
        a.ph_lo = 0; a.ph_hi = N_PHASES;
        void* kargs[] = {&a};
        hipError_t e = hipLaunchCooperativeKernel((const void*)mk_fwd, dim3(grid), dim3(NWAVES * 64), kargs, LDS_BYTES, stream);
        if (e != hipSuccess) fprintf(stderr, "kernel_launch: cooperative launch failed: %s (grid %d)\n", hipGetErrorString(e), grid);
    } else {
        for (int p = 0; p < N_PHASES; ++p) { a.ph_lo = p; a.ph_hi = p + 1; hipLaunchKernelGGL(mk_fwd, dim3(grid), dim3(NWAVES * 64), LDS_BYTES, stream, a); }
    }
}
```

```cpp
#include <hip/hip_runtime.h>
#include <hip/hip_bf16.h>
#include <cstdio>
#include <cstdint>
#include <cmath>
namespace pg8 {
#define PG8_LAS __attribute__((address_space(3)))
typedef unsigned short bf16_t;
typedef short bf16x8 __attribute__((ext_vector_type(8)));
typedef float f32x4 __attribute__((ext_vector_type(4)));
typedef unsigned u32x4 __attribute__((ext_vector_type(4)));
constexpr int BM = 256, BK = 64, HALF = 128, HTB = HALF * BK * 2  , STAGE_BYTES = 8 * HTB, NXCD = 8, WGM = 8;

__host__ __device__ __forceinline__ int lds_byte(int r, int c) { const int st = (r >> 4) * 2 + (c >> 5), rr = r & 15, cc = c & 31, ob = rr * 64 + cc * 2; return st * 1024 + (ob ^ (((ob >> 9) & 1) << 5)); }
__host__ __device__ __forceinline__ void stage_rc(int b, int& R, int& C) { const int st = b / 1024, sb = b % 1024, swz = sb ^ (((sb >> 9) & 1) << 5); R = (st >> 1) * 16 + swz / 64; C = (st & 1) * 32 + (swz % 64) / 2; }
__host__ __device__ __forceinline__ int perm32(int rho) { const int n = rho >> 4, i = rho & 15; return 8 * (i >> 2) + 4 * n + (i & 3); }

struct Unit { int pm, pn; };
struct Gemm { const bf16_t* A; const bf16_t* Bt; int M, N, K; };

struct StaticOrder {
    int nM, nN, nwg, G, c;
    __host__ __device__ void init(int M, int N, int G_, int c_) { nM = M / BM; nN = N / BM; nwg = nM * nN; G = G_; c = c_; }
    __host__ __device__ bool next(int i, Unit& u) const {
        const long L = (long)i * G + c; if (L >= nwg) return false;
        int wgid = (int)L; { const int q = nwg / NXCD, r = nwg % NXCD, xcd = wgid % NXCD, off = wgid / NXCD; wgid = (xcd < r ? xcd * (q + 1) : r * (q + 1) + (xcd - r) * q) + off; }
        const int nig = WGM * nN, gid = wgid / nig, fm = gid * WGM, gsz = (nM - fm) < WGM ? (nM - fm) : WGM;
        u.pm = fm + ((wgid % nig) % gsz); u.pn = (wgid % nig) / gsz; return true;
    }
    __device__ __forceinline__ void a_ready(const Unit&) const {}
    __device__ __forceinline__ void done(const Unit&) const {}
};

__device__ __forceinline__ unsigned cvt_pk_bf16(float lo, float hi) { unsigned r; asm volatile("v_cvt_pk_bf16_f32 %0, %1, %2" : "=v"(r) : "v"(lo), "v"(hi)); return r; }
typedef float f32x2 __attribute__((ext_vector_type(2)));
template <class Epi, class Sched, bool ALIGN_EPI = false, bool SP2 = false>
__device__ __forceinline__ void gemm_phase(PG8_LAS unsigned char* lds, const Gemm g, const Sched& S, const Epi& E) {
    const int tid = threadIdx.x, wid = __builtin_amdgcn_readfirstlane(tid >> 6), lane = tid & 63, wr = wid >> 2, wc = wid & 3, fr = lane & 15, fq = lane >> 4;
    const int K = g.K, nt = K / BK;
    unsigned voffA[2], voffB[2];
#pragma unroll
    for (int i = 0; i < 2; ++i) { int R, C; stage_rc(tid * 16 + i * 8192, R, C); const int Rb = Epi::PERM ? ((R & ~31) + perm32(R & 31)) : R;
        voffA[i] = (unsigned)(R * K + C) * 2u; voffB[i] = (unsigned)(Rb * K + C) * 2u; }
    const size_t kstep = (size_t)(BK * 2);
    const size_t hstep = (size_t)HALF * K * 2;
    const size_t tstep = 2 * hstep;
    const unsigned ldsw = (unsigned)wid * 1024u;
    const int aoff = lds_byte(wr * 64 + fr, fq * 8), boff = lds_byte(wc * 32 + fr, fq * 8);
#define PG8_SA(b, h) (((b) * 2 + (h)) * HTB)
#define PG8_SB(b, h) ((4 + (b) * 2 + (h)) * HTB)
#define PG8_STAGE(bufoff, gbase, voff) do { _Pragma("unroll") for (int _i = 0; _i < 2; ++_i) \
        __builtin_amdgcn_global_load_lds((const unsigned*)((const char*)(gbase) + (voff)[_i]), (PG8_LAS unsigned*)(lds + (bufoff) + ldsw + _i * 8192), 16, 0, 0); } while (0)
#define PG8_LDA(dst, b, h) do { _Pragma("unroll") for (int m = 0; m < 4; ++m) _Pragma("unroll") for (int k = 0; k < 2; ++k) dst[m][k] = *(const PG8_LAS bf16x8*)(lds + PG8_SA(b, h) + aoff + m * 2048 + k * 1024); } while (0)
#define PG8_LDB(dst, b, h) do { _Pragma("unroll") for (int n = 0; n < 2; ++n) _Pragma("unroll") for (int k = 0; k < 2; ++k) dst[n][k] = *(const PG8_LAS bf16x8*)(lds + PG8_SB(b, h) + boff + n * 2048 + k * 1024); } while (0)
#define PG8_MMA(ai, bj, At, Bt) do { __builtin_amdgcn_s_setprio(1); _Pragma("unroll") for (int m = 0; m < 4; ++m) _Pragma("unroll") for (int n = 0; n < 2; ++n) _Pragma("unroll") for (int k = 0; k < 2; ++k) \
        acc[ai][bj][m][n] = __builtin_amdgcn_mfma_f32_16x16x32_bf16(Bt[n][k], At[m][k], acc[ai][bj][m][n], 0, 0, 0); __builtin_amdgcn_s_setprio(0); } while (0)
#define PG8_WAIT_V(n) asm volatile("s_waitcnt vmcnt(" #n ")" ::: "memory")
#define PG8_WAIT_L(n) asm volatile("s_waitcnt lgkmcnt(" #n ")" ::: "memory")
#define PG8_BAR __builtin_amdgcn_s_barrier()
#define PG8_SCHED __builtin_amdgcn_sched_barrier(0)
    Unit cur, nxt; int ui = 0;
    if (!S.next(0, cur)) return;
    f32x4 acc[2][2][4][2];
#pragma unroll
    for (int a = 0; a < 2; ++a)
#pragma unroll
        for (int b = 0; b < 2; ++b)
#pragma unroll
            for (int m = 0; m < 4; ++m)
#pragma unroll
                for (int n = 0; n < 2; ++n) acc[a][b][m][n] = (f32x4){0.f, 0.f, 0.f, 0.f};
    bf16x8 At[4][2], B0[2][2], B1[2][2];
    const char* cA = (const char*)g.A + (size_t)cur.pm * tstep; const char* cB = (const char*)g.Bt + (size_t)cur.pn * tstep;
    S.a_ready(cur);
    if constexpr (SP2) {
        PG8_STAGE(PG8_SB(0, 0), cB, voffB); PG8_STAGE(PG8_SB(0, 1), cB + hstep, voffB); PG8_STAGE(PG8_SA(0, 0), cA, voffA); PG8_STAGE(PG8_SA(0, 1), cA + hstep, voffA);
        if (wr == 1) PG8_BAR;
        PG8_WAIT_V(2); PG8_BAR;
        PG8_STAGE(PG8_SB(1, 0), cB + kstep, voffB); PG8_STAGE(PG8_SA(1, 0), cA + kstep, voffA); PG8_STAGE(PG8_SB(1, 1), cB + hstep + kstep, voffB);
        PG8_WAIT_V(6); PG8_BAR;
    } else {
        PG8_STAGE(PG8_SB(0, 0), cB, voffB); PG8_STAGE(PG8_SA(0, 0), cA, voffA); PG8_STAGE(PG8_SB(0, 1), cB + hstep, voffB); PG8_STAGE(PG8_SA(0, 1), cA + hstep, voffA);
        if (wr == 1) PG8_BAR;
        PG8_WAIT_V(4); PG8_BAR;
        PG8_STAGE(PG8_SB(1, 0), cB + kstep, voffB); PG8_STAGE(PG8_SA(1, 0), cA + kstep, voffA); PG8_STAGE(PG8_SB(1, 1), cB + hstep + kstep, voffB);
        PG8_WAIT_V(6); PG8_BAR;
    }
    for (;;) {
        const bool has_next = S.next(ui + 1, nxt);
        const char* nA = has_next ? (const char*)g.A + (size_t)nxt.pm * tstep : cA; const char* nB = has_next ? (const char*)g.Bt + (size_t)nxt.pn * tstep : cB;
        for (int t = 0; t < nt; t += 2) {
            const bool last = (t == nt - 2);
            const char* a1 = cA + (size_t)(t + 1) * kstep;
            const char* a2 = last ? nA : cA + (size_t)(t + 2) * kstep; const char* b2 = last ? nB : cB + (size_t)(t + 2) * kstep;
            const char* a3 = a2 + kstep; const char* b3 = b2 + kstep;
            if (last && has_next) S.a_ready(nxt);
            if constexpr (SP2) {
            PG8_LDB(B0, 0, 0); PG8_LDB(B1, 0, 1); PG8_SCHED; PG8_LDA(At, 0, 0); PG8_STAGE(PG8_SA(1, 1), a1 + hstep, voffA);
            PG8_WAIT_V(8); PG8_WAIT_L(0); PG8_BAR; PG8_MMA(0, 0, At, B0); PG8_MMA(0, 1, At, B1); PG8_BAR; PG8_SCHED;
            PG8_LDA(At, 0, 1); PG8_STAGE(PG8_SB(0, 0), b2, voffB); PG8_STAGE(PG8_SB(0, 1), b2 + hstep, voffB); PG8_STAGE(PG8_SA(0, 0), a2, voffA);
            PG8_WAIT_V(8); PG8_WAIT_L(0); PG8_BAR; PG8_MMA(1, 0, At, B0); PG8_MMA(1, 1, At, B1); PG8_BAR; PG8_SCHED;
            PG8_LDB(B0, 1, 0); PG8_LDB(B1, 1, 1); PG8_SCHED; PG8_LDA(At, 1, 0); PG8_STAGE(PG8_SA(0, 1), a2 + hstep, voffA);
            PG8_WAIT_V(8); PG8_WAIT_L(0); PG8_BAR; PG8_MMA(0, 0, At, B0); PG8_MMA(0, 1, At, B1); PG8_BAR; PG8_SCHED;
            PG8_LDA(At, 1, 1); PG8_STAGE(PG8_SB(1, 0), b3, voffB); PG8_STAGE(PG8_SB(1, 1), b3 + hstep, voffB); PG8_STAGE(PG8_SA(1, 0), a3, voffA);
            PG8_WAIT_V(8); PG8_WAIT_L(0); PG8_BAR; PG8_MMA(1, 0, At, B0); PG8_MMA(1, 1, At, B1); PG8_BAR; PG8_SCHED;
            } else {
            PG8_LDB(B0, 0, 0); PG8_SCHED; PG8_LDA(At, 0, 0); PG8_STAGE(PG8_SA(1, 1), a1 + hstep, voffA);
            PG8_WAIT_L(8); PG8_BAR; PG8_WAIT_L(0); PG8_MMA(0, 0, At, B0); PG8_BAR; PG8_SCHED;
            PG8_LDB(B1, 0, 1); PG8_STAGE(PG8_SB(0, 0), b2, voffB);
            PG8_BAR; PG8_WAIT_L(0); PG8_MMA(0, 1, At, B1); PG8_BAR;
            PG8_LDA(At, 0, 1); PG8_STAGE(PG8_SA(0, 0), a2, voffA);
            PG8_BAR; PG8_WAIT_L(0); PG8_MMA(1, 0, At, B0); PG8_BAR; PG8_SCHED;
            PG8_STAGE(PG8_SB(0, 1), b2 + hstep, voffB);
            PG8_WAIT_V(6); PG8_BAR; PG8_MMA(1, 1, At, B1); PG8_BAR;
            PG8_LDB(B0, 1, 0); PG8_SCHED; PG8_LDA(At, 1, 0); PG8_STAGE(PG8_SA(0, 1), a2 + hstep, voffA);
            PG8_WAIT_L(8); PG8_BAR; PG8_WAIT_L(0); PG8_MMA(0, 0, At, B0); PG8_BAR; PG8_SCHED;
            PG8_LDB(B1, 1, 1); PG8_STAGE(PG8_SB(1, 0), b3, voffB);
            PG8_BAR; PG8_WAIT_L(0); PG8_MMA(0, 1, At, B1); PG8_BAR;
            PG8_LDA(At, 1, 1); PG8_STAGE(PG8_SA(1, 0), a3, voffA);
            PG8_BAR; PG8_WAIT_L(0); PG8_MMA(1, 0, At, B0); PG8_BAR; PG8_SCHED;
            PG8_STAGE(PG8_SB(1, 1), b3 + hstep, voffB);
            PG8_WAIT_V(6); PG8_BAR; PG8_MMA(1, 1, At, B1); PG8_BAR;
            }
        }
        if constexpr (ALIGN_EPI) { if (wr == 0) PG8_BAR; }
        if constexpr (!Epi::AFTER_DRAIN) { E(acc, cur, wr, wc, fr, fq); S.done(cur); }
        if (!has_next) break;
#pragma unroll
        for (int a = 0; a < 2; ++a)
#pragma unroll
            for (int b = 0; b < 2; ++b)
#pragma unroll
                for (int m = 0; m < 4; ++m)
#pragma unroll
                    for (int n = 0; n < 2; ++n) acc[a][b][m][n] = (f32x4){0.f, 0.f, 0.f, 0.f};
        cur = nxt; cA = nA; cB = nB; ++ui;
        if constexpr (ALIGN_EPI) { if (wr == 1) PG8_BAR; }
    }
    PG8_WAIT_V(0);
    if constexpr (!ALIGN_EPI) { if (wr == 0) PG8_BAR; }
    PG8_BAR;
    if constexpr (Epi::AFTER_DRAIN) { E.fused(acc, cur, wr, wc, fr, fq, lds, wid, lane); S.done(cur); }
#undef PG8_SA
#undef PG8_SB
#undef PG8_STAGE
#undef PG8_LDA
#undef PG8_LDB
#undef PG8_MMA
#undef PG8_WAIT_V
#undef PG8_WAIT_L
#undef PG8_BAR
#undef PG8_SCHED
}
}
namespace pg8 {
__device__ __forceinline__ u32x4 pack8(const f32x4 a, const f32x4 b) { u32x4 w; w.x = cvt_pk_bf16(a[0], a[1]); w.y = cvt_pk_bf16(a[2], a[3]); w.z = cvt_pk_bf16(b[0], b[1]); w.w = cvt_pk_bf16(b[2], b[3]); return w; }

struct EpiInProj {
    static constexpr bool PERM = true, AFTER_DRAIN = false;
    bf16_t* Q; bf16_t* KV; bf16_t* Z; bf16_t* BG; float* G; const float* qn; const float* kn;
    __device__ __forceinline__ void operator()(const f32x4 (&acc)[2][2][4][2], const Unit& u, int wr, int wc, int fr, int fq) const {
        const int pn = u.pn; const int row0 = u.pm * BM + wr * 64 + fr;
        if (pn <= 4) {
            const bool donorm = (pn < 2) || (pn >= 3 && wc < 2);
            const float* nw = (pn < 2) ? qn : kn;
            const float sc = (pn < 2) ? (0.125f * 1.4426950408889634f) : 1.0f;
            f32x4 w4[2][2];
#pragma unroll
            for (int bj = 0; bj < 2; ++bj)
#pragma unroll
                for (int n = 0; n < 2; ++n) { f32x4 t = *(const f32x4*)(nw + 32 * bj + 8 * fq + 4 * n); w4[bj][n] = donorm ? t * sc : (f32x4){1.f, 1.f, 1.f, 1.f}; }
            bf16_t* base; size_t rstride;
            if (pn < 2) { base = Q + (4 * pn + wc) * 64 + 8 * fq; rstride = 512; }
            else { const int ti = (pn - 2) * 2 + (wc >> 1), g = wc & 1; base = KV + (size_t)ti * ((size_t)4 * 2 * 8192 * 64) + 8 * fq; rstride = 64;
                   base += (size_t)g * 8192 * 64; }
#pragma unroll
            for (int ai = 0; ai < 2; ++ai)
#pragma unroll
                for (int m = 0; m < 4; ++m) {
                    const int r = row0 + ai * HALF + m * 16;
                    float rs = 1.f;
                    if (donorm) {
                        float ss = 0.f;
#pragma unroll
                        for (int bj = 0; bj < 2; ++bj)
#pragma unroll
                            for (int n = 0; n < 2; ++n) { const f32x4 x = acc[ai][bj][m][n]; ss += (x[0] * x[0] + x[1] * x[1]) + (x[2] * x[2] + x[3] * x[3]); }
                        ss += __shfl_xor(ss, 16); ss += __shfl_xor(ss, 32);
                        rs = 1.0f / sqrtf(ss * (1.0f / 64.0f) + 1e-6f);
                    }
                    size_t off;
                    if (pn < 2) off = (size_t)r * 512;
                    else { const int b = r >> 13, t = r & 8191; off = ((size_t)(b * 2) * 8192 + t) * 64; }
#pragma unroll
                    for (int bj = 0; bj < 2; ++bj) {
                        const f32x4 v0 = acc[ai][bj][m][0] * rs * w4[bj][0], v1 = acc[ai][bj][m][1] * rs * w4[bj][1];
                        *(u32x4*)(base + off + 32 * bj) = pack8(v0, v1);
                    }
                }
        } else if (pn <= 8) {
            bf16_t* base = Z + 128 * (pn - 5) + 32 * wc + 8 * fq;
#pragma unroll
            for (int ai = 0; ai < 2; ++ai)
#pragma unroll
                for (int m = 0; m < 4; ++m) {
                    const int r = row0 + ai * HALF + m * 16;
                    const f32x4 v0 = acc[ai][0][m][0] * acc[ai][1][m][0], v1 = acc[ai][0][m][1] * acc[ai][1][m][1];
                    *(u32x4*)(base + (size_t)r * 512) = pack8(v0, v1);
                }
        } else if (pn <= 10) {
            bf16_t* base = BG + 256 * (pn - 9) + 32 * wc + 8 * fq;
#pragma unroll
            for (int ai = 0; ai < 2; ++ai)
#pragma unroll
                for (int m = 0; m < 4; ++m) {
                    const int r = row0 + ai * HALF + m * 16;
#pragma unroll
                    for (int bj = 0; bj < 2; ++bj) *(u32x4*)(base + (size_t)r * 512 + 128 * bj) = pack8(acc[ai][bj][m][0], acc[ai][bj][m][1]);
                }
        } else {
            if (wc == 0 && fq < 3) {
#pragma unroll
                for (int ai = 0; ai < 2; ++ai)
#pragma unroll
                    for (int m = 0; m < 4; ++m) {
                        const int r = row0 + ai * HALF + m * 16;
#pragma unroll
                        for (int n = 0; n < 2; ++n) { const f32x4 x = acc[ai][0][m][n]; f32x4 s;
#pragma unroll
                            for (int e = 0; e < 4; ++e) s[e] = 1.0f / (1.0f + __expf(-x[e]));
                            *(f32x4*)(G + (size_t)r * 32 + 8 * fq + 4 * n) = s; }
                    }
            }
        }
    }
};

struct EpiOutProj {
    static constexpr bool PERM = true, AFTER_DRAIN = false;
    const float* x; float* out; bf16_t* A2; float* RSS; const float* mod; const float* n2;
    __device__ __forceinline__ void operator()(const f32x4 (&acc)[2][2][4][2], const Unit& u, int wr, int wc, int fr, int fq) const {
        const int row0 = u.pm * BM + wr * 64 + fr; const int b = (u.pm * BM) >> 13;
        const int col0 = u.pn * BM + wc * 32 + 8 * fq;
        f32x4 g1[2][2], a2[2][2];
#pragma unroll
        for (int bj = 0; bj < 2; ++bj)
#pragma unroll
            for (int n = 0; n < 2; ++n) { const int c = col0 + 128 * bj + 4 * n;
                g1[bj][n] = *(const f32x4*)(mod + (size_t)b * 6144 + 2 * 1024 + c);
                const f32x4 s2 = *(const f32x4*)(mod + (size_t)b * 6144 + 4 * 1024 + c), nn = *(const f32x4*)(n2 + c);
                a2[bj][n] = nn * (s2 + 1.0f); }
#pragma unroll
        for (int ai = 0; ai < 2; ++ai)
#pragma unroll
            for (int m = 0; m < 4; ++m) {
                const int r = row0 + ai * HALF + m * 16; float ss = 0.f;
#pragma unroll
                for (int bj = 0; bj < 2; ++bj) {
                    const size_t off = (size_t)r * 1024 + col0 + 128 * bj;
                    const f32x4 xa = *(const f32x4*)(x + off), xb = *(const f32x4*)(x + off + 4);
                    const f32x4 ya = xa + g1[bj][0] * acc[ai][bj][m][0], yb = xb + g1[bj][1] * acc[ai][bj][m][1];
                    *(f32x4*)(out + off) = ya; *(f32x4*)(out + off + 4) = yb;
                    ss += (ya[0] * ya[0] + ya[1] * ya[1]) + (ya[2] * ya[2] + ya[3] * ya[3]) + (yb[0] * yb[0] + yb[1] * yb[1]) + (yb[2] * yb[2] + yb[3] * yb[3]);
                    *(u32x4*)(A2 + off) = pack8(ya * a2[bj][0], yb * a2[bj][1]);
                }
                ss += __shfl_xor(ss, 16); ss += __shfl_xor(ss, 32);
                if (fq == 0) RSS[(size_t)r * 16 + u.pn * 4 + wc] = ss;
            }
    }
};

struct EpiFF1 {
    static constexpr bool PERM = true, AFTER_DRAIN = false;
    bf16_t* HID; const float* RSS; const float* bff1;
    __device__ __forceinline__ void operator()(const f32x4 (&acc)[2][2][4][2], const Unit& u, int wr, int wc, int fr, int fq) const {
        const int row0 = u.pm * BM + wr * 64 + fr; const int b = (u.pm * BM) >> 13;
        const int col0 = u.pn * BM + wc * 32 + 8 * fq;
        f32x4 bv[2][2];
#pragma unroll
        for (int bj = 0; bj < 2; ++bj)
#pragma unroll
            for (int n = 0; n < 2; ++n) bv[bj][n] = *(const f32x4*)(bff1 + (size_t)b * 4096 + col0 + 128 * bj + 4 * n);
#pragma unroll
        for (int ai = 0; ai < 2; ++ai)
#pragma unroll
            for (int m = 0; m < 4; ++m) {
                const int r = row0 + ai * HALF + m * 16;
                const f32x4 s0 = *(const f32x4*)(RSS + (size_t)r * 16), s1 = *(const f32x4*)(RSS + (size_t)r * 16 + 4), s2 = *(const f32x4*)(RSS + (size_t)r * 16 + 8), s3 = *(const f32x4*)(RSS + (size_t)r * 16 + 12);
                const f32x4 st = (s0 + s1) + (s2 + s3);
                const float rs = 1.0f / sqrtf(((st[0] + st[1]) + (st[2] + st[3])) * (1.0f / 1024.0f) + 1e-6f);
#pragma unroll
                for (int bj = 0; bj < 2; ++bj) {
                    f32x4 h0 = acc[ai][bj][m][0] * rs + bv[bj][0], h1 = acc[ai][bj][m][1] * rs + bv[bj][1];
#pragma unroll
                    for (int e = 0; e < 4; ++e) { const float a = fmaxf(h0[e], 0.f), c = fmaxf(h1[e], 0.f); h0[e] = a * a; h1[e] = c * c; }
                    *(u32x4*)(HID + (size_t)r * 4096 + col0 + 128 * bj) = pack8(h0, h1);
                }
            }
    }
};

struct EpiFF2 {
    static constexpr bool PERM = true, AFTER_DRAIN = false;
    float* out; const float* mod; float* dst;
    __device__ __forceinline__ void operator()(const f32x4 (&acc)[2][2][4][2], const Unit& u, int wr, int wc, int fr, int fq) const {
        const int row0 = u.pm * BM + wr * 64 + fr; const int b = (u.pm * BM) >> 13;
        const int col0 = u.pn * BM + wc * 32 + 8 * fq;
        f32x4 g2[2][2];
#pragma unroll
        for (int bj = 0; bj < 2; ++bj)
#pragma unroll
            for (int n = 0; n < 2; ++n) g2[bj][n] = *(const f32x4*)(mod + (size_t)b * 6144 + 5 * 1024 + col0 + 128 * bj + 4 * n);
#pragma unroll
        for (int ai = 0; ai < 2; ++ai)
#pragma unroll
            for (int m = 0; m < 4; ++m) {
                const int r = row0 + ai * HALF + m * 16;
#pragma unroll
                for (int bj = 0; bj < 2; ++bj) {
                    const size_t off = (size_t)r * 1024 + col0 + 128 * bj;
                    const f32x4 xa = *(const f32x4*)(out + off), xb = *(const f32x4*)(out + off + 4);
                    *(f32x4*)(dst + off) = xa + g2[bj][0] * acc[ai][bj][m][0]; *(f32x4*)(dst + off + 4) = xb + g2[bj][1] * acc[ai][bj][m][1];
                }
            }
    }
};
}

#ifndef MK_N_LAUNCHES
#define MK_N_LAUNCHES 1
#endif
constexpr int NWAVES = 8;
constexpr int N_PHASES = 8;
constexpr int BATCH = 4, T = 8192, D = 1024, M = BATCH * T, FF = 4096, NIN = 3072, INCOLS = 2840;
constexpr int NCMP = 511;
constexpr float LOG2E = 1.4426950408889634f;
constexpr size_t MiB = 1u << 20;
constexpr size_t WS_CTL = 0, CTL_ZERO_BYTES = 32 * 1024;
constexpr size_t WS_MOD = 1 * MiB;
constexpr size_t WS_BFF1 = 1 * MiB + 128 * 1024;
constexpr size_t WS_PEP = 1 * MiB + 256 * 1024;
constexpr size_t WS_RSS = 2 * MiB;
constexpr size_t WS_G = 4 * MiB;
constexpr size_t WS_WIN = 8 * MiB;
constexpr size_t WS_WOUT = 14 * MiB;
constexpr size_t WS_W1 = 16 * MiB;
constexpr size_t WS_W2 = 24 * MiB;
constexpr size_t WS_CW1K = 32 * MiB, WS_CW1V = 33 * MiB;
constexpr size_t WS_CW2K = 34 * MiB, WS_CW2V = 34 * MiB + 64 * 1024;
constexpr size_t WS_KC = 35 * MiB, WS_VC = 35 * MiB + 512 * 1024;
constexpr size_t WS_A2 = 36 * MiB;
constexpr size_t WS_H = 100 * MiB;
constexpr size_t WS_Q = 164 * MiB;
constexpr size_t WS_KV = 196 * MiB;
constexpr size_t KV_TENS = (size_t)4 * 2 * 8192 * 64;
constexpr size_t WS_Z = 244 * MiB;
constexpr size_t WS_BG = 276 * MiB;
constexpr size_t WS_MIX = 308 * MiB;
constexpr size_t WS_HID = 100 * MiB;
constexpr size_t WS_END = 372 * MiB;
constexpr int CW_BAR = 4096;

constexpr int RING_BYTES = 131072;
constexpr int LDSCTL_OFF = 151 * 1024, MISC_OFF = LDSCTL_OFF + 320;
constexpr int LDS_BYTES = 152 * 1024;

#define GAS __attribute__((address_space(1)))
#define LAS __attribute__((address_space(3)))
typedef unsigned short bf16;
typedef unsigned v4u __attribute__((ext_vector_type(4)));
typedef float f32x4 __attribute__((ext_vector_type(4)));
typedef float f32x16 __attribute__((ext_vector_type(16)));
typedef short bf16x8 __attribute__((ext_vector_type(8)));
typedef short s16x4 __attribute__((ext_vector_type(4)));
typedef GAS unsigned gu32;
#define RLX_AGENT __ATOMIC_RELAXED, __HIP_MEMORY_SCOPE_AGENT
#define LDS_WAIT() asm volatile("s_waitcnt lgkmcnt(0)" ::: "memory")
#define VM_WAIT() asm volatile("s_waitcnt vmcnt(0)" ::: "memory")
__device__ __forceinline__ unsigned f2bf(float f) { unsigned u = __builtin_bit_cast(unsigned, f); return (u + 0x7fffu + ((u >> 16) & 1u)) >> 16; }
__device__ __forceinline__ unsigned pk2(float lo, float hi) { return f2bf(lo) | (f2bf(hi) << 16); }
__device__ __forceinline__ float bf2f(unsigned short h) { return __builtin_bit_cast(float, (unsigned)h << 16); }
#define XB_TMO      128
#define XB_XCNT(j)  (256  + 64 * (j))
#define XB_XSUB(j)  (1280 + 64 * (j))
#define XB_XGEN(j)  (2304 + 64 * (j))
#define XB_TOP      3328
#define XB_TOPGEN   3392
#define XCD_BAR_WORDS 3456
#define XB_SPIN_CAP (1u << 18)

__device__ __forceinline__ unsigned xb_ld(unsigned* p)              { return __hip_atomic_load(p, __ATOMIC_RELAXED, __HIP_MEMORY_SCOPE_AGENT); }
__device__ __forceinline__ unsigned xb_add(unsigned* p, unsigned v) { return __hip_atomic_fetch_add(p, v, __ATOMIC_RELAXED, __HIP_MEMORY_SCOPE_AGENT); }
__device__ __forceinline__ unsigned xb_xcc_id() { return (unsigned)__builtin_amdgcn_s_getreg((3 << 11) | 20) & 0xFu; }
#define XB_SPIN(cond, bar) do { unsigned _sp = 0; while (cond) { __builtin_amdgcn_s_sleep(1); \
    if ((++_sp & 255u) == 0u) { if (xb_ld(&(bar)[XB_TMO])) break; if (_sp > XB_SPIN_CAP) { atomicAdd(&(bar)[XB_TMO], 1u); break; } } } } while (0)

struct XcdBarrier {
    unsigned* bar; unsigned x;
    volatile LAS unsigned* st;
};

__device__ __forceinline__ XcdBarrier xcd_barrier_post(unsigned* bar, volatile LAS unsigned* st) {
    XcdBarrier b; b.bar = bar; b.x = xb_xcc_id(); b.st = st;
    if (threadIdx.x == 0) (void)xb_add(&bar[XB_XCNT(b.x)], 1u);
    return b;
}
__device__ __forceinline__ void xcd_barrier_complete(unsigned* bar, unsigned x, unsigned& nloc, unsigned& nx) {
    const unsigned G = gridDim.x * gridDim.y * gridDim.z;
    unsigned sum, cnt, mine, sp = 0u;
    for (;;) {
        sum = 0u; cnt = 0u; mine = 0u;
#pragma unroll
        for (unsigned j = 0; j < 16; ++j) { const unsigned c = xb_ld(&bar[XB_XCNT(j)]); sum += c; cnt += (c > 0u) ? 1u : 0u; mine = (j == x) ? c : mine; }
        if (sum == G) break;
        __builtin_amdgcn_s_sleep(1);
        if ((++sp & 255u) == 0u) { if (xb_ld(&bar[XB_TMO])) break; if (sp > XB_SPIN_CAP) { atomicAdd(&bar[XB_TMO], 1u); break; } }
    }
    nloc = mine > 0u ? mine : 1u; nx = cnt > 0u ? cnt : 1u;
}

__device__ __forceinline__ void xcd_barrier(const XcdBarrier& b) {
    asm volatile("s_waitcnt vmcnt(0)" ::: "memory");
    __syncthreads();
    if (threadIdx.x == 0) {
        unsigned* bar = b.bar;
        __builtin_amdgcn_s_waitcnt(0);
        unsigned nloc = b.st[0], nx = b.st[1];
        if (nloc == 0u) { xcd_barrier_complete(bar, b.x, nloc, nx); b.st[0] = nloc; b.st[1] = nx; }
        const unsigned old = xb_add(&bar[XB_XSUB(b.x)], 1u);
        const unsigned gen = old / nloc;
        if (old + 1u == (gen + 1u) * nloc) {
            __builtin_amdgcn_fence(__ATOMIC_RELEASE, "agent");
            asm volatile("s_waitcnt vmcnt(0)" ::: "memory");
            const unsigned og = xb_add(&bar[XB_TOP], 1u);
            const unsigned tg = og / nx;
            if (og + 1u == (tg + 1u) * nx) xb_add(&bar[XB_TOPGEN], 1u);
            else XB_SPIN(xb_ld(&bar[XB_TOPGEN]) == tg, bar);
            __builtin_amdgcn_fence(__ATOMIC_ACQUIRE, "agent");
            xb_add(&bar[XB_XGEN(b.x)], 1u);
            asm volatile("s_waitcnt vmcnt(0)" ::: "memory");
        } else {
            XB_SPIN(xb_ld(&bar[XB_XGEN(b.x)]) == gen, bar);
            __builtin_amdgcn_fence(__ATOMIC_ACQUIRE, "agent");
            asm volatile("s_waitcnt vmcnt(0)" ::: "memory");
        }
    }
    __syncthreads();
}

struct Frame {
    LAS unsigned char* lds;
    volatile LAS unsigned* MISC;
    gu32* ctl;
    int tid, lane, wave;
    int vcu, G;
    const float* in[20];
    float* out;
    unsigned char* ws;
};
__device__ __forceinline__ float wave_sum(float v) {
#pragma unroll
    for (int o = 1; o < 64; o <<= 1) v += __shfl_xor(v, o);
    return v;
}

__device__ __forceinline__ void p0_transpose_item(const float* W, int K, int N, int nsrc0, int nvalid, bf16* WT, int drow0, int kb, LAS float* scr, int lane) {
    const int k0 = 64 * kb; const int nl = lane & 31;
    float tv[32];
#pragma unroll
    for (int i = 0; i < 32; ++i) { const int kk = 2 * i + (lane >> 5); tv[i] = (nl < nvalid) ? W[(size_t)(k0 + kk) * N + nsrc0 + nl] : 0.f; }
#pragma unroll
    for (int i = 0; i < 32; ++i) { const int kk = 2 * i + (lane >> 5); scr[kk * 33 + nl] = tv[i]; }
    LDS_WAIT(); asm volatile("" ::: "memory");
    const int c = lane & 7;
#pragma unroll
    for (int j = 0; j < 4; ++j) { const int n = (lane >> 3) + 8 * j; const LAS float* s = scr + (8 * c) * 33 + n;
        v4u o; o.x = pk2(s[0 * 33], s[1 * 33]); o.y = pk2(s[2 * 33], s[3 * 33]); o.z = pk2(s[4 * 33], s[5 * 33]); o.w = pk2(s[6 * 33], s[7 * 33]);
        *(GAS v4u*)(WT + (size_t)(drow0 + n) * K + k0 + 8 * c) = o; }
    LDS_WAIT(); asm volatile("" ::: "memory");
}
__device__ __forceinline__ void win_src(int rb, int& src0, int& nvalid) {
    const int pn = rb >> 3, q = rb & 7, bj = q >> 2, wc = q & 3; nvalid = 32;
    if (pn < 2) src0 = (4 * pn + wc) * 64 + 32 * bj;
    else if (pn < 5) src0 = 512 + (pn - 2) * 256 + (wc >> 1) * 128 + (wc & 1) * 64 + 32 * bj;
    else if (pn < 9) src0 = (bj == 0 ? 1304 : 2328) + 128 * (pn - 5) + 32 * wc;
    else if (pn < 11) src0 = 1816 + 256 * (pn - 9) + 32 * q;
    else { src0 = 1280; nvalid = (q == 0) ? 24 : 0; }
}
__device__ __forceinline__ void p0_phase(Frame& F) {
    const int bid = blockIdx.x;
    for (int it = bid; it < 224; it += F.G) {
      if (it < 192) {
        const int cb = it;
        LAS float* sc = (LAS float*)(F.lds);
        LAS float* red = (LAS float*)(F.lds + 16384);
        const float* c = F.in[1];
        for (int i = F.tid; i < 4096; i += 512) { const float v = c[i]; sc[i] = v / (1.0f + __expf(-v)); }
        __syncthreads();
        const float* wa = F.in[16]; const int col = 32 * cb + (F.lane & 31), kpar = F.lane >> 5;
        float a0 = 0.f, a1 = 0.f, a2 = 0.f, a3 = 0.f;
#pragma unroll 32
        for (int i = 0; i < 64; ++i) { const int k = 128 * F.wave + 2 * i + kpar; const float w = wa[(size_t)k * 6144 + col];
            a0 += sc[k] * w; a1 += sc[1024 + k] * w; a2 += sc[2048 + k] * w; a3 += sc[3072 + k] * w; }
        a0 += __shfl_xor(a0, 32); a1 += __shfl_xor(a1, 32); a2 += __shfl_xor(a2, 32); a3 += __shfl_xor(a3, 32);
        if (F.lane < 32) { red[(F.wave * 4 + 0) * 32 + F.lane] = a0; red[(F.wave * 4 + 1) * 32 + F.lane] = a1; red[(F.wave * 4 + 2) * 32 + F.lane] = a2; red[(F.wave * 4 + 3) * 32 + F.lane] = a3; }
        __syncthreads();
        if (F.tid < 128) { const int b = F.tid >> 5, cc = F.tid & 31; float s = F.in[17][32 * cb + cc];
#pragma unroll
            for (int w = 0; w < 8; ++w) s += red[(w * 4 + b) * 32 + cc];
            ((float*)(F.ws + WS_MOD))[b * 6144 + 32 * cb + cc] = s; }
        __syncthreads();
      } else {
        const int kv = (it - 192) >> 4, kc = (it - 192) & 15; const float* pe = F.in[kv ? 8 : 5]; const float* w1 = F.in[kv ? 9 : 6];
        if (F.tid < 256) { float s = 0.f;
#pragma unroll 32
            for (int k = 128 * kc; k < 128 * kc + 128; ++k) s += pe[k] * w1[(size_t)k * 256 + F.tid];
            ((float*)(F.ws + WS_PEP))[(kv * 16 + kc) * 256 + F.tid] = s; }
      }
    }
    __syncthreads();
    LAS float* scr = (LAS float*)(F.lds + F.wave * 16384);
    const int gw = F.vcu * NWAVES + F.wave, NGW = F.G * NWAVES;
    constexpr int I_IN = 96 * 16, I_OUT = 32 * 16, I_1 = 128 * 16, I_2 = 32 * 64, I_C1 = 8 * 32, I_C2 = 2 * 4;
    constexpr int NITEMS = I_IN + I_OUT + I_1 + I_2 + 2 * I_C1 + 2 * I_C2;
    for (int it = gw; it < NITEMS; it += NGW) {
        int r = it;
        if (r < I_IN) { const int rb = r >> 4, kb = r & 15; int s0, nv; win_src(rb, s0, nv); p0_transpose_item(F.in[2], D, INCOLS, s0, nv, (bf16*)(F.ws + WS_WIN), 32 * rb, kb, scr, F.lane); continue; } r -= I_IN;
        if (r < I_OUT) { const int rb = r >> 4, kb = r & 15; p0_transpose_item(F.in[13], D, D, 32 * rb, 32, (bf16*)(F.ws + WS_WOUT), 32 * rb, kb, scr, F.lane); continue; } r -= I_OUT;
        if (r < I_1) { const int rb = r >> 4, kb = r & 15; p0_transpose_item(F.in[18], D, FF, 32 * rb, 32, (bf16*)(F.ws + WS_W1), 32 * rb, kb, scr, F.lane); continue; } r -= I_1;
        if (r < I_2) { const int rb = r >> 6, kb = r & 63; p0_transpose_item(F.in[19], FF, D, 32 * rb, 32, (bf16*)(F.ws + WS_W2), 32 * rb, kb, scr, F.lane); continue; } r -= I_2;
        if (r < I_C1) { const int rb = r >> 5, kb = r & 31; p0_transpose_item(F.in[6], 2048, 256, 32 * rb, 32, (bf16*)(F.ws + WS_CW1K), 32 * rb, kb, scr, F.lane); continue; } r -= I_C1;
        if (r < I_C1) { const int rb = r >> 5, kb = r & 31; p0_transpose_item(F.in[9], 2048, 256, 32 * rb, 32, (bf16*)(F.ws + WS_CW1V), 32 * rb, kb, scr, F.lane); continue; } r -= I_C1;
        if (r < I_C2) { const int rb = r >> 2, kb = r & 3; p0_transpose_item(F.in[7], 256, 64, 32 * rb, 32, (bf16*)(F.ws + WS_CW2K), 32 * rb, kb, scr, F.lane); continue; } r -= I_C2;
        { const int rb = r >> 2, kb = r & 3; p0_transpose_item(F.in[10], 256, 64, 32 * rb, 32, (bf16*)(F.ws + WS_CW2V), 32 * rb, kb, scr, F.lane); }
    }
    __syncthreads();
}

__device__ __forceinline__ void p1_phase(Frame& F) {
    const int gw = F.vcu * NWAVES + F.wave, NGW = F.G * NWAVES;
    const float* mod = (const float*)(F.ws + WS_MOD);
    const float* x = F.in[0]; const float* n1 = F.in[14];
    bf16* H = (bf16*)(F.ws + WS_H);
    for (int chunk = gw; chunk < M / 16; chunk += NGW) {
        const int r0 = chunk * 16, b = r0 >> 13;
        f32x4 ca[4], cb[4];
#pragma unroll
        for (int j = 0; j < 4; ++j) { const int c = 4 * (F.lane + 64 * j);
            const f32x4 nn = *(const f32x4*)(n1 + c), s1 = *(const f32x4*)(mod + (size_t)b * 6144 + 1024 + c);
            ca[j] = nn * (s1 + 1.0f); cb[j] = *(const f32x4*)(mod + (size_t)b * 6144 + c); }
        for (int rr = 0; rr < 16; rr += 4) {
            f32x4 v[4][4]; float s[4];
#pragma unroll
            for (int q = 0; q < 4; ++q) { const GAS f32x4* xr = (const GAS f32x4*)(x + (size_t)(r0 + rr + q) * D) + F.lane;
#pragma unroll
                for (int j = 0; j < 4; ++j) v[q][j] = xr[64 * j]; }
#pragma unroll
            for (int q = 0; q < 4; ++q) { s[q] = 0.f;
#pragma unroll
                for (int j = 0; j < 4; ++j) s[q] += (v[q][j].x * v[q][j].x + v[q][j].y * v[q][j].y) + (v[q][j].z * v[q][j].z + v[q][j].w * v[q][j].w); }
#pragma unroll
            for (int o = 1; o < 64; o <<= 1) {
#pragma unroll
                for (int q = 0; q < 4; ++q) s[q] += __shfl_xor(s[q], o); }
#pragma unroll
            for (int q = 0; q < 4; ++q) {
                const float rs = 1.0f / sqrtf(s[q] * (1.0f / D) + 1e-6f);
                GAS unsigned long long* o8 = (GAS unsigned long long*)(H + (size_t)(r0 + rr + q) * D) + F.lane;
#pragma unroll
                for (int j = 0; j < 4; ++j) { const f32x4 h = v[q][j] * rs * ca[j] + cb[j];
                    o8[64 * j] = (unsigned long long)pk2(h.x, h.y) | ((unsigned long long)pk2(h.z, h.w) << 32); }
            }
        }
    }
    const bf16* W1t = (const bf16*)(F.ws + WS_W1);
    float* bff1 = (float*)(F.ws + WS_BFF1);
    for (int n = gw; n < FF; n += NGW) {
        float a[4] = {0.f, 0.f, 0.f, 0.f};
#pragma unroll
        for (int j = 0; j < 2; ++j) { const int k0 = 8 * F.lane + 512 * j;
            const v4u wv = *(const GAS v4u*)(W1t + (size_t)n * D + k0);
            float w[8]; w[0] = bf2f(wv.x & 0xffff); w[1] = bf2f(wv.x >> 16); w[2] = bf2f(wv.y & 0xffff); w[3] = bf2f(wv.y >> 16); w[4] = bf2f(wv.z & 0xffff); w[5] = bf2f(wv.z >> 16); w[6] = bf2f(wv.w & 0xffff); w[7] = bf2f(wv.w >> 16);
#pragma unroll
            for (int b = 0; b < 4; ++b) { const f32x4 s0 = *(const f32x4*)(mod + (size_t)b * 6144 + 3 * 1024 + k0), s1 = *(const f32x4*)(mod + (size_t)b * 6144 + 3 * 1024 + k0 + 4);
                a[b] += (w[0] * s0[0] + w[1] * s0[1]) + (w[2] * s0[2] + w[3] * s0[3]) + (w[4] * s1[0] + w[5] * s1[1]) + (w[6] * s1[2] + w[7] * s1[3]); } }
#pragma unroll
        for (int b = 0; b < 4; ++b) { const float s = wave_sum(a[b]); if (F.lane == 0) bff1[b * 4096 + n] = s; }
    }
}

__device__ __forceinline__ float gelu_tanh(float x) {
    const float u = 0.7978845608028654f * (x + 0.044715f * x * x * x);
    const float e = __expf(2.0f * u);
    const float th = 1.0f - 2.0f / (1.0f + e);
    return 0.5f * x * (1.0f + th);
}
__device__ __forceinline__ void p3_phase(Frame& F) {
    constexpr int AIMG = 0, GSTR = 2064, HIDO = 68224, HSTR = 528, OUTO = 85120, OSTR = 65;
    const int lane = F.lane, w = F.wave, r32 = lane & 31, hi = lane >> 5;
    for (int item = blockIdx.x; item < 256; item += F.G) {
        const int prob = item >> 4, mt = item & 15, kv = prob >> 3, b = (prob >> 1) & 3, g = prob & 1, n0 = 32 * mt;
        const bf16* raw = (const bf16*)(F.ws + WS_KV) + (size_t)kv * KV_TENS + (size_t)(b * 2 + g) * 8192 * 64;
        { v4u av[9];
#pragma unroll
          for (int q = 0; q < 9; ++q) { const int idx = F.tid + 512 * q, gl = idx >> 7, ch = idx & 127, gi = n0 + gl;
              av[q] = (v4u){0u, 0u, 0u, 0u}; if (idx < 33 * 128 && gi < 512) av[q] = *(const GAS v4u*)(raw + (size_t)gi * 1024 + ch * 8); }
#pragma unroll
          for (int q = 0; q < 9; ++q) { const int idx = F.tid + 512 * q, gl = idx >> 7, ch = idx & 127;
              if (idx < 33 * 128) *(LAS v4u*)(F.lds + AIMG + gl * GSTR + ch * 16) = av[q]; } }
        __syncthreads();
        const bf16* W1t = (const bf16*)(F.ws + (kv ? WS_CW1V : WS_CW1K));
        const bf16* bp = W1t + (size_t)(32 * w + r32) * 2048 + 8 * hi;
        const LAS unsigned char* ap = F.lds + AIMG + r32 * GSTR + hi * 16;
        f32x16 acc = {};
#pragma unroll 1
        for (int s0 = 0; s0 < 128; s0 += 32) {
            bf16x8 bfr[32];
#pragma unroll
            for (int j = 0; j < 32; ++j) bfr[j] = *(const GAS bf16x8*)(bp + 16 * (s0 + j));
            const LAS unsigned char* aq = ap + (s0 >= 64 ? GSTR + (s0 - 64) * 32 : s0 * 32);
#pragma unroll
            for (int j = 0; j < 32; ++j) { const bf16x8 af = *(const LAS bf16x8*)(aq + j * 32); acc = __builtin_amdgcn_mfma_f32_32x32x16_bf16(af, bfr[j], acc, 0, 0, 0); }
        }
        { const float* pp = (const float*)(F.ws + WS_PEP) + kv * 16 * 256 + 32 * w + r32; float pb = 0.f;
#pragma unroll
          for (int kc = 0; kc < 16; ++kc) pb += pp[kc * 256];
#pragma unroll
          for (int i = 0; i < 16; ++i) { const int row = (i & 3) + 8 * (i >> 2) + 4 * hi; const float h = gelu_tanh(acc[i] + pb);
              *(LAS unsigned short*)(F.lds + HIDO + row * HSTR + (32 * w + r32) * 2) = (unsigned short)f2bf(h); } }
        __syncthreads();
        if (w < 2) {
            const bf16* W2t = (const bf16*)(F.ws + (kv ? WS_CW2V : WS_CW2K));
            const bf16* bp2 = W2t + (size_t)(32 * w + r32) * 256 + 8 * hi;
            const LAS unsigned char* ap2 = F.lds + HIDO + r32 * HSTR + hi * 16;
            f32x16 a2 = {};
#pragma unroll
            for (int s = 0; s < 16; ++s) { const bf16x8 bf_ = *(const GAS bf16x8*)(bp2 + 16 * s); const bf16x8 af = *(const LAS bf16x8*)(ap2 + s * 32); a2 = __builtin_amdgcn_mfma_f32_32x32x16_bf16(af, bf_, a2, 0, 0, 0); }
#pragma unroll
            for (int i = 0; i < 16; ++i) { const int row = (i & 3) + 8 * (i >> 2) + 4 * hi; *(LAS float*)(F.lds + OUTO + (row * OSTR + 32 * w + r32) * 4) = a2[i]; }
        }
        __syncthreads();
        { const int row = F.tid >> 4, c4 = (F.tid & 15) * 4; const LAS float* op = (const LAS float*)(F.lds + OUTO) + row * OSTR + c4;
          float v0 = op[0], v1 = op[1], v2 = op[2], v3 = op[3];
          if (kv == 0) { float ss = (v0 * v0 + v1 * v1) + (v2 * v2 + v3 * v3); ss += __shfl_xor(ss, 1); ss += __shfl_xor(ss, 2); ss += __shfl_xor(ss, 4); ss += __shfl_xor(ss, 8);
              const float rs = 1.0f / sqrtf(ss * (1.0f / 64.0f) + 1e-6f); const f32x4 kn = *(const f32x4*)(F.in[4] + c4); v0 *= rs * kn[0]; v1 *= rs * kn[1]; v2 *= rs * kn[2]; v3 *= rs * kn[3]; }
          const int n = n0 + row; if (n >= NCMP) { v0 = v1 = v2 = v3 = 0.f; }
          bf16* dst = (bf16*)(F.ws + (kv ? WS_VC : WS_KC)) + ((size_t)(b * 2 + g) * 512 + n) * 64 + c4;
          *(GAS unsigned long long*)dst = (unsigned long long)pk2(v0, v1) | ((unsigned long long)pk2(v2, v3) << 32); }
        __syncthreads();
    }
}

namespace att {
constexpr int SLOT = 16384;
constexpr int L_RING = 0;
constexpr int L_IMP = 49152, IMP_STR = 132;
constexpr int L_OACC = 49152;
constexpr int L_BTAB = L_OACC + 65536;
constexpr int NBT = 800;
constexpr int L_WSF = L_BTAB + 4 * NBT * 4;
constexpr int L_SELM = L_WSF + 2048;
constexpr int L_UNI = L_SELM + 1024;
constexpr int L_END = L_UNI + 128;
static_assert(L_END <= RING_BYTES, "attention LDS map");
constexpr float NEG_INF = -INFINITY;
constexpr float THR = 8.0f;

__device__ __forceinline__ int t5_bucket(int n) {
    if (n < 16) return n;
    int b = 16;
    b += (n >= 21); b += (n >= 27); b += (n >= 35); b += (n >= 46); b += (n >= 59); b += (n >= 77); b += (n >= 99); b += (n >= 128);
    b += (n >= 166); b += (n >= 216); b += (n >= 280); b += (n >= 363); b += (n >= 470); b += (n >= 609); b += (n >= 790);
    return b;
}
__device__ __forceinline__ s16x4 vtr(const LAS unsigned char* p) { typedef short v4i16_t __attribute__((ext_vector_type(4))); return __builtin_bit_cast(s16x4, __builtin_amdgcn_ds_read_tr16_b64_v4i16((LAS v4i16_t*)p)); }
__device__ __forceinline__ unsigned cvtpk(float lo, float hi) { typedef float f2 __attribute__((ext_vector_type(2))); typedef __bf16 b2 __attribute__((ext_vector_type(2))); f2 v = {lo, hi}; b2 b = __builtin_convertvector(v, b2); return __builtin_bit_cast(unsigned, b); }
__device__ __forceinline__ float xhalf_max(float a) { auto rr = __builtin_amdgcn_permlane32_swap(__float_as_uint(a), __float_as_uint(a), false, false); return fmaxf(__uint_as_float(rr[0]), __uint_as_float(rr[1])); }
__device__ __forceinline__ float xhalf_sum(float a) { auto rr = __builtin_amdgcn_permlane32_swap(__float_as_uint(a), __float_as_uint(a), false, false); return __uint_as_float(rr[0]) + __uint_as_float(rr[1]); }
__device__ __forceinline__ float quad_sum(float a) {
    a += __int_as_float(__builtin_amdgcn_update_dpp(0, __float_as_int(a), 0xB1, 0xf, 0xf, true));
    a += __int_as_float(__builtin_amdgcn_update_dpp(0, __float_as_int(a), 0x4E, 0xf, 0xf, true));
    return a;
}
__device__ __forceinline__ void glds16(const void* gsrc, unsigned lds_dst) { unsigned keep;
    asm volatile("s_mov_b32 %0, m0\n\ts_mov_b32 m0, %2\n\ts_nop 0\n\tglobal_load_lds_dwordx4 %1, off\n\ts_mov_b32 m0, %0" : "=&s"(keep) : "v"(gsrc), "s"(lds_dst) : "memory"); }
#define ATT_WAIT_BAR(N) asm volatile("s_waitcnt vmcnt(" #N ") lgkmcnt(0)\n\ts_barrier" ::: "memory")
__device__ __forceinline__ void tile_dma(const bf16* Kt, const bf16* Vt, bool hasV, unsigned slot_addr, int w, int lane) {
    glds16(Kt + lane * 64 + w * 8, (unsigned)__builtin_amdgcn_readfirstlane(slot_addr + w * 1024));
    if (hasV) glds16(Vt + (16 * (w & 3) + (lane >> 2)) * 64 + (w >> 2) * 32 + (lane & 3) * 8, (unsigned)__builtin_amdgcn_readfirstlane(slot_addr + 8192 + w * 1024));
}
__device__ __forceinline__ void qk_tile(const LAS unsigned char* buf, const bf16x8 (&qf)[4], const f32x16& c, f32x16& p0, f32x16& p1, int r32, int hi) {
    const LAS unsigned char* kp = buf + hi * 1024 + r32 * 16;
    bf16x8 k0[4], k1[4];
#pragma unroll
    for (int s = 0; s < 4; ++s) { k0[s] = *(const LAS bf16x8*)(kp + s * 2048); k1[s] = *(const LAS bf16x8*)(kp + s * 2048 + 512); }
    p0 = __builtin_amdgcn_mfma_f32_32x32x16_bf16(k0[0], qf[0], c, 0, 0, 0);
    p1 = __builtin_amdgcn_mfma_f32_32x32x16_bf16(k1[0], qf[0], c, 0, 0, 0);
#pragma unroll
    for (int s = 1; s < 4; ++s) {
        p0 = __builtin_amdgcn_mfma_f32_32x32x16_bf16(k0[s], qf[s], p0, 0, 0, 0);
        p1 = __builtin_amdgcn_mfma_f32_32x32x16_bf16(k1[s], qf[s], p1, 0, 0, 0);
    }
}
template <int KSTEP>
__device__ __forceinline__ void bias_mask(f32x16& p0, f32x16& p1, const LAS float* bt, float bsub, int dbase, int wlim, int hi) {
#pragma unroll
    for (int i = 0; i < 16; ++i) {
        const int kl = (i & 3) + 8 * (i >> 2) + 4 * hi;
        const int d0 = dbase - KSTEP * kl, d1 = d0 - KSTEP * 32;
        const int i0 = min(max(d0, 0), NBT - 1), i1 = min(max(d1, 0), NBT - 1);
        const float b0 = bt[i0] - bsub, b1 = bt[i1] - bsub;
        p0[i] = (d0 >= 0 && d0 < wlim) ? p0[i] + b0 : NEG_INF;
        p1[i] = (d1 >= 0 && d1 < wlim) ? p1[i] + b1 : NEG_INF;
    }
}
__device__ __forceinline__ float rowmax32(const f32x16& p0, const f32x16& p1) {
    float a = fmaxf(fmaxf(p0[0], p1[0]), p0[1]), b = fmaxf(fmaxf(p1[1], p0[2]), p1[2]);
#pragma unroll
    for (int i = 3; i < 15; i += 2) { a = fmaxf(fmaxf(a, p0[i]), p1[i]); b = fmaxf(fmaxf(b, p0[i + 1]), p1[i + 1]); }
    a = fmaxf(fmaxf(a, p0[15]), p1[15]);
    return xhalf_max(fmaxf(a, b));
}
__device__ __forceinline__ void pv_tile(const LAS unsigned char* buf, const f32x16& p0, const f32x16& p1, f32x16 (&o)[2], int lane, int hi) {
    const LAS unsigned char* vp = buf + 8192 + ((lane >> 4) & 1) * 32 + (lane & 3) * 8 + (4 * hi + ((lane & 15) >> 2)) * 64;
    bf16x8 pa[4];
#pragma unroll
    for (int s = 0; s < 2; ++s) {
        v4u a, c;
        a.x = cvtpk(p0[8 * s + 0], p0[8 * s + 1]); a.y = cvtpk(p0[8 * s + 2], p0[8 * s + 3]); a.z = cvtpk(p0[8 * s + 4], p0[8 * s + 5]); a.w = cvtpk(p0[8 * s + 6], p0[8 * s + 7]);
        c.x = cvtpk(p1[8 * s + 0], p1[8 * s + 1]); c.y = cvtpk(p1[8 * s + 2], p1[8 * s + 3]); c.z = cvtpk(p1[8 * s + 4], p1[8 * s + 5]); c.w = cvtpk(p1[8 * s + 6], p1[8 * s + 7]);
        pa[s] = __builtin_bit_cast(bf16x8, a); pa[2 + s] = __builtin_bit_cast(bf16x8, c);
    }
#pragma unroll
    for (int ks = 0; ks < 4; ++ks)
#pragma unroll
        for (int d0 = 0; d0 < 2; ++d0) {
            const s16x4 lo = vtr(vp + d0 * 4096 + ks * 1024), hh = vtr(vp + d0 * 4096 + ks * 1024 + 512);
            const bf16x8 vf = (bf16x8){lo[0], lo[1], lo[2], lo[3], hh[0], hh[1], hh[2], hh[3]};
            o[d0] = __builtin_amdgcn_mfma_f32_32x32x16_bf16(pa[ks], vf, o[d0], 0, 0, 0);
        }
}
__device__ __forceinline__ void row_to_regs(LAS float* wsf, float v, float (&f)[16], int r32, int hi) {
    if (hi == 0) wsf[r32] = v;
#pragma unroll
    for (int u = 0; u < 4; ++u) { const f32x4 t = *(const LAS f32x4*)(wsf + 8 * u + 4 * hi); f[4 * u] = t[0]; f[4 * u + 1] = t[1]; f[4 * u + 2] = t[2]; f[4 * u + 3] = t[3]; }
}
struct SmState { float m, l; bool have; f32x16 negm; };
__device__ __forceinline__ void sm_init(SmState& st) { st.m = 0.f; st.l = 0.f; st.have = false; st.negm = f32x16{}; }
template <bool HASO>
__device__ __forceinline__ void sm_rebase(SmState& st, f32x16& p0, f32x16& p1, f32x16 (&o)[2], LAS float* wsf, int r32, int hi) {
    const float mx = rowmax32(p0, p1);
    const bool fin = mx > NEG_INF;
    const bool trig = st.have ? (mx > THR) : fin;
    if (__any(trig)) {
        const float dl = st.have ? fmaxf(mx, 0.f) : (fin ? mx : 0.f);
        const float alpha = st.have ? __builtin_amdgcn_exp2f(-dl) : 1.0f;
        st.m += dl; st.l *= alpha; st.have = st.have || fin;
#pragma unroll
        for (int i = 0; i < 16; ++i) { p0[i] -= dl; p1[i] -= dl; st.negm[i] -= dl; }
        if (HASO) { float f[16]; row_to_regs(wsf, alpha, f, r32, hi);
#pragma unroll
            for (int i = 0; i < 16; ++i) { o[0][i] *= f[i]; o[1][i] *= f[i]; } }
    }
}
__device__ __forceinline__ float exp_sum(f32x16& p0, f32x16& p1) {
    float s0 = 0.f, s1 = 0.f;
#pragma unroll
    for (int i = 0; i < 16; ++i) { p0[i] = __builtin_amdgcn_exp2f(p0[i]); p1[i] = __builtin_amdgcn_exp2f(p1[i]); s0 += p0[i]; s1 += p1[i]; }
    return s0 + s1;
}

__device__ __forceinline__ void attn_item(Frame& F, int b, int g, int qb) {
    const int tid = F.tid, lane = F.lane, w = F.wave, r32 = lane & 31, hi = lane >> 5, qi = r32 >> 2, r = r32 & 3;
    const int t0 = qb * 64, tl = 8 * w + qi, tpos = t0 + tl;
    LAS unsigned char* lds = F.lds;
    const unsigned lds0 = (unsigned)(uintptr_t)lds;
    LAS float* imp = (LAS float*)(lds + L_IMP);
    LAS float* btab = (LAS float*)(lds + L_BTAB);
    LAS float* wsf = (LAS float*)(lds + L_WSF) + w * 64;
    LAS unsigned* selm = (LAS unsigned*)(lds + L_SELM);
    LAS unsigned* uni = (LAS unsigned*)(lds + L_UNI);
    const bf16* KVb = (const bf16*)(F.ws + WS_KV);
    const size_t bgoff = (size_t)(b * 2 + g) * 8192 * 64;
    const bf16* ksb = KVb + 2 * KV_TENS + bgoff; const bf16* vsb = KVb + 3 * KV_TENS + bgoff;
    const bf16* kwb = KVb + 4 * KV_TENS + bgoff; const bf16* vwb = KVb + 5 * KV_TENS + bgoff;
    const bf16* kcb = (const bf16*)(F.ws + WS_KC) + (size_t)(b * 2 + g) * 512 * 64;
    const bf16* vcb = (const bf16*)(F.ws + WS_VC) + (size_t)(b * 2 + g) * 512 * 64;
    { const float* rb = F.in[11];
      for (int i = tid; i < 4 * NBT; i += 512) { const int rr = i / NBT, d = i - rr * NBT; btab[i] = rb[t5_bucket(d) * 8 + 4 * g + rr] * LOG2E; } }
    for (int i = lane; i < 8 * IMP_STR; i += 64) imp[8 * w * IMP_STR + i] = 0.f;
    bf16x8 qf[4];
    { const bf16* Qp = (const bf16*)(F.ws + WS_Q) + ((size_t)(b * 8192 + tpos) * 512 + (4 * g + r) * 64 + 8 * hi);
#pragma unroll
      for (int s = 0; s < 4; ++s) qf[s] = *(const GAS bf16x8*)(Qp + 16 * s); }
    float gate[3];
    { const float* gp = (const float*)(F.ws + WS_G) + (size_t)(b * 8192 + tpos) * 32 + (4 * g + r) * 3; gate[0] = gp[0]; gate[1] = gp[1]; gate[2] = gp[2]; }
    const float bfar = F.in[11][31 * 8 + 4 * g + r] * LOG2E;
    const LAS float* bt = btab + r * NBT;
    LAS float* oaccp = (LAS float*)(lds + L_OACC) + w * 2048 + lane;
    asm volatile("s_waitcnt vmcnt(0)" ::: "memory");
    __syncthreads();

    const int nct = (4 * qb + 3 + 63) >> 6;
    const int dcb = tpos - 31;
    SmState sc; sm_init(sc);
    f32x16 oc[2]; oc[0] = f32x16{}; oc[1] = f32x16{};
    tile_dma(kcb, vcb, false, lds0 + L_RING, w, lane);
    if (nct > 1) { tile_dma(kcb + 4096, vcb, false, lds0 + L_RING + SLOT, w, lane); ATT_WAIT_BAR(1); } else { ATT_WAIT_BAR(0); }
    for (int c = 0, sl = 0; c < nct; ++c) {
        const int sl2 = sl >= SLOT ? sl - SLOT : sl + 2 * SLOT;
        if (c + 2 < nct) tile_dma(kcb + (size_t)(c + 2) * 4096, vcb, false, lds0 + L_RING + sl2, w, lane);
        f32x16 p0, p1; qk_tile(lds + L_RING + sl, qf, sc.negm, p0, p1, r32, hi);
        bias_mask<16>(p0, p1, bt, 0.f, dcb - 1024 * c, 1 << 30, hi);
        sm_rebase<false>(sc, p0, p1, oc, wsf, r32, hi);
        sc.l += exp_sum(p0, p1);
        if (c + 2 < nct) { ATT_WAIT_BAR(1); } else { ATT_WAIT_BAR(0); }
        sl = sl == 2 * SLOT ? 0 : sl + SLOT;
    }
    const float lc = xhalf_sum(sc.l);
    const float ilc = lc > 0.f ? 1.0f / lc : 0.f;
    {
        tile_dma(kcb, vcb, true, lds0 + L_RING, w, lane);
        if (nct > 1) { tile_dma(kcb + 4096, vcb + 4096, true, lds0 + L_RING + SLOT, w, lane); ATT_WAIT_BAR(2); } else { ATT_WAIT_BAR(0); }
        for (int c = 0, sl = 0; c < nct; ++c) {
            const int sl2 = sl >= SLOT ? sl - SLOT : sl + 2 * SLOT;
            if (c + 2 < nct) tile_dma(kcb + (size_t)(c + 2) * 4096, vcb + (size_t)(c + 2) * 4096, true, lds0 + L_RING + sl2, w, lane);
            f32x16 p0, p1; qk_tile(lds + L_RING + sl, qf, sc.negm, p0, p1, r32, hi);
            bias_mask<16>(p0, p1, bt, 0.f, dcb - 1024 * c, 1 << 30, hi);
#pragma unroll
            for (int i = 0; i < 16; ++i) { p0[i] = __builtin_amdgcn_exp2f(p0[i]) * ilc; p1[i] = __builtin_amdgcn_exp2f(p1[i]) * ilc; }
#pragma unroll
            for (int a = 0; a < 2; ++a)
#pragma unroll
                for (int u = 0; u < 4; ++u) {
                    const float x0 = a ? p1[4 * u] : p0[4 * u], x1 = a ? p1[4 * u + 1] : p0[4 * u + 1], x2 = a ? p1[4 * u + 2] : p0[4 * u + 2], x3 = a ? p1[4 * u + 3] : p0[4 * u + 3];
                    const float mainv = quad_sum((x0 + x1) + (x2 + 0.5f * x3)), spill = quad_sum(0.5f * x3);
                    const int j = 16 * c + 8 * a + 2 * u + hi;
                    if (r == 0) { (void)__hip_atomic_fetch_add(&imp[(8 * w + qi) * IMP_STR + j], mainv, __ATOMIC_RELAXED, __HIP_MEMORY_SCOPE_WORKGROUP); if (j + 1 < 128) (void)__hip_atomic_fetch_add(&imp[(8 * w + qi) * IMP_STR + j + 1], spill, __ATOMIC_RELAXED, __HIP_MEMORY_SCOPE_WORKGROUP); }
                }
            pv_tile(lds + L_RING + sl, p0, p1, oc, lane, hi);
            if (c + 2 < nct) { ATT_WAIT_BAR(2); } else { ATT_WAIT_BAR(0); }
            sl = sl == 2 * SLOT ? 0 : sl + SLOT;
        }
    }
    unsigned wu0 = 0u, wu1 = 0u, wu2 = 0u, wu3 = 0u;
    for (int qq = 0; qq < 8; ++qq) {
        const int q = 8 * w + qq;
        const float v0 = imp[q * IMP_STR + lane], v1 = imp[q * IMP_STR + 64 + lane];
        const int j0 = lane, j1 = 64 + lane;
        const bool val0 = j0 <= qb, val1 = j1 <= qb;
        const bool fo0 = (j0 == 0) || (j0 == qb) || (j0 == qb - 1), fo1 = (j1 == qb) || (j1 == qb - 1);
        const unsigned k0 = !val0 ? 0u : (fo0 ? 0x7f000000u : __float_as_uint(v0) + 1u);
        const unsigned k1 = !val1 ? 0u : (fo1 ? 0x7f000000u : __float_as_uint(v1) + 1u);
        unsigned Tt = 0u;
        for (int bit = 30; bit >= 0; --bit) {
            const unsigned cand = Tt | (1u << bit);
            const int cnt = __popcll(__ballot(k0 >= cand)) + __popcll(__ballot(k1 >= cand));
            if (cnt >= 16) Tt = cand;
        }
        const bool gt0 = k0 > Tt, gt1 = k1 > Tt, eq0 = k0 == Tt, eq1 = k1 == Tt;
        const unsigned long long e0 = __ballot(eq0), e1 = __ballot(eq1);
        const int ngt = __popcll(__ballot(gt0)) + __popcll(__ballot(gt1)); const int need = 16 - ngt;
        const unsigned long long below = (1ull << lane) - 1ull;
        const int pre0 = __popcll(e0 & below), pre1 = __popcll(e0) + __popcll(e1 & below);
        const bool s0 = val0 && (gt0 || (eq0 && pre0 < need)), s1 = val1 && (gt1 || (eq1 && pre1 < need));
        const unsigned long long m0 = __ballot(s0), m1 = __ballot(s1);
        const unsigned a0 = (unsigned)m0, a1 = (unsigned)(m0 >> 32), a2 = (unsigned)m1, a3 = (unsigned)(m1 >> 32);
        if (lane == 0) { selm[q * 4 + 0] = a0; selm[q * 4 + 1] = a1; selm[q * 4 + 2] = a2; selm[q * 4 + 3] = a3; }
        wu0 |= a0; wu1 |= a1; wu2 |= a2; wu3 |= a3;
    }
    if (lane == 0) { uni[w * 4 + 0] = wu0; uni[w * 4 + 1] = wu1; uni[w * 4 + 2] = wu2; uni[w * 4 + 3] = wu3; }
    __syncthreads();
    { float f[16]; row_to_regs(wsf, gate[0], f, r32, hi);
#pragma unroll
      for (int i = 0; i < 16; ++i) { oaccp[i * 64] = oc[0][i] * f[i]; oaccp[(16 + i) * 64] = oc[1][i] * f[i]; } }
    unsigned mym[4], bu[4] = {0u, 0u, 0u, 0u};
#pragma unroll
    for (int k = 0; k < 4; ++k) { mym[k] = selm[(8 * w + qi) * 4 + k];
#pragma unroll
        for (int ww = 0; ww < 8; ++ww) bu[k] |= uni[ww * 4 + k]; }
    unsigned wuv[4] = {wu0, wu1, wu2, wu3};
#pragma unroll
    for (int k = 0; k < 4; ++k) { bu[k] = __builtin_amdgcn_readfirstlane(bu[k]); wuv[k] = __builtin_amdgcn_readfirstlane(wuv[k]); }
#ifndef REP_SEL
#define REP_SEL 1
#endif
#ifndef REP_WIN
#define REP_WIN 1
#endif
#ifndef REP_CMP
#define REP_CMP 1
#endif
    for (int rep_ = 0; rep_ < REP_SEL; ++rep_) {
        f32x16 o[2]; o[0] = f32x16{}; o[1] = f32x16{}; SmState ss; sm_init(ss);
#define NEXT_SEL(from, dst) do { dst = -1; for (int j_ = (from); j_ <= qb; ++j_) if ((bu[j_ >> 5] >> (j_ & 31)) & 1u) { dst = j_; break; } } while (0)
        int j0, j1, j2;
        NEXT_SEL(0, j0); j1 = -1; j2 = -1; if (j0 >= 0) NEXT_SEL(j0 + 1, j1);
        if (j0 >= 0) tile_dma(ksb + (size_t)j0 * 4096, vsb + (size_t)j0 * 4096, true, lds0 + L_RING, w, lane);
        if (j1 >= 0) { tile_dma(ksb + (size_t)j1 * 4096, vsb + (size_t)j1 * 4096, true, lds0 + L_RING + SLOT, w, lane); ATT_WAIT_BAR(2); } else { ATT_WAIT_BAR(0); }
        int sl = 0;
        while (j0 >= 0) {
            const int sl2 = sl >= SLOT ? sl - SLOT : sl + 2 * SLOT;
            j2 = -1; if (j1 >= 0) NEXT_SEL(j1 + 1, j2);
            if (j2 >= 0) tile_dma(ksb + (size_t)j2 * 4096, vsb + (size_t)j2 * 4096, true, lds0 + L_RING + sl2, w, lane);
            if ((wuv[j0 >> 5] >> (j0 & 31)) & 1u) {
                const bool mine = (mym[j0 >> 5] >> (j0 & 31)) & 1u;
                f32x16 c;
#pragma unroll
                for (int i = 0; i < 16; ++i) c[i] = mine ? ss.negm[i] : NEG_INF;
                f32x16 p0, p1; qk_tile(lds + L_RING + sl, qf, c, p0, p1, r32, hi);
                if (qb - j0 < 14) bias_mask<1>(p0, p1, bt, bfar, tpos - 64 * j0, 1 << 30, hi);
                sm_rebase<true>(ss, p0, p1, o, wsf, r32, hi);
                ss.l += exp_sum(p0, p1);
                pv_tile(lds + L_RING + sl, p0, p1, o, lane, hi);
            }
            if (j2 >= 0) { ATT_WAIT_BAR(2); } else { ATT_WAIT_BAR(0); }
            sl = sl == 2 * SLOT ? 0 : sl + SLOT;
            j0 = j1; j1 = j2;
        }
#undef NEXT_SEL
        const float ls = xhalf_sum(ss.l);
        float f[16]; row_to_regs(wsf, ls > 0.f ? gate[1] / (ls * REP_SEL) : 0.f, f, r32, hi);
#pragma unroll
        for (int i = 0; i < 16; ++i) { oaccp[i * 64] += o[0][i] * f[i]; oaccp[(16 + i) * 64] += o[1][i] * f[i]; }
    }
    {
        f32x16 o[2]; o[0] = f32x16{}; o[1] = f32x16{}; SmState sw; sm_init(sw);
        const int jf = qb >= 8 ? qb - 8 : 0;
        tile_dma(kwb + (size_t)jf * 4096, vwb + (size_t)jf * 4096, true, lds0 + L_RING, w, lane);
        if (jf + 1 <= qb) { tile_dma(kwb + (size_t)(jf + 1) * 4096, vwb + (size_t)(jf + 1) * 4096, true, lds0 + L_RING + SLOT, w, lane); ATT_WAIT_BAR(2); } else { ATT_WAIT_BAR(0); }
        for (int j = jf, sl = 0; j <= qb; ++j) {
            const int sl2 = sl >= SLOT ? sl - SLOT : sl + 2 * SLOT;
            if (j + 2 <= qb) tile_dma(kwb + (size_t)(j + 2) * 4096, vwb + (size_t)(j + 2) * 4096, true, lds0 + L_RING + sl2, w, lane);
            f32x16 p0, p1; qk_tile(lds + L_RING + sl, qf, sw.negm, p0, p1, r32, hi);
            bias_mask<1>(p0, p1, bt, 0.f, tpos - 64 * j, 512, hi);
            sm_rebase<true>(sw, p0, p1, o, wsf, r32, hi);
            sw.l += exp_sum(p0, p1);
            pv_tile(lds + L_RING + sl, p0, p1, o, lane, hi);
            if (j + 2 <= qb) { ATT_WAIT_BAR(2); } else { ATT_WAIT_BAR(0); }
            sl = sl == 2 * SLOT ? 0 : sl + SLOT;
        }
        const float lw = xhalf_sum(sw.l);
        float f[16]; row_to_regs(wsf, lw > 0.f ? gate[2] / lw : 0.f, f, r32, hi);
#pragma unroll
        for (int i = 0; i < 16; ++i) { o[0][i] = oaccp[i * 64] + o[0][i] * f[i]; o[1][i] = oaccp[(16 + i) * 64] + o[1][i] * f[i]; }
        asm volatile("" ::: "memory");
        LAS unsigned short* stg = (LAS unsigned short*)(lds + L_OACC + w * 8192);
#pragma unroll
        for (int i = 0; i < 16; ++i) { const int orow = (i & 3) + 8 * (i >> 2) + 4 * hi;
            stg[orow * 64 + r32] = (unsigned short)f2bf(o[0][i]); stg[orow * 64 + 32 + r32] = (unsigned short)f2bf(o[1][i]); }
        LDS_WAIT();
        bf16* MIX = (bf16*)(F.ws + WS_MIX);
#pragma unroll
        for (int i = 0; i < 4; ++i) { const int row = i * 8 + (lane >> 3), ch = lane & 7; const v4u v = *(const LAS v4u*)(stg + row * 64 + ch * 8);
            *(GAS v4u*)(MIX + (size_t)(b * 8192 + t0 + 8 * w + (row >> 2)) * 1024 + (4 * g + (row & 3)) * 64 + ch * 8) = v; }
    }
    __syncthreads();
}
}

__device__ __forceinline__ void p4_phase(Frame& F) {
    {
        const bf16* Z = (const bf16*)(F.ws + WS_Z); const bf16* BG = (const bf16*)(F.ws + WS_BG); bf16* MIX = (bf16*)(F.ws + WS_MIX);
        const float* cw = F.in[12];
        const int ch = F.tid & 63, rsub = F.tid >> 6;
        f32x4 w0a = *(const f32x4*)(cw + 8 * ch), w0b = *(const f32x4*)(cw + 8 * ch + 4), w1a = *(const f32x4*)(cw + 512 + 8 * ch), w1b = *(const f32x4*)(cw + 512 + 8 * ch + 4), w2a = *(const f32x4*)(cw + 1024 + 8 * ch), w2b = *(const f32x4*)(cw + 1024 + 8 * ch + 4);
        for (int rb = blockIdx.x; rb < M / 8; rb += F.G) {
            const int row = 8 * rb + rsub, t = row & 8191;
            const v4u z2 = *(const GAS v4u*)(Z + (size_t)row * 512 + 8 * ch);
            v4u z1 = (v4u){0u, 0u, 0u, 0u}, z0 = (v4u){0u, 0u, 0u, 0u};
            if (t >= 1) z1 = *(const GAS v4u*)(Z + (size_t)(row - 1) * 512 + 8 * ch);
            if (t >= 2) z0 = *(const GAS v4u*)(Z + (size_t)(row - 2) * 512 + 8 * ch);
            const v4u bg = *(const GAS v4u*)(BG + (size_t)row * 512 + 8 * ch);
            float o[8];
#define CV(k, comp, sh, wa, wi) o[k] = bf2f((unsigned short)((bg.comp >> sh) & 0xffff)) * (w0##wa[wi] * bf2f((unsigned short)((z0.comp >> sh) & 0xffff)) + w1##wa[wi] * bf2f((unsigned short)((z1.comp >> sh) & 0xffff)) + w2##wa[wi] * bf2f((unsigned short)((z2.comp >> sh) & 0xffff)))
            CV(0, x, 0, a, 0); CV(1, x, 16, a, 1); CV(2, y, 0, a, 2); CV(3, y, 16, a, 3); CV(4, z, 0, b, 0); CV(5, z, 16, b, 1); CV(6, w, 0, b, 2); CV(7, w, 16, b, 3);
#undef CV
            v4u ov; ov.x = pk2(o[0], o[1]); ov.y = pk2(o[2], o[3]); ov.z = pk2(o[4], o[5]); ov.w = pk2(o[6], o[7]);
            *(GAS v4u*)(MIX + (size_t)row * 1024 + 512 + 8 * ch) = ov;
        }
    }
    asm volatile("s_waitcnt vmcnt(0)" ::: "memory");
    for (int rd = 0; rd * F.G < 1024; ++rd) {
        const int pos = (rd & 1) ? (F.G - 1 - (int)blockIdx.x) : (int)blockIdx.x;
        const int k = rd * F.G + pos; if (k >= 1024) continue;
        const int qb = 127 - (k >> 3), bg = k & 7;
        att::attn_item(F, bg >> 1, bg & 1, qb);
    }
}

struct Args { const float* in[20]; float* out; unsigned char* ws; int ph_lo, ph_hi; };
__global__ void __launch_bounds__(NWAVES * 64, 2) mk_fwd(Args args) {
    extern __shared__ __attribute__((aligned(16))) unsigned char lds[];
    Frame F;
    F.lds = (LAS unsigned char*)lds;
    F.MISC = (volatile LAS unsigned*)(F.lds + MISC_OFF);
    F.tid = threadIdx.x; F.lane = F.tid & 63; F.wave = __builtin_amdgcn_readfirstlane(F.tid >> 6);
    F.G = gridDim.x; { const int bx = blockIdx.x; F.vcu = (F.G % 8 == 0) ? (bx % 8) * (F.G / 8) + bx / 8 : bx; }
    F.ws = args.ws; F.out = args.out; F.ctl = (gu32*)(args.ws + WS_CTL);
#pragma unroll
    for (int i = 0; i < 20; ++i) F.in[i] = args.in[i];
    for (int u = F.tid; u < (LDS_BYTES - LDSCTL_OFF) / 4; u += NWAVES * 64) ((LAS unsigned*)(F.lds + LDSCTL_OFF))[u] = 0u;
    __syncthreads();
    const int lo = args.ph_lo, hi = args.ph_hi;
    const bool one = (hi - lo) > 1;
    XcdBarrier bar; bar.bar = (unsigned*)(F.ctl + CW_BAR); bar.x = 0; bar.st = nullptr;
    if (one) bar = xcd_barrier_post((unsigned*)(F.ctl + CW_BAR), F.MISC + 8);
#ifdef ONLY_PHASE
#define IN(k) ((k) == ONLY_PHASE && lo <= (k) && (k) < hi)
#else
#define IN(k) (lo <= (k) && (k) < hi)
#endif
#ifndef REP_MASK
#define REP_MASK 0
#endif
#define REPS(k) for (int rep_ = 0; rep_ < 1 + ((REP_MASK >> (k)) & 1); ++rep_)
#define SEAM(k) do { if (IN(k) && IN((k) + 1)) xcd_barrier(bar); } while (0)
    unsigned char* ws = args.ws;
#ifdef PROBE_PHASE
    unsigned long long tp0_ = 0, tp1_ = 0;
#define TPS(k) do { if ((k) == PROBE_PHASE) tp0_ = __builtin_amdgcn_s_memrealtime(); if ((k) == PROBE_END) tp1_ = __builtin_amdgcn_s_memrealtime(); } while (0)
#else
#define TPS(k) do {} while (0)
#endif
    TPS(0);
    if (IN(0)) { REPS(0) p0_phase(F); SEAM(0); }
    TPS(1);
    if (IN(1)) { REPS(1) p1_phase(F); SEAM(1); }
    TPS(2);
    if (IN(2)) {
        pg8::Gemm g{(const pg8::bf16_t*)(ws + WS_H), (const pg8::bf16_t*)(ws + WS_WIN), M, NIN, D}; pg8::StaticOrder S; S.init(M, NIN, F.G, (int)blockIdx.x);
        pg8::EpiInProj E{(pg8::bf16_t*)(ws + WS_Q), (pg8::bf16_t*)(ws + WS_KV), (pg8::bf16_t*)(ws + WS_Z), (pg8::bf16_t*)(ws + WS_BG), (float*)(ws + WS_G), F.in[3], F.in[4]};
        pg8::gemm_phase<pg8::EpiInProj, pg8::StaticOrder, true, true>(F.lds, g, S, E);
#ifdef DUP_P2
        pg8::gemm_phase<pg8::EpiInProj, pg8::StaticOrder, true, true>(F.lds, g, S, E);
#endif
        SEAM(2);
    }
    TPS(3);
    if (IN(3)) { REPS(3) p3_phase(F); SEAM(3); }
    TPS(4);
    if (IN(4)) { REPS(4) p4_phase(F); SEAM(4); }
    TPS(5);
    if (IN(5)) {
        pg8::Gemm g{(const pg8::bf16_t*)(ws + WS_MIX), (const pg8::bf16_t*)(ws + WS_WOUT), M, D, D}; pg8::StaticOrder S; S.init(M, D, F.G, (int)blockIdx.x);
        pg8::EpiOutProj E{F.in[0], F.out, (pg8::bf16_t*)(ws + WS_A2), (float*)(ws + WS_RSS), (const float*)(ws + WS_MOD), F.in[15]};
        REPS(5) pg8::gemm_phase<pg8::EpiOutProj, pg8::StaticOrder, true, true>(F.lds, g, S, E);
        SEAM(5);
    }
    TPS(6);
    if (IN(6)) {
        pg8::Gemm g{(const pg8::bf16_t*)(ws + WS_A2), (const pg8::bf16_t*)(ws + WS_W1), M, FF, D}; pg8::StaticOrder S; S.init(M, FF, F.G, (int)blockIdx.x);
        pg8::EpiFF1 E{(pg8::bf16_t*)(ws + WS_HID), (const float*)(ws + WS_RSS), (const float*)(ws + WS_BFF1)};
        REPS(6) pg8::gemm_phase<pg8::EpiFF1, pg8::StaticOrder, true, true>(F.lds, g, S, E);
        SEAM(6);
    }
    TPS(7);
    if (IN(7)) {
        pg8::Gemm g{(const pg8::bf16_t*)(ws + WS_HID), (const pg8::bf16_t*)(ws + WS_W2), M, D, FF}; pg8::StaticOrder S; S.init(M, D, F.G, (int)blockIdx.x);
#ifdef DUP_P7
        { pg8::EpiFF2 E0{F.out, (const float*)(ws + WS_MOD), (float*)(ws + (size_t)380 * MiB)};
          pg8::gemm_phase<pg8::EpiFF2, pg8::StaticOrder, true, true>(F.lds, g, S, E0); }
#endif
        pg8::EpiFF2 E{F.out, (const float*)(ws + WS_MOD), F.out};
        pg8::gemm_phase<pg8::EpiFF2, pg8::StaticOrder, true, true>(F.lds, g, S, E);
    }
    TPS(8);
#ifdef PROBE_PHASE
    if (blockIdx.x == 0 && F.tid == 0) { const unsigned long long until = __builtin_amdgcn_s_memrealtime() + (unsigned long long)PROBE_MULT * (tp1_ - tp0_);
        while (__builtin_amdgcn_s_memrealtime() < until) __builtin_amdgcn_s_sleep(8); }
#endif
#undef IN
#undef SEAM
}

extern "C" void kernel_launch(void* const* d_in, const int* in_sizes, int n_in, void* d_out, int out_size, void* d_ws, size_t ws_size, hipStream_t stream) {
    static int grid = 0;
    if (grid == 0) {
        if (n_in != 20 || in_sizes[0] != M * D || out_size != M * D || ws_size < WS_END) { fprintf(stderr, "kernel_launch: unexpected problem shape (n_in %d, in0 %d, out %d, ws %zu)\n", n_in, n_in > 0 ? in_sizes[0] : -1, out_size, ws_size); grid = -1; return; }
        int dev = 0, cus = 0, per_cu = 0;
        if (hipGetDevice(&dev) != hipSuccess || hipDeviceGetAttribute(&cus, hipDeviceAttributeMultiprocessorCount, dev) != hipSuccess) { grid = -1; return; }
        if (hipFuncSetAttribute((const void*)mk_fwd, hipFuncAttributeMaxDynamicSharedMemorySize, LDS_BYTES) != hipSuccess) { fprintf(stderr, "kernel_launch: hipFuncSetAttribute failed\n"); grid = -1; return; }
        if (hipOccupancyMaxActiveBlocksPerMultiprocessor(&per_cu, (const void*)mk_fwd, NWAVES * 64, LDS_BYTES) != hipSuccess || per_cu < 1) { fprintf(stderr, "kernel_launch: occupancy query says %d blocks per CU\n", per_cu); (void)hipGetLastError(); per_cu = 1; }
        grid = cus * 1;
        if (per_cu < 1) grid = -1;
    }
    if (grid < 0) return;
    (void)hipMemsetAsync((char*)d_ws + WS_CTL, 0, CTL_ZERO_BYTES, stream);
    Args a{};
    for (int i = 0; i < 20; ++i) a.in[i] = (const float*)d_in[i];
    a.out = (float*)d_out; a.ws = (unsigned char*)d_ws;
    if (MK_N_LAUNCHES == 1) {
        a.ph_lo = 0; a.ph_hi = N_PHASES;
        void* kargs[] = {&a};
        hipError_t e = hipLaunchCooperativeKernel((const void*)mk_fwd, dim3(grid), dim3(NWAVES * 64), kargs, LDS_BYTES, stream);
        if (e != hipSuccess) fprintf(stderr, "kernel_launch: cooperative launch failed: %s (grid %d)\n", hipGetErrorString(e), grid);
    } else {
        for (int p = 0; p < N_PHASES; ++p) { a.ph_lo = p; a.ph_hi = p + 1; hipLaunchKernelGGL(mk_fwd, dim3(grid), dim3(NWAVES * 64), LDS_BYTES, stream, a); }
    }
}
```

```cpp
#include <hip/hip_runtime.h>
#include <hip/hip_bf16.h>
#include <cstdio>
#include <cstdint>
#include <cmath>
namespace pg8 {
#define PG8_LAS __attribute__((address_space(3)))
typedef unsigned short bf16_t;
typedef short bf16x8 __attribute__((ext_vector_type(8)));
typedef float f32x4 __attribute__((ext_vector_type(4)));
typedef unsigned u32x4 __attribute__((ext_vector_type(4)));
constexpr int BM = 256, BK = 64, HALF = 128, HTB = HALF * BK * 2  , STAGE_BYTES = 8 * HTB, NXCD = 8, WGM = 8;

__host__ __device__ __forceinline__ int lds_byte(int r, int c) { const int st = (r >> 4) * 2 + (c >> 5), rr = r & 15, cc = c & 31, ob = rr * 64 + cc * 2; return st * 1024 + (ob ^ (((ob >> 9) & 1) << 5)); }
__host__ __device__ __forceinline__ void stage_rc(int b, int& R, int& C) { const int st = b / 1024, sb = b % 1024, swz = sb ^ (((sb >> 9) & 1) << 5); R = (st >> 1) * 16 + swz / 64; C = (st & 1) * 32 + (swz % 64) / 2; }
__host__ __device__ __forceinline__ int perm32(int rho) { const int n = rho >> 4, i = rho & 15; return 8 * (i >> 2) + 4 * n + (i & 3); }

struct Unit { int pm, pn; };
struct Gemm { const bf16_t* A; const bf16_t* Bt; int M, N, K; };

struct StaticOrder {
    int nM, nN, nwg, G, c;
    __host__ __device__ void init(int M, int N, int G_, int c_) { nM = M / BM; nN = N / BM; nwg = nM * nN; G = G_; c = c_; }
    __host__ __device__ bool next(int i, Unit& u) const {
        const long L = (long)i * G + c; if (L >= nwg) return false;
        int wgid = (int)L; { const int q = nwg / NXCD, r = nwg % NXCD, xcd = wgid % NXCD, off = wgid / NXCD; wgid = (xcd < r ? xcd * (q + 1) : r * (q + 1) + (xcd - r) * q) + off; }
        const int nig = WGM * nN, gid = wgid / nig, fm = gid * WGM, gsz = (nM - fm) < WGM ? (nM - fm) : WGM;
        u.pm = fm + ((wgid % nig) % gsz); u.pn = (wgid % nig) / gsz; return true;
    }
    __device__ __forceinline__ void a_ready(const Unit&) const {}
    __device__ __forceinline__ void done(const Unit&) const {}
};

__device__ __forceinline__ unsigned cvt_pk_bf16(float lo, float hi) { unsigned r; asm volatile("v_cvt_pk_bf16_f32 %0, %1, %2" : "=v"(r) : "v"(lo), "v"(hi)); return r; }
typedef float f32x2 __attribute__((ext_vector_type(2)));
template <class Epi, class Sched, bool ALIGN_EPI = false, bool SP2 = false>
__device__ __forceinline__ void gemm_phase(PG8_LAS unsigned char* lds, const Gemm g, const Sched& S, const Epi& E) {
    const int tid = threadIdx.x, wid = __builtin_amdgcn_readfirstlane(tid >> 6), lane = tid & 63, wr = wid >> 2, wc = wid & 3, fr = lane & 15, fq = lane >> 4;
    const int K = g.K, nt = K / BK;
    unsigned voffA[2], voffB[2];
#pragma unroll
    for (int i = 0; i < 2; ++i) { int R, C; stage_rc(tid * 16 + i * 8192, R, C); const int Rb = Epi::PERM ? ((R & ~31) + perm32(R & 31)) : R;
        voffA[i] = (unsigned)(R * K + C) * 2u; voffB[i] = (unsigned)(Rb * K + C) * 2u; }
    const size_t kstep = (size_t)(BK * 2);
    const size_t hstep = (size_t)HALF * K * 2;
    const size_t tstep = 2 * hstep;
    const unsigned ldsw = (unsigned)wid * 1024u;
    const int aoff = lds_byte(wr * 64 + fr, fq * 8), boff = lds_byte(wc * 32 + fr, fq * 8);
#define PG8_SA(b, h) (((b) * 2 + (h)) * HTB)
#define PG8_SB(b, h) ((4 + (b) * 2 + (h)) * HTB)
#define PG8_STAGE(bufoff, gbase, voff) do { _Pragma("unroll") for (int _i = 0; _i < 2; ++_i) \
        __builtin_amdgcn_global_load_lds((const unsigned*)((const char*)(gbase) + (voff)[_i]), (PG8_LAS unsigned*)(lds + (bufoff) + ldsw + _i * 8192), 16, 0, 0); } while (0)
#define PG8_LDA(dst, b, h) do { _Pragma("unroll") for (int m = 0; m < 4; ++m) _Pragma("unroll") for (int k = 0; k < 2; ++k) dst[m][k] = *(const PG8_LAS bf16x8*)(lds + PG8_SA(b, h) + aoff + m * 2048 + k * 1024); } while (0)
#define PG8_LDB(dst, b, h) do { _Pragma("unroll") for (int n = 0; n < 2; ++n) _Pragma("unroll") for (int k = 0; k < 2; ++k) dst[n][k] = *(const PG8_LAS bf16x8*)(lds + PG8_SB(b, h) + boff + n * 2048 + k * 1024); } while (0)
#define PG8_MMA(ai, bj, At, Bt) do { __builtin_amdgcn_s_setprio(1); _Pragma("unroll") for (int m = 0; m < 4; ++m) _Pragma("unroll") for (int n = 0; n < 2; ++n) _Pragma("unroll") for (int k = 0; k < 2; ++k) \
        acc[ai][bj][m][n] = __builtin_amdgcn_mfma_f32_16x16x32_bf16(Bt[n][k], At[m][k], acc[ai][bj][m][n], 0, 0, 0); __builtin_amdgcn_s_setprio(0); } while (0)
#define PG8_WAIT_V(n) asm volatile("s_waitcnt vmcnt(" #n ")" ::: "memory")
#define PG8_WAIT_L(n) asm volatile("s_waitcnt lgkmcnt(" #n ")" ::: "memory")
#define PG8_BAR __builtin_amdgcn_s_barrier()
#define PG8_SCHED __builtin_amdgcn_sched_barrier(0)
    Unit cur, nxt; int ui = 0;
    if (!S.next(0, cur)) return;
    f32x4 acc[2][2][4][2];
#pragma unroll
    for (int a = 0; a < 2; ++a)
#pragma unroll
        for (int b = 0; b < 2; ++b)
#pragma unroll
            for (int m = 0; m < 4; ++m)
#pragma unroll
                for (int n = 0; n < 2; ++n) acc[a][b][m][n] = (f32x4){0.f, 0.f, 0.f, 0.f};
    bf16x8 At[4][2], B0[2][2], B1[2][2];
    const char* cA = (const char*)g.A + (size_t)cur.pm * tstep; const char* cB = (const char*)g.Bt + (size_t)cur.pn * tstep;
    S.a_ready(cur);
    if constexpr (SP2) {
        PG8_STAGE(PG8_SB(0, 0), cB, voffB); PG8_STAGE(PG8_SB(0, 1), cB + hstep, voffB); PG8_STAGE(PG8_SA(0, 0), cA, voffA); PG8_STAGE(PG8_SA(0, 1), cA + hstep, voffA);
        if (wr == 1) PG8_BAR;
        PG8_WAIT_V(2); PG8_BAR;
        PG8_STAGE(PG8_SB(1, 0), cB + kstep, voffB); PG8_STAGE(PG8_SA(1, 0), cA + kstep, voffA); PG8_STAGE(PG8_SB(1, 1), cB + hstep + kstep, voffB);
        PG8_WAIT_V(6); PG8_BAR;
    } else {
        PG8_STAGE(PG8_SB(0, 0), cB, voffB); PG8_STAGE(PG8_SA(0, 0), cA, voffA); PG8_STAGE(PG8_SB(0, 1), cB + hstep, voffB); PG8_STAGE(PG8_SA(0, 1), cA + hstep, voffA);
        if (wr == 1) PG8_BAR;
        PG8_WAIT_V(4); PG8_BAR;
        PG8_STAGE(PG8_SB(1, 0), cB + kstep, voffB); PG8_STAGE(PG8_SA(1, 0), cA + kstep, voffA); PG8_STAGE(PG8_SB(1, 1), cB + hstep + kstep, voffB);
        PG8_WAIT_V(6); PG8_BAR;
    }
    for (;;) {
        const bool has_next = S.next(ui + 1, nxt);
        const char* nA = has_next ? (const char*)g.A + (size_t)nxt.pm * tstep : cA; const char* nB = has_next ? (const char*)g.Bt + (size_t)nxt.pn * tstep : cB;
        for (int t = 0; t < nt; t += 2) {
            const bool last = (t == nt - 2);
            const char* a1 = cA + (size_t)(t + 1) * kstep;
            const char* a2 = last ? nA : cA + (size_t)(t + 2) * kstep; const char* b2 = last ? nB : cB + (size_t)(t + 2) * kstep;
            const char* a3 = a2 + kstep; const char* b3 = b2 + kstep;
            if (last && has_next) S.a_ready(nxt);
            if constexpr (SP2) {
            PG8_LDB(B0, 0, 0); PG8_LDB(B1, 0, 1); PG8_SCHED; PG8_LDA(At, 0, 0); PG8_STAGE(PG8_SA(1, 1), a1 + hstep, voffA);
            PG8_WAIT_V(8); PG8_WAIT_L(0); PG8_BAR; PG8_MMA(0, 0, At, B0); PG8_MMA(0, 1, At, B1); PG8_BAR; PG8_SCHED;
            PG8_LDA(At, 0, 1); PG8_STAGE(PG8_SB(0, 0), b2, voffB); PG8_STAGE(PG8_SB(0, 1), b2 + hstep, voffB); PG8_STAGE(PG8_SA(0, 0), a2, voffA);
            PG8_WAIT_V(8); PG8_WAIT_L(0); PG8_BAR; PG8_MMA(1, 0, At, B0); PG8_MMA(1, 1, At, B1); PG8_BAR; PG8_SCHED;
            PG8_LDB(B0, 1, 0); PG8_LDB(B1, 1, 1); PG8_SCHED; PG8_LDA(At, 1, 0); PG8_STAGE(PG8_SA(0, 1), a2 + hstep, voffA);
            PG8_WAIT_V(8); PG8_WAIT_L(0); PG8_BAR; PG8_MMA(0, 0, At, B0); PG8_MMA(0, 1, At, B1); PG8_BAR; PG8_SCHED;
            PG8_LDA(At, 1, 1); PG8_STAGE(PG8_SB(1, 0), b3, voffB); PG8_STAGE(PG8_SB(1, 1), b3 + hstep, voffB); PG8_STAGE(PG8_SA(1, 0), a3, voffA);
            PG8_WAIT_V(8); PG8_WAIT_L(0); PG8_BAR; PG8_MMA(1, 0, At, B0); PG8_MMA(1, 1, At, B1); PG8_BAR; PG8_SCHED;
            } else {
            PG8_LDB(B0, 0, 0); PG8_SCHED; PG8_LDA(At, 0, 0); PG8_STAGE(PG8_SA(1, 1), a1 + hstep, voffA);
            PG8_WAIT_L(8); PG8_BAR; PG8_WAIT_L(0); PG8_MMA(0, 0, At, B0); PG8_BAR; PG8_SCHED;
            PG8_LDB(B1, 0, 1); PG8_STAGE(PG8_SB(0, 0), b2, voffB);
            PG8_BAR; PG8_WAIT_L(0); PG8_MMA(0, 1, At, B1); PG8_BAR;
            PG8_LDA(At, 0, 1); PG8_STAGE(PG8_SA(0, 0), a2, voffA);
            PG8_BAR; PG8_WAIT_L(0); PG8_MMA(1, 0, At, B0); PG8_BAR; PG8_SCHED;
            PG8_STAGE(PG8_SB(0, 1), b2 + hstep, voffB);
            PG8_WAIT_V(6); PG8_BAR; PG8_MMA(1, 1, At, B1); PG8_BAR;
            PG8_LDB(B0, 1, 0); PG8_SCHED; PG8_LDA(At, 1, 0); PG8_STAGE(PG8_SA(0, 1), a2 + hstep, voffA);
            PG8_WAIT_L(8); PG8_BAR; PG8_WAIT_L(0); PG8_MMA(0, 0, At, B0); PG8_BAR; PG8_SCHED;
            PG8_LDB(B1, 1, 1); PG8_STAGE(PG8_SB(1, 0), b3, voffB);
            PG8_BAR; PG8_WAIT_L(0); PG8_MMA(0, 1, At, B1); PG8_BAR;
            PG8_LDA(At, 1, 1); PG8_STAGE(PG8_SA(1, 0), a3, voffA);
            PG8_BAR; PG8_WAIT_L(0); PG8_MMA(1, 0, At, B0); PG8_BAR; PG8_SCHED;
            PG8_STAGE(PG8_SB(1, 1), b3 + hstep, voffB);
            PG8_WAIT_V(6); PG8_BAR; PG8_MMA(1, 1, At, B1); PG8_BAR;
            }
        }
        if constexpr (ALIGN_EPI) { if (wr == 0) PG8_BAR; }
        if constexpr (!Epi::AFTER_DRAIN) { E(acc, cur, wr, wc, fr, fq); S.done(cur); }
        if (!has_next) break;
#pragma unroll
        for (int a = 0; a < 2; ++a)
#pragma unroll
            for (int b = 0; b < 2; ++b)
#pragma unroll
                for (int m = 0; m < 4; ++m)
#pragma unroll
                    for (int n = 0; n < 2; ++n) acc[a][b][m][n] = (f32x4){0.f, 0.f, 0.f, 0.f};
        cur = nxt; cA = nA; cB = nB; ++ui;
        if constexpr (ALIGN_EPI) { if (wr == 1) PG8_BAR; }
    }
    PG8_WAIT_V(0);
    if constexpr (!ALIGN_EPI) { if (wr == 0) PG8_BAR; }
    PG8_BAR;
    if constexpr (Epi::AFTER_DRAIN) { E.fused(acc, cur, wr, wc, fr, fq, lds, wid, lane); S.done(cur); }
#undef PG8_SA
#undef PG8_SB
#undef PG8_STAGE
#undef PG8_LDA
#undef PG8_LDB
#undef PG8_MMA
#undef PG8_WAIT_V
#undef PG8_WAIT_L
#undef PG8_BAR
#undef PG8_SCHED
}
}
namespace pg8 {
__device__ __forceinline__ u32x4 pack8(const f32x4 a, const f32x4 b) { u32x4 w; w.x = cvt_pk_bf16(a[0], a[1]); w.y = cvt_pk_bf16(a[2], a[3]); w.z = cvt_pk_bf16(b[0], b[1]); w.w = cvt_pk_bf16(b[2], b[3]); return w; }

struct EpiInProj {
    static constexpr bool PERM = true, AFTER_DRAIN = false;
    bf16_t* Q; bf16_t* KV; bf16_t* Z; bf16_t* BG; float* G; const float* qn; const float* kn;
    __device__ __forceinline__ void operator()(const f32x4 (&acc)[2][2][4][2], const Unit& u, int wr, int wc, int fr, int fq) const {
        const int pn = u.pn; const int row0 = u.pm * BM + wr * 64 + fr;
        if (pn <= 4) {
            const bool donorm = (pn < 2) || (pn >= 3 && wc < 2);
            const float* nw = (pn < 2) ? qn : kn;
            const float sc = (pn < 2) ? (0.125f * 1.4426950408889634f) : 1.0f;
            f32x4 w4[2][2];
#pragma unroll
            for (int bj = 0; bj < 2; ++bj)
#pragma unroll
                for (int n = 0; n < 2; ++n) { f32x4 t = *(const f32x4*)(nw + 32 * bj + 8 * fq + 4 * n); w4[bj][n] = donorm ? t * sc : (f32x4){1.f, 1.f, 1.f, 1.f}; }
            bf16_t* base; size_t rstride;
            if (pn < 2) { base = Q + (4 * pn + wc) * 64 + 8 * fq; rstride = 512; }
            else { const int ti = (pn - 2) * 2 + (wc >> 1), g = wc & 1; base = KV + (size_t)ti * ((size_t)4 * 2 * 8192 * 64) + 8 * fq; rstride = 64;
                   base += (size_t)g * 8192 * 64; }
#pragma unroll
            for (int ai = 0; ai < 2; ++ai)
#pragma unroll
                for (int m = 0; m < 4; ++m) {
                    const int r = row0 + ai * HALF + m * 16;
                    float rs = 1.f;
                    if (donorm) {
                        float ss = 0.f;
#pragma unroll
                        for (int bj = 0; bj < 2; ++bj)
#pragma unroll
                            for (int n = 0; n < 2; ++n) { const f32x4 x = acc[ai][bj][m][n]; ss += (x[0] * x[0] + x[1] * x[1]) + (x[2] * x[2] + x[3] * x[3]); }
                        ss += __shfl_xor(ss, 16); ss += __shfl_xor(ss, 32);
                        rs = 1.0f / sqrtf(ss * (1.0f / 64.0f) + 1e-6f);
                    }
                    size_t off;
                    if (pn < 2) off = (size_t)r * 512;
                    else { const int b = r >> 13, t = r & 8191; off = ((size_t)(b * 2) * 8192 + t) * 64; }
#pragma unroll
                    for (int bj = 0; bj < 2; ++bj) {
                        const f32x4 v0 = acc[ai][bj][m][0] * rs * w4[bj][0], v1 = acc[ai][bj][m][1] * rs * w4[bj][1];
                        *(u32x4*)(base + off + 32 * bj) = pack8(v0, v1);
                    }
                }
        } else if (pn <= 8) {
            bf16_t* base = Z + 128 * (pn - 5) + 32 * wc + 8 * fq;
#pragma unroll
            for (int ai = 0; ai < 2; ++ai)
#pragma unroll
                for (int m = 0; m < 4; ++m) {
                    const int r = row0 + ai * HALF + m * 16;
                    const f32x4 v0 = acc[ai][0][m][0] * acc[ai][1][m][0], v1 = acc[ai][0][m][1] * acc[ai][1][m][1];
                    *(u32x4*)(base + (size_t)r * 512) = pack8(v0, v1);
                }
        } else if (pn <= 10) {
            bf16_t* base = BG + 256 * (pn - 9) + 32 * wc + 8 * fq;
#pragma unroll
            for (int ai = 0; ai < 2; ++ai)
#pragma unroll
                for (int m = 0; m < 4; ++m) {
                    const int r = row0 + ai * HALF + m * 16;
#pragma unroll
                    for (int bj = 0; bj < 2; ++bj) *(u32x4*)(base + (size_t)r * 512 + 128 * bj) = pack8(acc[ai][bj][m][0], acc[ai][bj][m][1]);
                }
        } else {
            if (wc == 0 && fq < 3) {
#pragma unroll
                for (int ai = 0; ai < 2; ++ai)
#pragma unroll
                    for (int m = 0; m < 4; ++m) {
                        const int r = row0 + ai * HALF + m * 16;
#pragma unroll
                        for (int n = 0; n < 2; ++n) { const f32x4 x = acc[ai][0][m][n]; f32x4 s;
#pragma unroll
                            for (int e = 0; e < 4; ++e) s[e] = 1.0f / (1.0f + __expf(-x[e]));
                            *(f32x4*)(G + (size_t)r * 32 + 8 * fq + 4 * n) = s; }
                    }
            }
        }
    }
};

struct EpiOutProj {
    static constexpr bool PERM = true, AFTER_DRAIN = false;
    const float* x; float* out; bf16_t* A2; float* RSS; const float* mod; const float* n2;
    __device__ __forceinline__ void operator()(const f32x4 (&acc)[2][2][4][2], const Unit& u, int wr, int wc, int fr, int fq) const {
        const int row0 = u.pm * BM + wr * 64 + fr; const int b = (u.pm * BM) >> 13;
        const int col0 = u.pn * BM + wc * 32 + 8 * fq;
        f32x4 g1[2][2], a2[2][2];
#pragma unroll
        for (int bj = 0; bj < 2; ++bj)
#pragma unroll
            for (int n = 0; n < 2; ++n) { const int c = col0 + 128 * bj + 4 * n;
                g1[bj][n] = *(const f32x4*)(mod + (size_t)b * 6144 + 2 * 1024 + c);
                const f32x4 s2 = *(const f32x4*)(mod + (size_t)b * 6144 + 4 * 1024 + c), nn = *(const f32x4*)(n2 + c);
                a2[bj][n] = nn * (s2 + 1.0f); }
#pragma unroll
        for (int ai = 0; ai < 2; ++ai)
#pragma unroll
            for (int m = 0; m < 4; ++m) {
                const int r = row0 + ai * HALF + m * 16; float ss = 0.f;
#pragma unroll
                for (int bj = 0; bj < 2; ++bj) {
                    const size_t off = (size_t)r * 1024 + col0 + 128 * bj;
                    const f32x4 xa = *(const f32x4*)(x + off), xb = *(const f32x4*)(x + off + 4);
                    const f32x4 ya = xa + g1[bj][0] * acc[ai][bj][m][0], yb = xb + g1[bj][1] * acc[ai][bj][m][1];
                    *(f32x4*)(out + off) = ya; *(f32x4*)(out + off + 4) = yb;
                    ss += (ya[0] * ya[0] + ya[1] * ya[1]) + (ya[2] * ya[2] + ya[3] * ya[3]) + (yb[0] * yb[0] + yb[1] * yb[1]) + (yb[2] * yb[2] + yb[3] * yb[3]);
                    *(u32x4*)(A2 + off) = pack8(ya * a2[bj][0], yb * a2[bj][1]);
                }
                ss += __shfl_xor(ss, 16); ss += __shfl_xor(ss, 32);
                if (fq == 0) RSS[(size_t)r * 16 + u.pn * 4 + wc] = ss;
            }
    }
};

struct EpiFF1 {
    static constexpr bool PERM = true, AFTER_DRAIN = false;
    bf16_t* HID; const float* RSS; const float* bff1;
    __device__ __forceinline__ void operator()(const f32x4 (&acc)[2][2][4][2], const Unit& u, int wr, int wc, int fr, int fq) const {
        const int row0 = u.pm * BM + wr * 64 + fr; const int b = (u.pm * BM) >> 13;
        const int col0 = u.pn * BM + wc * 32 + 8 * fq;
        f32x4 bv[2][2];
#pragma unroll
        for (int bj = 0; bj < 2; ++bj)
#pragma unroll
            for (int n = 0; n < 2; ++n) bv[bj][n] = *(const f32x4*)(bff1 + (size_t)b * 4096 + col0 + 128 * bj + 4 * n);
#pragma unroll
        for (int ai = 0; ai < 2; ++ai)
#pragma unroll
            for (int m = 0; m < 4; ++m) {
                const int r = row0 + ai * HALF + m * 16;
                const f32x4 s0 = *(const f32x4*)(RSS + (size_t)r * 16), s1 = *(const f32x4*)(RSS + (size_t)r * 16 + 4), s2 = *(const f32x4*)(RSS + (size_t)r * 16 + 8), s3 = *(const f32x4*)(RSS + (size_t)r * 16 + 12);
                const f32x4 st = (s0 + s1) + (s2 + s3);
                const float rs = 1.0f / sqrtf(((st[0] + st[1]) + (st[2] + st[3])) * (1.0f / 1024.0f) + 1e-6f);
#pragma unroll
                for (int bj = 0; bj < 2; ++bj) {
                    f32x4 h0 = acc[ai][bj][m][0] * rs + bv[bj][0], h1 = acc[ai][bj][m][1] * rs + bv[bj][1];
#pragma unroll
                    for (int e = 0; e < 4; ++e) { const float a = fmaxf(h0[e], 0.f), c = fmaxf(h1[e], 0.f); h0[e] = a * a; h1[e] = c * c; }
                    *(u32x4*)(HID + (size_t)r * 4096 + col0 + 128 * bj) = pack8(h0, h1);
                }
            }
    }
};

struct EpiFF2 {
    static constexpr bool PERM = true, AFTER_DRAIN = false;
    float* out; const float* mod; float* dst;
    __device__ __forceinline__ void operator()(const f32x4 (&acc)[2][2][4][2], const Unit& u, int wr, int wc, int fr, int fq) const {
        const int row0 = u.pm * BM + wr * 64 + fr; const int b = (u.pm * BM) >> 13;
        const int col0 = u.pn * BM + wc * 32 + 8 * fq;
        f32x4 g2[2][2];
#pragma unroll
        for (int bj = 0; bj < 2; ++bj)
#pragma unroll
            for (int n = 0; n < 2; ++n) g2[bj][n] = *(const f32x4*)(mod + (size_t)b * 6144 + 5 * 1024 + col0 + 128 * bj + 4 * n);
#pragma unroll
        for (int ai = 0; ai < 2; ++ai)
#pragma unroll
            for (int m = 0; m < 4; ++m) {
                const int r = row0 + ai * HALF + m * 16;
#pragma unroll
                for (int bj = 0; bj < 2; ++bj) {
                    const size_t off = (size_t)r * 1024 + col0 + 128 * bj;
                    const f32x4 xa = *(const f32x4*)(out + off), xb = *(const f32x4*)(out + off + 4);
                    *(f32x4*)(dst + off) = xa + g2[bj][0] * acc[ai][bj][m][0]; *(f32x4*)(dst + off + 4) = xb + g2[bj][1] * acc[ai][bj][m][1];
                }
            }
    }
};
}

#ifndef MK_N_LAUNCHES
#define MK_N_LAUNCHES 1
#endif
constexpr int NWAVES = 8;
constexpr int N_PHASES = 8;
constexpr int BATCH = 4, T = 8192, D = 1024, M = BATCH * T, FF = 4096, NIN = 3072, INCOLS = 2840;
constexpr int NCMP = 511;
constexpr float LOG2E = 1.4426950408889634f;
constexpr size_t MiB = 1u << 20;
constexpr size_t WS_CTL = 0, CTL_ZERO_BYTES = 32 * 1024;
constexpr size_t WS_MOD = 1 * MiB;
constexpr size_t WS_BFF1 = 1 * MiB + 128 * 1024;
constexpr size_t WS_PEP = 1 * MiB + 256 * 1024;
constexpr size_t WS_RSS = 2 * MiB;
constexpr size_t WS_G = 4 * MiB;
constexpr size_t WS_WIN = 8 * MiB;
constexpr size_t WS_WOUT = 14 * MiB;
constexpr size_t WS_W1 = 16 * MiB;
constexpr size_t WS_W2 = 24 * MiB;
constexpr size_t WS_CW1K = 32 * MiB, WS_CW1V = 33 * MiB;
constexpr size_t WS_CW2K = 34 * MiB, WS_CW2V = 34 * MiB + 64 * 1024;
constexpr size_t WS_KC = 35 * MiB, WS_VC = 35 * MiB + 512 * 1024;
constexpr size_t WS_A2 = 36 * MiB;
constexpr size_t WS_H = 100 * MiB;
constexpr size_t WS_Q = 164 * MiB;
constexpr size_t WS_KV = 196 * MiB;
constexpr size_t KV_TENS = (size_t)4 * 2 * 8192 * 64;
constexpr size_t WS_Z = 244 * MiB;
constexpr size_t WS_BG = 276 * MiB;
constexpr size_t WS_MIX = 308 * MiB;
constexpr size_t WS_HID = 100 * MiB;
constexpr size_t WS_END = 372 * MiB;
constexpr int CW_BAR = 4096;

constexpr int RING_BYTES = 131072;
constexpr int LDSCTL_OFF = 151 * 1024, MISC_OFF = LDSCTL_OFF + 320;
constexpr int LDS_BYTES = 152 * 1024;

#define GAS __attribute__((address_space(1)))
#define LAS __attribute__((address_space(3)))
typedef unsigned short bf16;
typedef unsigned v4u __attribute__((ext_vector_type(4)));
typedef float f32x4 __attribute__((ext_vector_type(4)));
typedef float f32x16 __attribute__((ext_vector_type(16)));
typedef short bf16x8 __attribute__((ext_vector_type(8)));
typedef short s16x4 __attribute__((ext_vector_type(4)));
typedef GAS unsigned gu32;
#define RLX_AGENT __ATOMIC_RELAXED, __HIP_MEMORY_SCOPE_AGENT
#define LDS_WAIT() asm volatile("s_waitcnt lgkmcnt(0)" ::: "memory")
#define VM_WAIT() asm volatile("s_waitcnt vmcnt(0)" ::: "memory")
__device__ __forceinline__ unsigned f2bf(float f) { unsigned u = __builtin_bit_cast(unsigned, f); return (u + 0x7fffu + ((u >> 16) & 1u)) >> 16; }
__device__ __forceinline__ unsigned pk2(float lo, float hi) { return f2bf(lo) | (f2bf(hi) << 16); }
__device__ __forceinline__ float bf2f(unsigned short h) { return __builtin_bit_cast(float, (unsigned)h << 16); }
#define XB_TMO      128
#define XB_XCNT(j)  (256  + 64 * (j))
#define XB_XSUB(j)  (1280 + 64 * (j))
#define XB_XGEN(j)  (2304 + 64 * (j))
#define XB_TOP      3328
#define XB_TOPGEN   3392
#define XCD_BAR_WORDS 3456
#define XB_SPIN_CAP (1u << 18)

__device__ __forceinline__ unsigned xb_ld(unsigned* p)              { return __hip_atomic_load(p, __ATOMIC_RELAXED, __HIP_MEMORY_SCOPE_AGENT); }
__device__ __forceinline__ unsigned xb_add(unsigned* p, unsigned v) { return __hip_atomic_fetch_add(p, v, __ATOMIC_RELAXED, __HIP_MEMORY_SCOPE_AGENT); }
__device__ __forceinline__ unsigned xb_xcc_id() { return (unsigned)__builtin_amdgcn_s_getreg((3 << 11) | 20) & 0xFu; }
#define XB_SPIN(cond, bar) do { unsigned _sp = 0; while (cond) { __builtin_amdgcn_s_sleep(1); \
    if ((++_sp & 255u) == 0u) { if (xb_ld(&(bar)[XB_TMO])) break; if (_sp > XB_SPIN_CAP) { atomicAdd(&(bar)[XB_TMO], 1u); break; } } } } while (0)

struct XcdBarrier {
    unsigned* bar; unsigned x;
    volatile LAS unsigned* st;
};

__device__ __forceinline__ XcdBarrier xcd_barrier_post(unsigned* bar, volatile LAS unsigned* st) {
    XcdBarrier b; b.bar = bar; b.x = xb_xcc_id(); b.st = st;
    if (threadIdx.x == 0) (void)xb_add(&bar[XB_XCNT(b.x)], 1u);
    return b;
}
__device__ __forceinline__ void xcd_barrier_complete(unsigned* bar, unsigned x, unsigned& nloc, unsigned& nx) {
    const unsigned G = gridDim.x * gridDim.y * gridDim.z;
    unsigned sum, cnt, mine, sp = 0u;
    for (;;) {
        sum = 0u; cnt = 0u; mine = 0u;
#pragma unroll
        for (unsigned j = 0; j < 16; ++j) { const unsigned c = xb_ld(&bar[XB_XCNT(j)]); sum += c; cnt += (c > 0u) ? 1u : 0u; mine = (j == x) ? c : mine; }
        if (sum == G) break;
        __builtin_amdgcn_s_sleep(1);
        if ((++sp & 255u) == 0u) { if (xb_ld(&bar[XB_TMO])) break; if (sp > XB_SPIN_CAP) { atomicAdd(&bar[XB_TMO], 1u); break; } }
    }
    nloc = mine > 0u ? mine : 1u; nx = cnt > 0u ? cnt : 1u;
}

__device__ __forceinline__ void xcd_barrier(const XcdBarrier& b) {
    asm volatile("s_waitcnt vmcnt(0)" ::: "memory");
    __syncthreads();
    if (threadIdx.x == 0) {
        unsigned* bar = b.bar;
        __builtin_amdgcn_s_waitcnt(0);
        unsigned nloc = b.st[0], nx = b.st[1];
        if (nloc == 0u) { xcd_barrier_complete(bar, b.x, nloc, nx); b.st[0] = nloc; b.st[1] = nx; }
        const unsigned old = xb_add(&bar[XB_XSUB(b.x)], 1u);
        const unsigned gen = old / nloc;
        if (old + 1u == (gen + 1u) * nloc) {
            __builtin_amdgcn_fence(__ATOMIC_RELEASE, "agent");
            asm volatile("s_waitcnt vmcnt(0)" ::: "memory");
            const unsigned og = xb_add(&bar[XB_TOP], 1u);
            const unsigned tg = og / nx;
            if (og + 1u == (tg + 1u) * nx) xb_add(&bar[XB_TOPGEN], 1u);
            else XB_SPIN(xb_ld(&bar[XB_TOPGEN]) == tg, bar);
            __builtin_amdgcn_fence(__ATOMIC_ACQUIRE, "agent");
            xb_add(&bar[XB_XGEN(b.x)], 1u);
            asm volatile("s_waitcnt vmcnt(0)" ::: "memory");
        } else {
            XB_SPIN(xb_ld(&bar[XB_XGEN(b.x)]) == gen, bar);
            __builtin_amdgcn_fence(__ATOMIC_ACQUIRE, "agent");
            asm volatile("s_waitcnt vmcnt(0)" ::: "memory");
        }
    }
    __syncthreads();
}

struct Frame {
    LAS unsigned char* lds;
    volatile LAS unsigned* MISC;
    gu32* ctl;
    int tid, lane, wave;
    int vcu, G;
    const float* in[20];
    float* out;
    unsigned char* ws;
    unsigned long long tp_t0, tp_acc;
};
#ifdef ATP_A
#define ATP(F, id) do { if ((id) == ATP_A) (F).tp_t0 = __builtin_amdgcn_s_memrealtime(); if ((id) == ATP_B) (F).tp_acc += __builtin_amdgcn_s_memrealtime() - (F).tp_t0; } while (0)
#else
#define ATP(F, id) do {} while (0)
#endif
__device__ __forceinline__ float wave_sum(float v) {
#pragma unroll
    for (int o = 1; o < 64; o <<= 1) v += __shfl_xor(v, o);
    return v;
}

__device__ __forceinline__ void p0_transpose_item(const float* W, int K, int N, int nsrc0, int nvalid, bf16* WT, int drow0, int kb, LAS float* scr, int lane) {
    const int k0 = 64 * kb; const int nl = lane & 31;
    float tv[32];
#pragma unroll
    for (int i = 0; i < 32; ++i) { const int kk = 2 * i + (lane >> 5); tv[i] = (nl < nvalid) ? W[(size_t)(k0 + kk) * N + nsrc0 + nl] : 0.f; }
#pragma unroll
    for (int i = 0; i < 32; ++i) { const int kk = 2 * i + (lane >> 5); scr[kk * 33 + nl] = tv[i]; }
    LDS_WAIT(); asm volatile("" ::: "memory");
    const int c = lane & 7;
#pragma unroll
    for (int j = 0; j < 4; ++j) { const int n = (lane >> 3) + 8 * j; const LAS float* s = scr + (8 * c) * 33 + n;
        v4u o; o.x = pk2(s[0 * 33], s[1 * 33]); o.y = pk2(s[2 * 33], s[3 * 33]); o.z = pk2(s[4 * 33], s[5 * 33]); o.w = pk2(s[6 * 33], s[7 * 33]);
        *(GAS v4u*)(WT + (size_t)(drow0 + n) * K + k0 + 8 * c) = o; }
    LDS_WAIT(); asm volatile("" ::: "memory");
}
__device__ __forceinline__ void win_src(int rb, int& src0, int& nvalid) {
    const int pn = rb >> 3, q = rb & 7, bj = q >> 2, wc = q & 3; nvalid = 32;
    if (pn < 2) src0 = (4 * pn + wc) * 64 + 32 * bj;
    else if (pn < 5) src0 = 512 + (pn - 2) * 256 + (wc >> 1) * 128 + (wc & 1) * 64 + 32 * bj;
    else if (pn < 9) src0 = (bj == 0 ? 1304 : 2328) + 128 * (pn - 5) + 32 * wc;
    else if (pn < 11) src0 = 1816 + 256 * (pn - 9) + 32 * q;
    else { src0 = 1280; nvalid = (q == 0) ? 24 : 0; }
}
__device__ __forceinline__ void p0_phase(Frame& F) {
    const int bid = blockIdx.x;
    for (int it = bid; it < 224; it += F.G) {
      if (it < 192) {
        const int cb = it;
        LAS float* sc = (LAS float*)(F.lds);
        LAS float* red = (LAS float*)(F.lds + 16384);
        const float* c = F.in[1];
        for (int i = F.tid; i < 4096; i += 512) { const float v = c[i]; sc[i] = v / (1.0f + __expf(-v)); }
        __syncthreads();
        const float* wa = F.in[16]; const int col = 32 * cb + (F.lane & 31), kpar = F.lane >> 5;
        float a0 = 0.f, a1 = 0.f, a2 = 0.f, a3 = 0.f;
#pragma unroll 32
        for (int i = 0; i < 64; ++i) { const int k = 128 * F.wave + 2 * i + kpar; const float w = wa[(size_t)k * 6144 + col];
            a0 += sc[k] * w; a1 += sc[1024 + k] * w; a2 += sc[2048 + k] * w; a3 += sc[3072 + k] * w; }
        a0 += __shfl_xor(a0, 32); a1 += __shfl_xor(a1, 32); a2 += __shfl_xor(a2, 32); a3 += __shfl_xor(a3, 32);
        if (F.lane < 32) { red[(F.wave * 4 + 0) * 32 + F.lane] = a0; red[(F.wave * 4 + 1) * 32 + F.lane] = a1; red[(F.wave * 4 + 2) * 32 + F.lane] = a2; red[(F.wave * 4 + 3) * 32 + F.lane] = a3; }
        __syncthreads();
        if (F.tid < 128) { const int b = F.tid >> 5, cc = F.tid & 31; float s = F.in[17][32 * cb + cc];
#pragma unroll
            for (int w = 0; w < 8; ++w) s += red[(w * 4 + b) * 32 + cc];
            ((float*)(F.ws + WS_MOD))[b * 6144 + 32 * cb + cc] = s; }
        __syncthreads();
      } else {
        const int kv = (it - 192) >> 4, kc = (it - 192) & 15; const float* pe = F.in[kv ? 8 : 5]; const float* w1 = F.in[kv ? 9 : 6];
        if (F.tid < 256) { float s = 0.f;
#pragma unroll 32
            for (int k = 128 * kc; k < 128 * kc + 128; ++k) s += pe[k] * w1[(size_t)k * 256 + F.tid];
            ((float*)(F.ws + WS_PEP))[(kv * 16 + kc) * 256 + F.tid] = s; }
      }
    }
    __syncthreads();
    LAS float* scr = (LAS float*)(F.lds + F.wave * 16384);
    const int gw = F.vcu * NWAVES + F.wave, NGW = F.G * NWAVES;
    constexpr int I_IN = 96 * 16, I_OUT = 32 * 16, I_1 = 128 * 16, I_2 = 32 * 64, I_C1 = 8 * 32, I_C2 = 2 * 4;
    constexpr int NITEMS = I_IN + I_OUT + I_1 + I_2 + 2 * I_C1 + 2 * I_C2;
    for (int it = gw; it < NITEMS; it += NGW) {
        int r = it;
        if (r < I_IN) { const int rb = r >> 4, kb = r & 15; int s0, nv; win_src(rb, s0, nv); p0_transpose_item(F.in[2], D, INCOLS, s0, nv, (bf16*)(F.ws + WS_WIN), 32 * rb, kb, scr, F.lane); continue; } r -= I_IN;
        if (r < I_OUT) { const int rb = r >> 4, kb = r & 15; p0_transpose_item(F.in[13], D, D, 32 * rb, 32, (bf16*)(F.ws + WS_WOUT), 32 * rb, kb, scr, F.lane); continue; } r -= I_OUT;
        if (r < I_1) { const int rb = r >> 4, kb = r & 15; p0_transpose_item(F.in[18], D, FF, 32 * rb, 32, (bf16*)(F.ws + WS_W1), 32 * rb, kb, scr, F.lane); continue; } r -= I_1;
        if (r < I_2) { const int rb = r >> 6, kb = r & 63; p0_transpose_item(F.in[19], FF, D, 32 * rb, 32, (bf16*)(F.ws + WS_W2), 32 * rb, kb, scr, F.lane); continue; } r -= I_2;
        if (r < I_C1) { const int rb = r >> 5, kb = r & 31; p0_transpose_item(F.in[6], 2048, 256, 32 * rb, 32, (bf16*)(F.ws + WS_CW1K), 32 * rb, kb, scr, F.lane); continue; } r -= I_C1;
        if (r < I_C1) { const int rb = r >> 5, kb = r & 31; p0_transpose_item(F.in[9], 2048, 256, 32 * rb, 32, (bf16*)(F.ws + WS_CW1V), 32 * rb, kb, scr, F.lane); continue; } r -= I_C1;
        if (r < I_C2) { const int rb = r >> 2, kb = r & 3; p0_transpose_item(F.in[7], 256, 64, 32 * rb, 32, (bf16*)(F.ws + WS_CW2K), 32 * rb, kb, scr, F.lane); continue; } r -= I_C2;
        { const int rb = r >> 2, kb = r & 3; p0_transpose_item(F.in[10], 256, 64, 32 * rb, 32, (bf16*)(F.ws + WS_CW2V), 32 * rb, kb, scr, F.lane); }
    }
    __syncthreads();
}

__device__ __forceinline__ void p1_phase(Frame& F) {
    const int gw = F.vcu * NWAVES + F.wave, NGW = F.G * NWAVES;
    const float* mod = (const float*)(F.ws + WS_MOD);
    const float* x = F.in[0]; const float* n1 = F.in[14];
    bf16* H = (bf16*)(F.ws + WS_H);
    for (int chunk = gw; chunk < M / 16; chunk += NGW) {
        const int r0 = chunk * 16, b = r0 >> 13;
        f32x4 ca[4], cb[4];
#pragma unroll
        for (int j = 0; j < 4; ++j) { const int c = 4 * (F.lane + 64 * j);
            const f32x4 nn = *(const f32x4*)(n1 + c), s1 = *(const f32x4*)(mod + (size_t)b * 6144 + 1024 + c);
            ca[j] = nn * (s1 + 1.0f); cb[j] = *(const f32x4*)(mod + (size_t)b * 6144 + c); }
        for (int rr = 0; rr < 16; rr += 4) {
            f32x4 v[4][4]; float s[4];
#pragma unroll
            for (int q = 0; q < 4; ++q) { const GAS f32x4* xr = (const GAS f32x4*)(x + (size_t)(r0 + rr + q) * D) + F.lane;
#pragma unroll
                for (int j = 0; j < 4; ++j) v[q][j] = xr[64 * j]; }
#pragma unroll
            for (int q = 0; q < 4; ++q) { s[q] = 0.f;
#pragma unroll
                for (int j = 0; j < 4; ++j) s[q] += (v[q][j].x * v[q][j].x + v[q][j].y * v[q][j].y) + (v[q][j].z * v[q][j].z + v[q][j].w * v[q][j].w); }
#pragma unroll
            for (int o = 1; o < 64; o <<= 1) {
#pragma unroll
                for (int q = 0; q < 4; ++q) s[q] += __shfl_xor(s[q], o); }
#pragma unroll
            for (int q = 0; q < 4; ++q) {
                const float rs = 1.0f / sqrtf(s[q] * (1.0f / D) + 1e-6f);
                GAS unsigned long long* o8 = (GAS unsigned long long*)(H + (size_t)(r0 + rr + q) * D) + F.lane;
#pragma unroll
                for (int j = 0; j < 4; ++j) { const f32x4 h = v[q][j] * rs * ca[j] + cb[j];
                    o8[64 * j] = (unsigned long long)pk2(h.x, h.y) | ((unsigned long long)pk2(h.z, h.w) << 32); }
            }
        }
    }
    const bf16* W1t = (const bf16*)(F.ws + WS_W1);
    float* bff1 = (float*)(F.ws + WS_BFF1);
    for (int n = gw; n < FF; n += NGW) {
        float a[4] = {0.f, 0.f, 0.f, 0.f};
#pragma unroll
        for (int j = 0; j < 2; ++j) { const int k0 = 8 * F.lane + 512 * j;
            const v4u wv = *(const GAS v4u*)(W1t + (size_t)n * D + k0);
            float w[8]; w[0] = bf2f(wv.x & 0xffff); w[1] = bf2f(wv.x >> 16); w[2] = bf2f(wv.y & 0xffff); w[3] = bf2f(wv.y >> 16); w[4] = bf2f(wv.z & 0xffff); w[5] = bf2f(wv.z >> 16); w[6] = bf2f(wv.w & 0xffff); w[7] = bf2f(wv.w >> 16);
#pragma unroll
            for (int b = 0; b < 4; ++b) { const f32x4 s0 = *(const f32x4*)(mod + (size_t)b * 6144 + 3 * 1024 + k0), s1 = *(const f32x4*)(mod + (size_t)b * 6144 + 3 * 1024 + k0 + 4);
                a[b] += (w[0] * s0[0] + w[1] * s0[1]) + (w[2] * s0[2] + w[3] * s0[3]) + (w[4] * s1[0] + w[5] * s1[1]) + (w[6] * s1[2] + w[7] * s1[3]); } }
#pragma unroll
        for (int b = 0; b < 4; ++b) { const float s = wave_sum(a[b]); if (F.lane == 0) bff1[b * 4096 + n] = s; }
    }
}

__device__ __forceinline__ float gelu_tanh(float x) {
    const float u = 0.7978845608028654f * (x + 0.044715f * x * x * x);
    const float e = __expf(2.0f * u);
    const float th = 1.0f - 2.0f / (1.0f + e);
    return 0.5f * x * (1.0f + th);
}
__device__ __forceinline__ void p3_phase(Frame& F) {
    constexpr int AIMG = 0, GSTR = 2064, HIDO = 68224, HSTR = 528, OUTO = 85120, OSTR = 65;
    const int lane = F.lane, w = F.wave, r32 = lane & 31, hi = lane >> 5;
    for (int item = blockIdx.x; item < 256; item += F.G) {
        const int prob = item >> 4, mt = item & 15, kv = prob >> 3, b = (prob >> 1) & 3, g = prob & 1, n0 = 32 * mt;
        const bf16* raw = (const bf16*)(F.ws + WS_KV) + (size_t)kv * KV_TENS + (size_t)(b * 2 + g) * 8192 * 64;
        { v4u av[9];
#pragma unroll
          for (int q = 0; q < 9; ++q) { const int idx = F.tid + 512 * q, gl = idx >> 7, ch = idx & 127, gi = n0 + gl;
              av[q] = (v4u){0u, 0u, 0u, 0u}; if (idx < 33 * 128 && gi < 512) av[q] = *(const GAS v4u*)(raw + (size_t)gi * 1024 + ch * 8); }
#pragma unroll
          for (int q = 0; q < 9; ++q) { const int idx = F.tid + 512 * q, gl = idx >> 7, ch = idx & 127;
              if (idx < 33 * 128) *(LAS v4u*)(F.lds + AIMG + gl * GSTR + ch * 16) = av[q]; } }
        __syncthreads();
        const bf16* W1t = (const bf16*)(F.ws + (kv ? WS_CW1V : WS_CW1K));
        const bf16* bp = W1t + (size_t)(32 * w + r32) * 2048 + 8 * hi;
        const LAS unsigned char* ap = F.lds + AIMG + r32 * GSTR + hi * 16;
        f32x16 acc = {};
#pragma unroll 1
        for (int s0 = 0; s0 < 128; s0 += 32) {
            bf16x8 bfr[32];
#pragma unroll
            for (int j = 0; j < 32; ++j) bfr[j] = *(const GAS bf16x8*)(bp + 16 * (s0 + j));
            const LAS unsigned char* aq = ap + (s0 >= 64 ? GSTR + (s0 - 64) * 32 : s0 * 32);
#pragma unroll
            for (int j = 0; j < 32; ++j) { const bf16x8 af = *(const LAS bf16x8*)(aq + j * 32); acc = __builtin_amdgcn_mfma_f32_32x32x16_bf16(af, bfr[j], acc, 0, 0, 0); }
        }
        { const float* pp = (const float*)(F.ws + WS_PEP) + kv * 16 * 256 + 32 * w + r32; float pb = 0.f;
#pragma unroll
          for (int kc = 0; kc < 16; ++kc) pb += pp[kc * 256];
#pragma unroll
          for (int i = 0; i < 16; ++i) { const int row = (i & 3) + 8 * (i >> 2) + 4 * hi; const float h = gelu_tanh(acc[i] + pb);
              *(LAS unsigned short*)(F.lds + HIDO + row * HSTR + (32 * w + r32) * 2) = (unsigned short)f2bf(h); } }
        __syncthreads();
        if (w < 2) {
            const bf16* W2t = (const bf16*)(F.ws + (kv ? WS_CW2V : WS_CW2K));
            const bf16* bp2 = W2t + (size_t)(32 * w + r32) * 256 + 8 * hi;
            const LAS unsigned char* ap2 = F.lds + HIDO + r32 * HSTR + hi * 16;
            f32x16 a2 = {};
#pragma unroll
            for (int s = 0; s < 16; ++s) { const bf16x8 bf_ = *(const GAS bf16x8*)(bp2 + 16 * s); const bf16x8 af = *(const LAS bf16x8*)(ap2 + s * 32); a2 = __builtin_amdgcn_mfma_f32_32x32x16_bf16(af, bf_, a2, 0, 0, 0); }
#pragma unroll
            for (int i = 0; i < 16; ++i) { const int row = (i & 3) + 8 * (i >> 2) + 4 * hi; *(LAS float*)(F.lds + OUTO + (row * OSTR + 32 * w + r32) * 4) = a2[i]; }
        }
        __syncthreads();
        { const int row = F.tid >> 4, c4 = (F.tid & 15) * 4; const LAS float* op = (const LAS float*)(F.lds + OUTO) + row * OSTR + c4;
          float v0 = op[0], v1 = op[1], v2 = op[2], v3 = op[3];
          if (kv == 0) { float ss = (v0 * v0 + v1 * v1) + (v2 * v2 + v3 * v3); ss += __shfl_xor(ss, 1); ss += __shfl_xor(ss, 2); ss += __shfl_xor(ss, 4); ss += __shfl_xor(ss, 8);
              const float rs = 1.0f / sqrtf(ss * (1.0f / 64.0f) + 1e-6f); const f32x4 kn = *(const f32x4*)(F.in[4] + c4); v0 *= rs * kn[0]; v1 *= rs * kn[1]; v2 *= rs * kn[2]; v3 *= rs * kn[3]; }
          const int n = n0 + row; if (n >= NCMP) { v0 = v1 = v2 = v3 = 0.f; }
          bf16* dst = (bf16*)(F.ws + (kv ? WS_VC : WS_KC)) + ((size_t)(b * 2 + g) * 512 + n) * 64 + c4;
          *(GAS unsigned long long*)dst = (unsigned long long)pk2(v0, v1) | ((unsigned long long)pk2(v2, v3) << 32); }
        __syncthreads();
    }
}

namespace att {
constexpr int SLOT = 16384;
constexpr int L_RING = 0;
constexpr int L_IMP = 49152, IMP_STR = 132;
constexpr int L_OACC = 49152;
constexpr int L_BTAB = L_OACC + 65536;
constexpr int NBT = 960, BT0 = 895;
constexpr int L_WSF = L_BTAB + 4 * NBT * 4;
constexpr int L_SELM = L_WSF + 2048;
constexpr int L_UNI = L_SELM + 1024;
constexpr int L_END = L_UNI + 256;
static_assert(L_END <= LDSCTL_OFF, "attention LDS map");
constexpr float NEG_INF = -INFINITY;
constexpr float THR = 8.0f;

__device__ __forceinline__ int t5_bucket(int n) {
    if (n < 16) return n;
    int b = 16;
    b += (n >= 21); b += (n >= 27); b += (n >= 35); b += (n >= 46); b += (n >= 59); b += (n >= 77); b += (n >= 99); b += (n >= 128);
    b += (n >= 166); b += (n >= 216); b += (n >= 280); b += (n >= 363); b += (n >= 470); b += (n >= 609); b += (n >= 790);
    return b;
}
__device__ __forceinline__ s16x4 vtr(const LAS unsigned char* p) { typedef short v4i16_t __attribute__((ext_vector_type(4))); return __builtin_bit_cast(s16x4, __builtin_amdgcn_ds_read_tr16_b64_v4i16((LAS v4i16_t*)p)); }
__device__ __forceinline__ unsigned cvtpk(float lo, float hi) { typedef float f2 __attribute__((ext_vector_type(2))); typedef __bf16 b2 __attribute__((ext_vector_type(2))); f2 v = {lo, hi}; b2 b = __builtin_convertvector(v, b2); return __builtin_bit_cast(unsigned, b); }
__device__ __forceinline__ float xhalf_max(float a) { auto rr = __builtin_amdgcn_permlane32_swap(__float_as_uint(a), __float_as_uint(a), false, false); return fmaxf(__uint_as_float(rr[0]), __uint_as_float(rr[1])); }
__device__ __forceinline__ float xhalf_sum(float a) { auto rr = __builtin_amdgcn_permlane32_swap(__float_as_uint(a), __float_as_uint(a), false, false); return __uint_as_float(rr[0]) + __uint_as_float(rr[1]); }
__device__ __forceinline__ float quad_sum(float a) {
    a += __int_as_float(__builtin_amdgcn_update_dpp(0, __float_as_int(a), 0xB1, 0xf, 0xf, true));
    a += __int_as_float(__builtin_amdgcn_update_dpp(0, __float_as_int(a), 0x4E, 0xf, 0xf, true));
    return a;
}
__device__ __forceinline__ void glds16(const void* gsrc, unsigned lds_dst) { unsigned keep;
    asm volatile("s_mov_b32 %0, m0\n\ts_mov_b32 m0, %2\n\ts_nop 0\n\tglobal_load_lds_dwordx4 %1, off\n\ts_mov_b32 m0, %0" : "=&s"(keep) : "v"(gsrc), "s"(lds_dst) : "memory"); }
#define ATT_WAIT_BAR(N) asm volatile("s_waitcnt vmcnt(" #N ") lgkmcnt(0)\n\ts_barrier" ::: "memory")
__device__ __forceinline__ void tile_dma(const bf16* Kt, const bf16* Vt, bool hasV, unsigned slot_addr, int w, int lane) {
    glds16(Kt + lane * 64 + w * 8, (unsigned)__builtin_amdgcn_readfirstlane(slot_addr + w * 1024));
    if (hasV) glds16(Vt + (16 * (w & 3) + (lane >> 2)) * 64 + (w >> 2) * 32 + (lane & 3) * 8, (unsigned)__builtin_amdgcn_readfirstlane(slot_addr + 8192 + w * 1024));
}
__device__ __forceinline__ void qk_tile(const LAS unsigned char* buf, const bf16x8 (&qf)[4], float cv, f32x16& p0, f32x16& p1, int r32, int hi) {
    const LAS unsigned char* kp = buf + hi * 1024 + r32 * 16;
    f32x16 c;
#pragma unroll
    for (int i = 0; i < 16; ++i) c[i] = cv;
    bf16x8 k0[4], k1[4];
#pragma unroll
    for (int s = 0; s < 4; ++s) { k0[s] = *(const LAS bf16x8*)(kp + s * 2048); k1[s] = *(const LAS bf16x8*)(kp + s * 2048 + 512); }
    p0 = __builtin_amdgcn_mfma_f32_32x32x16_bf16(k0[0], qf[0], c, 0, 0, 0);
    p1 = __builtin_amdgcn_mfma_f32_32x32x16_bf16(k1[0], qf[0], c, 0, 0, 0);
#pragma unroll
    for (int s = 1; s < 4; ++s) {
        p0 = __builtin_amdgcn_mfma_f32_32x32x16_bf16(k0[s], qf[s], p0, 0, 0, 0);
        p1 = __builtin_amdgcn_mfma_f32_32x32x16_bf16(k1[s], qf[s], p1, 0, 0, 0);
    }
}
template <int KSTEP>
__device__ __forceinline__ void bias_mask(f32x16& p0, f32x16& p1, const LAS float* bt, int dbase, int hi) {
#pragma unroll
    for (int i = 0; i < 16; ++i) {
        const int kl = (i & 3) + 8 * (i >> 2) + 4 * hi;
        const int d0 = dbase - KSTEP * kl, d1 = d0 - KSTEP * 32;
        const int i0 = BT0 - min(max(d0, 0), BT0), i1 = BT0 - min(max(d1, 0), BT0);
        const float b0 = bt[i0], b1 = bt[i1];
        p0[i] = (d0 >= 0) ? p0[i] + b0 : NEG_INF;
        p1[i] = (d1 >= 0) ? p1[i] + b1 : NEG_INF;
        if ((i & 3) == 3) asm volatile("" ::: "memory");
    }
}
template <int MODE>
__device__ __forceinline__ void bias_near(f32x16& p0, f32x16& p1, const LAS float* tb, int dbase, int hi) {
#pragma unroll
    for (int i = 0; i < 16; ++i) {
        const int ko = (i & 3) + 8 * (i >> 2);
        const float b0 = tb[ko], b1 = tb[ko + 32];
        const int d0 = dbase - ko - 4 * hi, d1 = d0 - 32;
        if (MODE == 0) { p0[i] += b0; p1[i] += b1; }
        else if (MODE == 1) { p0[i] = d0 >= 0 ? p0[i] + b0 : NEG_INF; p1[i] = d1 >= 0 ? p1[i] + b1 : NEG_INF; }
        else { p0[i] = d0 < 512 ? p0[i] + b0 : NEG_INF; p1[i] = d1 < 512 ? p1[i] + b1 : NEG_INF; }
        if ((i & 7) == 7) asm volatile("" ::: "memory");
    }
}
__device__ __forceinline__ void bias_near_mode(f32x16& p0, f32x16& p1, const LAS float* tb, int dbase, int hi, int mode) {
    if (mode == 0) bias_near<0>(p0, p1, tb, dbase, hi); else if (mode == 1) bias_near<1>(p0, p1, tb, dbase, hi); else bias_near<2>(p0, p1, tb, dbase, hi);
}
__device__ __forceinline__ float rowmax32(const f32x16& p0, const f32x16& p1) {
    float a = fmaxf(fmaxf(p0[0], p1[0]), p0[1]), b = fmaxf(fmaxf(p1[1], p0[2]), p1[2]);
#pragma unroll
    for (int i = 3; i < 15; i += 2) { a = fmaxf(fmaxf(a, p0[i]), p1[i]); b = fmaxf(fmaxf(b, p0[i + 1]), p1[i + 1]); }
    a = fmaxf(fmaxf(a, p0[15]), p1[15]);
    return xhalf_max(fmaxf(a, b));
}
__device__ __forceinline__ void pv_tile(const LAS unsigned char* buf, const f32x16& p0, const f32x16& p1, f32x16 (&o)[2], int lane, int hi) {
    const LAS unsigned char* vp = buf + 8192 + ((lane >> 4) & 1) * 32 + (lane & 3) * 8 + (4 * hi + ((lane & 15) >> 2)) * 64;
    bf16x8 pa[4];
#pragma unroll
    for (int s = 0; s < 2; ++s) {
        v4u a, c;
        a.x = cvtpk(p0[8 * s + 0], p0[8 * s + 1]); a.y = cvtpk(p0[8 * s + 2], p0[8 * s + 3]); a.z = cvtpk(p0[8 * s + 4], p0[8 * s + 5]); a.w = cvtpk(p0[8 * s + 6], p0[8 * s + 7]);
        c.x = cvtpk(p1[8 * s + 0], p1[8 * s + 1]); c.y = cvtpk(p1[8 * s + 2], p1[8 * s + 3]); c.z = cvtpk(p1[8 * s + 4], p1[8 * s + 5]); c.w = cvtpk(p1[8 * s + 6], p1[8 * s + 7]);
        pa[s] = __builtin_bit_cast(bf16x8, a); pa[2 + s] = __builtin_bit_cast(bf16x8, c);
    }
#pragma unroll
    for (int ks = 0; ks < 4; ++ks)
#pragma unroll
        for (int d0 = 0; d0 < 2; ++d0) {
            const s16x4 lo = vtr(vp + d0 * 4096 + ks * 1024), hh = vtr(vp + d0 * 4096 + ks * 1024 + 512);
            const bf16x8 vf = (bf16x8){lo[0], lo[1], lo[2], lo[3], hh[0], hh[1], hh[2], hh[3]};
            o[d0] = __builtin_amdgcn_mfma_f32_32x32x16_bf16(pa[ks], vf, o[d0], 0, 0, 0);
        }
}
__device__ __forceinline__ void row_to_regs(LAS float* wsf, float v, float (&f)[16], int r32, int hi) {
    if (hi == 0) wsf[r32] = v;
#pragma unroll
    for (int u = 0; u < 4; ++u) { const f32x4 t = *(const LAS f32x4*)(wsf + 8 * u + 4 * hi); f[4 * u] = t[0]; f[4 * u + 1] = t[1]; f[4 * u + 2] = t[2]; f[4 * u + 3] = t[3]; }
}
struct SmState { float m, l; bool have; };
__device__ __forceinline__ void sm_init(SmState& st) { st.m = 0.f; st.l = 0.f; st.have = false; }
template <bool HASO>
__device__ __forceinline__ void sm_rebase(SmState& st, f32x16& p0, f32x16& p1, f32x16 (&o)[2], LAS float* wsf, int r32, int hi) {
    const float mx = rowmax32(p0, p1);
    const bool fin = mx > NEG_INF;
    const bool trig = st.have ? (mx > THR) : fin;
    if (__any(trig)) {
        const float dl = st.have ? fmaxf(mx, 0.f) : (fin ? mx : 0.f);
        const float alpha = st.have ? __builtin_amdgcn_exp2f(-dl) : 1.0f;
        st.m += dl; st.l *= alpha; st.have = st.have || fin;
#pragma unroll
        for (int i = 0; i < 16; ++i) { p0[i] -= dl; p1[i] -= dl; }
        if (HASO) { float f[16]; row_to_regs(wsf, alpha, f, r32, hi);
#pragma unroll
            for (int i = 0; i < 16; ++i) { o[0][i] *= f[i]; o[1][i] *= f[i]; } }
    }
}
__device__ __forceinline__ float exp_sum(f32x16& p0, f32x16& p1) {
    float s0 = 0.f, s1 = 0.f;
#pragma unroll
    for (int i = 0; i < 16; ++i) { p0[i] = __builtin_amdgcn_exp2f(p0[i]); p1[i] = __builtin_amdgcn_exp2f(p1[i]); s0 += p0[i]; s1 += p1[i]; }
    return s0 + s1;
}

__device__ __forceinline__ void build_btab(Frame& F, int g) {
    LAS float* btab = (LAS float*)(F.lds + L_BTAB); const float* rb = F.in[11];
    __syncthreads();
    for (int i = F.tid; i < 4 * NBT; i += 512) { const int rr = i / NBT, d = BT0 - (i - rr * NBT); btab[i] = rb[t5_bucket(d > 0 ? d : 0) * 8 + 4 * g + rr] * LOG2E; }
    __syncthreads();
}
__device__ __forceinline__ void attn_item(Frame& F, int b, int g, int qb) {
    const int tid = F.tid, lane = F.lane, w = F.wave, r32 = lane & 31, hi = lane >> 5, qi = r32 >> 2, r = r32 & 3;
    const int t0 = qb * 64, tl = 8 * w + qi, tpos = t0 + tl;
    ATP(F, 0);
    LAS unsigned char* lds = F.lds;
    const unsigned lds0 = (unsigned)(uintptr_t)lds;
    LAS float* imp = (LAS float*)(lds + L_IMP);
    LAS float* btab = (LAS float*)(lds + L_BTAB);
    LAS float* wsf = (LAS float*)(lds + L_WSF) + w * 64;
    LAS unsigned* selm = (LAS unsigned*)(lds + L_SELM);
    LAS unsigned* uni = (LAS unsigned*)(lds + L_UNI);
    const bf16* KVb = (const bf16*)(F.ws + WS_KV);
    const size_t bgoff = (size_t)(b * 2 + g) * 8192 * 64;
    const bf16* ksb = KVb + 2 * KV_TENS + bgoff; const bf16* vsb = KVb + 3 * KV_TENS + bgoff;
    const bf16* kwb = KVb + 4 * KV_TENS + bgoff; const bf16* vwb = KVb + 5 * KV_TENS + bgoff;
    const bf16* kcb = (const bf16*)(F.ws + WS_KC) + (size_t)(b * 2 + g) * 512 * 64;
    const bf16* vcb = (const bf16*)(F.ws + WS_VC) + (size_t)(b * 2 + g) * 512 * 64;
    for (int i = lane; i < 8 * IMP_STR; i += 64) imp[8 * w * IMP_STR + i] = 0.f;
    if (tid < 64) uni[tid] = 0u;
    bf16x8 qf[4];
    { const bf16* Qp = (const bf16*)(F.ws + WS_Q) + ((size_t)(b * 8192 + tpos) * 512 + (4 * g + r) * 64 + 8 * hi);
#pragma unroll
      for (int s = 0; s < 4; ++s) qf[s] = *(const GAS bf16x8*)(Qp + 16 * s); }
    float gate[3];
    { const float* gp = (const float*)(F.ws + WS_G) + (size_t)(b * 8192 + tpos) * 32 + (4 * g + r) * 3; gate[0] = gp[0]; gate[1] = gp[1]; gate[2] = gp[2]; }
    const float bfar = F.in[11][31 * 8 + 4 * g + r] * LOG2E;
    const LAS float* bt = btab + r * NBT;
    LAS float* oaccp = (LAS float*)(lds + L_OACC) + w * 2048 + lane;
    asm volatile("s_waitcnt vmcnt(0)" ::: "memory");
    __syncthreads();

    ATP(F, 1);
    const int nct = (4 * qb + 3 + 63) >> 6;
    const int dcb = tpos - 31;
    const int ncfar = (t0 - 1829) >= 0 ? min(nct, (t0 - 1829) / 1024 + 1) : 0;
    SmState sc; sm_init(sc);
    f32x16 oc[2]; oc[0] = f32x16{}; oc[1] = f32x16{};
    tile_dma(kcb, vcb, false, lds0 + L_RING, w, lane);
    if (nct > 1) { tile_dma(kcb + 4096, vcb, false, lds0 + L_RING + SLOT, w, lane); ATT_WAIT_BAR(1); } else { ATT_WAIT_BAR(0); }
    for (int c = 0, sl = 0; c < nct; ++c) {
        const int sl2 = sl >= SLOT ? sl - SLOT : sl + 2 * SLOT;
        if (c + 2 < nct) tile_dma(kcb + (size_t)(c + 2) * 4096, vcb, false, lds0 + L_RING + sl2, w, lane);
        f32x16 p0, p1; qk_tile(lds + L_RING + sl, qf, c < ncfar ? bfar - sc.m : -sc.m, p0, p1, r32, hi);
        if (c >= ncfar) bias_mask<16>(p0, p1, bt, dcb - 1024 * c, hi);
        sm_rebase<false>(sc, p0, p1, oc, wsf, r32, hi);
        sc.l += exp_sum(p0, p1);
        if (c + 2 < nct) { ATT_WAIT_BAR(1); } else { ATT_WAIT_BAR(0); }
        sl = sl == 2 * SLOT ? 0 : sl + SLOT;
    }
    ATP(F, 2);
    const float lc = xhalf_sum(sc.l);
    const float ilc = lc > 0.f ? 1.0f / lc : 0.f;
    {
        tile_dma(kcb, vcb, true, lds0 + L_RING, w, lane);
        if (nct > 1) { tile_dma(kcb + 4096, vcb + 4096, true, lds0 + L_RING + SLOT, w, lane); ATT_WAIT_BAR(2); } else { ATT_WAIT_BAR(0); }
        for (int c = 0, sl = 0; c < nct; ++c) {
            const int sl2 = sl >= SLOT ? sl - SLOT : sl + 2 * SLOT;
            if (c + 2 < nct) tile_dma(kcb + (size_t)(c + 2) * 4096, vcb + (size_t)(c + 2) * 4096, true, lds0 + L_RING + sl2, w, lane);
            f32x16 p0, p1; qk_tile(lds + L_RING + sl, qf, c < ncfar ? bfar - sc.m : -sc.m, p0, p1, r32, hi);
            if (c >= ncfar) bias_mask<16>(p0, p1, bt, dcb - 1024 * c, hi);
#pragma unroll
            for (int i = 0; i < 16; ++i) { p0[i] = __builtin_amdgcn_exp2f(p0[i]) * ilc; p1[i] = __builtin_amdgcn_exp2f(p1[i]) * ilc; }
#pragma unroll
            for (int a = 0; a < 2; ++a)
#pragma unroll
                for (int u = 0; u < 4; ++u) {
                    const float x0 = a ? p1[4 * u] : p0[4 * u], x1 = a ? p1[4 * u + 1] : p0[4 * u + 1], x2 = a ? p1[4 * u + 2] : p0[4 * u + 2], x3 = a ? p1[4 * u + 3] : p0[4 * u + 3];
                    const float mainv = quad_sum((x0 + x1) + (x2 + 0.5f * x3)), spill = quad_sum(0.5f * x3);
                    const int j = 16 * c + 8 * a + 2 * u + hi;
                    if (r == 0) { (void)__hip_atomic_fetch_add(&imp[(8 * w + qi) * IMP_STR + j], mainv, __ATOMIC_RELAXED, __HIP_MEMORY_SCOPE_WORKGROUP); if (j + 1 < 128) (void)__hip_atomic_fetch_add(&imp[(8 * w + qi) * IMP_STR + j + 1], spill, __ATOMIC_RELAXED, __HIP_MEMORY_SCOPE_WORKGROUP); }
                }
            pv_tile(lds + L_RING + sl, p0, p1, oc, lane, hi);
            if (c + 2 < nct) { ATT_WAIT_BAR(2); } else { ATT_WAIT_BAR(0); }
            sl = sl == 2 * SLOT ? 0 : sl + SLOT;
        }
    }
    ATP(F, 3);
    for (int pass = 0; pass < 2; ++pass) {
        const int q = 8 * w + 4 * pass + (lane >> 4), t = lane & 15;
        const f32x4 va = *(const LAS f32x4*)(imp + q * IMP_STR + 8 * t), vb = *(const LAS f32x4*)(imp + q * IMP_STR + 8 * t + 4);
        unsigned key[8];
#pragma unroll
        for (int e = 0; e < 8; ++e) { const int j = 8 * t + e; const float v = e < 4 ? va[e] : vb[e - 4];
            const bool val = j <= qb, fo = (j == 0) || (j == qb) || (j == qb - 1);
            key[e] = !val ? 0u : (fo ? 0x7f000000u : __float_as_uint(v) + 1u); }
        unsigned Tt = 0u;
        for (int bit = 30; bit >= 0; --bit) {
            const unsigned cand = Tt | (1u << bit); int cnt = 0;
#pragma unroll
            for (int e = 0; e < 8; ++e) cnt += (key[e] >= cand) ? 1 : 0;
            cnt += __builtin_amdgcn_update_dpp(0, cnt, 0x128, 0xf, 0xf, true);
            cnt += __builtin_amdgcn_update_dpp(0, cnt, 0x124, 0xf, 0xf, true);
            cnt += __builtin_amdgcn_update_dpp(0, cnt, 0x122, 0xf, 0xf, true);
            cnt += __builtin_amdgcn_update_dpp(0, cnt, 0x121, 0xf, 0xf, true);
            if (cnt >= 16) Tt = cand;
        }
        int ngt = 0, neq = 0;
#pragma unroll
        for (int e = 0; e < 8; ++e) { ngt += (key[e] > Tt) ? 1 : 0; neq += (key[e] == Tt) ? 1 : 0; }
        ngt += __builtin_amdgcn_update_dpp(0, ngt, 0x128, 0xf, 0xf, true); ngt += __builtin_amdgcn_update_dpp(0, ngt, 0x124, 0xf, 0xf, true);
        ngt += __builtin_amdgcn_update_dpp(0, ngt, 0x122, 0xf, 0xf, true); ngt += __builtin_amdgcn_update_dpp(0, ngt, 0x121, 0xf, 0xf, true);
        const int need = 16 - ngt;
        int inc = neq;
        inc += __builtin_amdgcn_update_dpp(0, inc, 0x111, 0xf, 0xf, true);
        inc += __builtin_amdgcn_update_dpp(0, inc, 0x112, 0xf, 0xf, true);
        inc += __builtin_amdgcn_update_dpp(0, inc, 0x114, 0xf, 0xf, true);
        inc += __builtin_amdgcn_update_dpp(0, inc, 0x118, 0xf, 0xf, true);
        int pre = inc - neq; unsigned bits = 0u;
#pragma unroll
        for (int e = 0; e < 8; ++e) { const bool eq = key[e] == Tt; const bool sel = (key[e] != 0u) && ((key[e] > Tt) || (eq && pre < need)); pre += eq ? 1 : 0; bits |= sel ? (1u << e) : 0u; }
        unsigned word = bits << ((t & 3) * 8);
        word |= (unsigned)__builtin_amdgcn_update_dpp(0, (int)word, 0xB1, 0xf, 0xf, true);
        word |= (unsigned)__builtin_amdgcn_update_dpp(0, (int)word, 0x4E, 0xf, 0xf, true);
        if ((t & 3) == 0) { selm[q * 4 + (t >> 2)] = word; (void)__hip_atomic_fetch_or(&uni[w * 4 + (t >> 2)], word, __ATOMIC_RELAXED, __HIP_MEMORY_SCOPE_WORKGROUP); (void)__hip_atomic_fetch_or(&uni[32 + (t >> 2)], word, __ATOMIC_RELAXED, __HIP_MEMORY_SCOPE_WORKGROUP); }
    }
    __syncthreads();
    { float f[16]; row_to_regs(wsf, gate[0], f, r32, hi);
#pragma unroll
      for (int i = 0; i < 16; ++i) { oaccp[i * 64] = oc[0][i] * f[i]; oaccp[(16 + i) * 64] = oc[1][i] * f[i]; } }
    unsigned mym[4], bu[4], wuv[4];
#pragma unroll
    for (int k = 0; k < 4; ++k) { mym[k] = selm[(8 * w + qi) * 4 + k]; bu[k] = __builtin_amdgcn_readfirstlane(uni[32 + k]); wuv[k] = __builtin_amdgcn_readfirstlane(uni[w * 4 + k]); }
    ATP(F, 4);
#ifndef REP_SEL
#define REP_SEL 1
#endif
#ifndef REP_WIN
#define REP_WIN 1
#endif
#ifndef REP_CMP
#define REP_CMP 1
#endif
    for (int rep_ = 0; rep_ < REP_SEL; ++rep_) {
        f32x16 o[2]; o[0] = f32x16{}; o[1] = f32x16{}; SmState ss; sm_init(ss);
#define NEXT_SEL(from, dst) do { dst = -1; for (int j_ = (from); j_ <= qb; ++j_) if ((bu[j_ >> 5] >> (j_ & 31)) & 1u) { dst = j_; break; } } while (0)
        int j0, j1, j2;
        NEXT_SEL(0, j0); j1 = -1; j2 = -1; if (j0 >= 0) NEXT_SEL(j0 + 1, j1);
        if (j0 >= 0) tile_dma(ksb + (size_t)j0 * 4096, vsb + (size_t)j0 * 4096, true, lds0 + L_RING, w, lane);
        if (j1 >= 0) { tile_dma(ksb + (size_t)j1 * 4096, vsb + (size_t)j1 * 4096, true, lds0 + L_RING + SLOT, w, lane); ATT_WAIT_BAR(2); } else { ATT_WAIT_BAR(0); }
        int sl = 0;
        while (j0 >= 0) {
            const int sl2 = sl >= SLOT ? sl - SLOT : sl + 2 * SLOT;
            j2 = -1; if (j1 >= 0) NEXT_SEL(j1 + 1, j2);
            if (j2 >= 0) tile_dma(ksb + (size_t)j2 * 4096, vsb + (size_t)j2 * 4096, true, lds0 + L_RING + sl2, w, lane);
            if ((wuv[j0 >> 5] >> (j0 & 31)) & 1u) {
                const bool mine = (mym[j0 >> 5] >> (j0 & 31)) & 1u;
                const bool nearj = qb - j0 < 14;
                f32x16 p0, p1; qk_tile(lds + L_RING + sl, qf, mine ? (nearj ? -ss.m - bfar : -ss.m) : NEG_INF, p0, p1, r32, hi);
                if (nearj) bias_near_mode(p0, p1, bt + (BT0 - (tpos - 64 * j0)) + 4 * hi, tpos - 64 * j0, hi, j0 == qb ? 1 : 0);
                sm_rebase<true>(ss, p0, p1, o, wsf, r32, hi);
                ss.l += exp_sum(p0, p1);
                pv_tile(lds + L_RING + sl, p0, p1, o, lane, hi);
            }
            if (j2 >= 0) { ATT_WAIT_BAR(2); } else { ATT_WAIT_BAR(0); }
            sl = sl == 2 * SLOT ? 0 : sl + SLOT;
            j0 = j1; j1 = j2;
        }
#undef NEXT_SEL
        const float ls = xhalf_sum(ss.l);
        float f[16]; row_to_regs(wsf, ls > 0.f ? gate[1] / (ls * REP_SEL) : 0.f, f, r32, hi);
#pragma unroll
        for (int i = 0; i < 16; ++i) { oaccp[i * 64] += o[0][i] * f[i]; oaccp[(16 + i) * 64] += o[1][i] * f[i]; }
    }
    ATP(F, 5);
    {
        f32x16 o[2]; o[0] = f32x16{}; o[1] = f32x16{}; SmState sw; sm_init(sw);
        const int jf = qb >= 8 ? qb - 8 : 0;
        tile_dma(kwb + (size_t)jf * 4096, vwb + (size_t)jf * 4096, true, lds0 + L_RING, w, lane);
        if (jf + 1 <= qb) { tile_dma(kwb + (size_t)(jf + 1) * 4096, vwb + (size_t)(jf + 1) * 4096, true, lds0 + L_RING + SLOT, w, lane); ATT_WAIT_BAR(2); } else { ATT_WAIT_BAR(0); }
        for (int j = jf, sl = 0; j <= qb; ++j) {
            const int sl2 = sl >= SLOT ? sl - SLOT : sl + 2 * SLOT;
            if (j + 2 <= qb) tile_dma(kwb + (size_t)(j + 2) * 4096, vwb + (size_t)(j + 2) * 4096, true, lds0 + L_RING + sl2, w, lane);
            f32x16 p0, p1; qk_tile(lds + L_RING + sl, qf, -sw.m, p0, p1, r32, hi);
            bias_near_mode(p0, p1, bt + (BT0 - (tpos - 64 * j)) + 4 * hi, tpos - 64 * j, hi, j == qb ? 1 : (j == qb - 8 ? 2 : 0));
            sm_rebase<true>(sw, p0, p1, o, wsf, r32, hi);
            sw.l += exp_sum(p0, p1);
            pv_tile(lds + L_RING + sl, p0, p1, o, lane, hi);
            if (j + 2 <= qb) { ATT_WAIT_BAR(2); } else { ATT_WAIT_BAR(0); }
            sl = sl == 2 * SLOT ? 0 : sl + SLOT;
        }
        const float lw = xhalf_sum(sw.l);
        float f[16]; row_to_regs(wsf, lw > 0.f ? gate[2] / lw : 0.f, f, r32, hi);
#pragma unroll
        for (int i = 0; i < 16; ++i) { o[0][i] = oaccp[i * 64] + o[0][i] * f[i]; o[1][i] = oaccp[(16 + i) * 64] + o[1][i] * f[i]; }
        asm volatile("" ::: "memory");
        LAS unsigned short* stg = (LAS unsigned short*)(lds + L_OACC + w * 8192);
#pragma unroll
        for (int i = 0; i < 16; ++i) { const int orow = (i & 3) + 8 * (i >> 2) + 4 * hi;
            stg[orow * 64 + r32] = (unsigned short)f2bf(o[0][i]); stg[orow * 64 + 32 + r32] = (unsigned short)f2bf(o[1][i]); }
        LDS_WAIT();
        bf16* MIX = (bf16*)(F.ws + WS_MIX);
#pragma unroll
        for (int i = 0; i < 4; ++i) { const int row = i * 8 + (lane >> 3), ch = lane & 7; const v4u v = *(const LAS v4u*)(stg + row * 64 + ch * 8);
            *(GAS v4u*)(MIX + (size_t)(b * 8192 + t0 + 8 * w + (row >> 2)) * 1024 + (4 * g + (row & 3)) * 64 + ch * 8) = v; }
    }
    __syncthreads();
    ATP(F, 6);
}
}

__device__ __forceinline__ void p4_phase(Frame& F) {
    {
        const bf16* Z = (const bf16*)(F.ws + WS_Z); const bf16* BG = (const bf16*)(F.ws + WS_BG); bf16* MIX = (bf16*)(F.ws + WS_MIX);
        const float* cw = F.in[12];
        const int ch = F.tid & 63, rsub = F.tid >> 6;
        f32x4 w0a = *(const f32x4*)(cw + 8 * ch), w0b = *(const f32x4*)(cw + 8 * ch + 4), w1a = *(const f32x4*)(cw + 512 + 8 * ch), w1b = *(const f32x4*)(cw + 512 + 8 * ch + 4), w2a = *(const f32x4*)(cw + 1024 + 8 * ch), w2b = *(const f32x4*)(cw + 1024 + 8 * ch + 4);
        for (int rb = blockIdx.x; rb < M / 8; rb += F.G) {
            const int row = 8 * rb + rsub, t = row & 8191;
            const v4u z2 = *(const GAS v4u*)(Z + (size_t)row * 512 + 8 * ch);
            v4u z1 = (v4u){0u, 0u, 0u, 0u}, z0 = (v4u){0u, 0u, 0u, 0u};
            if (t >= 1) z1 = *(const GAS v4u*)(Z + (size_t)(row - 1) * 512 + 8 * ch);
            if (t >= 2) z0 = *(const GAS v4u*)(Z + (size_t)(row - 2) * 512 + 8 * ch);
            const v4u bg = *(const GAS v4u*)(BG + (size_t)row * 512 + 8 * ch);
            float o[8];
#define CV(k, comp, sh, wa, wi) o[k] = bf2f((unsigned short)((bg.comp >> sh) & 0xffff)) * (w0##wa[wi] * bf2f((unsigned short)((z0.comp >> sh) & 0xffff)) + w1##wa[wi] * bf2f((unsigned short)((z1.comp >> sh) & 0xffff)) + w2##wa[wi] * bf2f((unsigned short)((z2.comp >> sh) & 0xffff)))
            CV(0, x, 0, a, 0); CV(1, x, 16, a, 1); CV(2, y, 0, a, 2); CV(3, y, 16, a, 3); CV(4, z, 0, b, 0); CV(5, z, 16, b, 1); CV(6, w, 0, b, 2); CV(7, w, 16, b, 3);
#undef CV
            v4u ov; ov.x = pk2(o[0], o[1]); ov.y = pk2(o[2], o[3]); ov.z = pk2(o[4], o[5]); ov.w = pk2(o[6], o[7]);
            *(GAS v4u*)(MIX + (size_t)row * 1024 + 512 + 8 * ch) = ov;
        }
    }
    asm volatile("s_waitcnt vmcnt(0)" ::: "memory");
    if (F.G == 256) {
        const int bg = blockIdx.x & 7, s_ = blockIdx.x >> 3;
        att::build_btab(F, bg & 1);
        att::attn_item(F, bg >> 1, bg & 1, 127 - s_);
        att::attn_item(F, bg >> 1, bg & 1, 64 + s_);
        att::attn_item(F, bg >> 1, bg & 1, 63 - s_);
        att::attn_item(F, bg >> 1, bg & 1, s_);
    } else {
        for (int rd = 0; rd * F.G < 1024; ++rd) {
            const int pos = (rd & 1) ? (F.G - 1 - (int)blockIdx.x) : (int)blockIdx.x;
            const int k = rd * F.G + pos; if (k >= 1024) continue;
            const int qb = 127 - (k >> 3), bg = k & 7;
            att::build_btab(F, bg & 1);
            att::attn_item(F, bg >> 1, bg & 1, qb);
        }
    }
}

struct Args { const float* in[20]; float* out; unsigned char* ws; int ph_lo, ph_hi; };
__global__ void __launch_bounds__(NWAVES * 64, 2) mk_fwd(Args args) {
    extern __shared__ __attribute__((aligned(16))) unsigned char lds[];
    Frame F;
    F.lds = (LAS unsigned char*)lds;
    F.MISC = (volatile LAS unsigned*)(F.lds + MISC_OFF);
    F.tid = threadIdx.x; F.lane = F.tid & 63; F.wave = __builtin_amdgcn_readfirstlane(F.tid >> 6);
    F.G = gridDim.x; { const int bx = blockIdx.x; F.vcu = (F.G % 8 == 0) ? (bx % 8) * (F.G / 8) + bx / 8 : bx; }
    F.tp_t0 = 0; F.tp_acc = 0; F.ws = args.ws; F.out = args.out; F.ctl = (gu32*)(args.ws + WS_CTL);
#pragma unroll
    for (int i = 0; i < 20; ++i) F.in[i] = args.in[i];
    for (int u = F.tid; u < (LDS_BYTES - LDSCTL_OFF) / 4; u += NWAVES * 64) ((LAS unsigned*)(F.lds + LDSCTL_OFF))[u] = 0u;
    __syncthreads();
    const int lo = args.ph_lo, hi = args.ph_hi;
    const bool one = (hi - lo) > 1;
    XcdBarrier bar; bar.bar = (unsigned*)(F.ctl + CW_BAR); bar.x = 0; bar.st = nullptr;
    if (one) bar = xcd_barrier_post((unsigned*)(F.ctl + CW_BAR), F.MISC + 8);
#ifdef ONLY_PHASE
#define IN(k) ((k) == ONLY_PHASE && lo <= (k) && (k) < hi)
#else
#define IN(k) (lo <= (k) && (k) < hi)
#endif
#ifndef REP_MASK
#define REP_MASK 0
#endif
#define REPS(k) for (int rep_ = 0; rep_ < 1 + ((REP_MASK >> (k)) & 1); ++rep_)
#define SEAM(k) do { if (IN(k) && IN((k) + 1)) xcd_barrier(bar); } while (0)
    unsigned char* ws = args.ws;
#ifdef PROBE_PHASE
    unsigned long long tp0_ = 0, tp1_ = 0;
#define TPS(k) do { if ((k) == PROBE_PHASE) tp0_ = __builtin_amdgcn_s_memrealtime(); if ((k) == PROBE_END) tp1_ = __builtin_amdgcn_s_memrealtime(); } while (0)
#else
#define TPS(k) do {} while (0)
#endif
    TPS(0);
    if (IN(0)) { REPS(0) p0_phase(F); SEAM(0); }
    TPS(1);
    if (IN(1)) { REPS(1) p1_phase(F); SEAM(1); }
#ifdef XTRA_BAR
    for (int xb_ = 0; xb_ < XTRA_BAR; ++xb_) xcd_barrier(bar);
#endif
    TPS(2);
    if (IN(2)) {
        pg8::Gemm g{(const pg8::bf16_t*)(ws + WS_H), (const pg8::bf16_t*)(ws + WS_WIN), M, NIN, D}; pg8::StaticOrder S; S.init(M, NIN, F.G, (int)blockIdx.x);
        pg8::EpiInProj E{(pg8::bf16_t*)(ws + WS_Q), (pg8::bf16_t*)(ws + WS_KV), (pg8::bf16_t*)(ws + WS_Z), (pg8::bf16_t*)(ws + WS_BG), (float*)(ws + WS_G), F.in[3], F.in[4]};
        pg8::gemm_phase<pg8::EpiInProj, pg8::StaticOrder, true, true>(F.lds, g, S, E);
#ifdef DUP_P2
        pg8::gemm_phase<pg8::EpiInProj, pg8::StaticOrder, true, true>(F.lds, g, S, E);
#endif
        SEAM(2);
    }
    TPS(3);
    if (IN(3)) { REPS(3) p3_phase(F); SEAM(3); }
    TPS(4);
    if (IN(4)) { REPS(4) p4_phase(F); SEAM(4); }
    TPS(5);
    if (IN(5)) {
        pg8::Gemm g{(const pg8::bf16_t*)(ws + WS_MIX), (const pg8::bf16_t*)(ws + WS_WOUT), M, D, D}; pg8::StaticOrder S; S.init(M, D, F.G, (int)blockIdx.x);
        pg8::EpiOutProj E{F.in[0], F.out, (pg8::bf16_t*)(ws + WS_A2), (float*)(ws + WS_RSS), (const float*)(ws + WS_MOD), F.in[15]};
        REPS(5) pg8::gemm_phase<pg8::EpiOutProj, pg8::StaticOrder, true, true>(F.lds, g, S, E);
        SEAM(5);
    }
    TPS(6);
    if (IN(6)) {
        pg8::Gemm g{(const pg8::bf16_t*)(ws + WS_A2), (const pg8::bf16_t*)(ws + WS_W1), M, FF, D}; pg8::StaticOrder S; S.init(M, FF, F.G, (int)blockIdx.x);
        pg8::EpiFF1 E{(pg8::bf16_t*)(ws + WS_HID), (const float*)(ws + WS_RSS), (const float*)(ws + WS_BFF1)};
        REPS(6) pg8::gemm_phase<pg8::EpiFF1, pg8::StaticOrder, true, true>(F.lds, g, S, E);
        SEAM(6);
    }
    TPS(7);
    if (IN(7)) {
        pg8::Gemm g{(const pg8::bf16_t*)(ws + WS_HID), (const pg8::bf16_t*)(ws + WS_W2), M, D, FF}; pg8::StaticOrder S; S.init(M, D, F.G, (int)blockIdx.x);
#ifdef DUP_P7
        { pg8::EpiFF2 E0{F.out, (const float*)(ws + WS_MOD), (float*)(ws + (size_t)380 * MiB)};
          pg8::gemm_phase<pg8::EpiFF2, pg8::StaticOrder, true, true>(F.lds, g, S, E0); }
#endif
        pg8::EpiFF2 E{F.out, (const float*)(ws + WS_MOD), F.out};
        pg8::gemm_phase<pg8::EpiFF2, pg8::StaticOrder, true, true>(F.lds, g, S, E);
    }
    TPS(8);
#ifdef ATP_A
    if (blockIdx.x == 0 && F.tid == 0) { const unsigned long long until = __builtin_amdgcn_s_memrealtime() + (unsigned long long)ATP_MULT * F.tp_acc;
        while (__builtin_amdgcn_s_memrealtime() < until) __builtin_amdgcn_s_sleep(8); }
#endif
#ifdef PROBE_PHASE
    if (blockIdx.x == 0 && F.tid == 0) { const unsigned long long until = __builtin_amdgcn_s_memrealtime() + (unsigned long long)PROBE_MULT * (tp1_ - tp0_);
        while (__builtin_amdgcn_s_memrealtime() < until) __builtin_amdgcn_s_sleep(8); }
#endif
#undef IN
#undef SEAM
}

extern "C" void kernel_launch(void* const* d_in, const int* in_sizes, int n_in, void* d_out, int out_size, void* d_ws, size_t ws_size, hipStream_t stream) {
    static int grid = 0;
    if (grid == 0) {
        if (n_in != 20 || in_sizes[0] != M * D || out_size != M * D || ws_size < WS_END) { fprintf(stderr, "kernel_launch: unexpected problem shape (n_in %d, in0 %d, out %d, ws %zu)\n", n_in, n_in > 0 ? in_sizes[0] : -1, out_size, ws_size); grid = -1; return; }
        int dev = 0, cus = 0, per_cu = 0;
        if (hipGetDevice(&dev) != hipSuccess || hipDeviceGetAttribute(&cus, hipDeviceAttributeMultiprocessorCount, dev) != hipSuccess) { grid = -1; return; }
        if (hipFuncSetAttribute((const void*)mk_fwd, hipFuncAttributeMaxDynamicSharedMemorySize, LDS_BYTES) != hipSuccess) { fprintf(stderr, "kernel_launch: hipFuncSetAttribute failed\n"); grid = -1; return; }
        if (hipOccupancyMaxActiveBlocksPerMultiprocessor(&per_cu, (const void*)mk_fwd, NWAVES * 64, LDS_BYTES) != hipSuccess || per_cu < 1) { fprintf(stderr, "kernel_launch: occupancy query says %d blocks per CU\n", per_cu); (void)hipGetLastError(); per_cu = 1; }
        grid = cus * 1;
        if (per_cu < 1) grid = -1;
    }
    if (grid < 0) return;
    (void)hipMemsetAsync((char*)d_ws + WS_CTL, 0, CTL_ZERO_BYTES, stream);
    Args a{};
    for (int i = 0; i < 20; ++i) a.in[i] = (const float*)d_in[i];
    a.out = (float*)d_out; a.ws = (unsigned char*)d_ws;
    if (MK_N_LAUNCHES == 1) {
        a.ph_lo = 0; a.ph_hi = N_PHASES;
        void* kargs[] = {&a};
        hipError_t e = hipLaunchCooperativeKernel((const void*)mk_fwd, dim3(grid), dim3(NWAVES * 64), kargs, LDS_BYTES, stream);
        if (e != hipSuccess) fprintf(stderr, "kernel_launch: cooperative launch failed: %s (grid %d)\n", hipGetErrorString(e), grid);
    } else {
        for (int p = 0; p < N_PHASES; ++p) { a.ph_lo = p; a.ph_hi = p + 1; hipLaunchKernelGGL(mk_fwd, dim3(grid), dim3(NWAVES * 64), LDS_BYTES, stream, a); }
    }
}
```

```cpp
#include <hip/hip_runtime.h>
#include <hip/hip_bf16.h>
#include <cstdio>
#include <cstdint>
#include <cmath>
namespace pg8 {
#define PG8_LAS __attribute__((address_space(3)))
typedef unsigned short bf16_t;
typedef short bf16x8 __attribute__((ext_vector_type(8)));
typedef float f32x4 __attribute__((ext_vector_type(4)));
typedef unsigned u32x4 __attribute__((ext_vector_type(4)));
constexpr int BM = 256, BK = 64, HALF = 128, HTB = HALF * BK * 2  , STAGE_BYTES = 8 * HTB, NXCD = 8, WGM = 8;

__host__ __device__ __forceinline__ int lds_byte(int r, int c) { const int st = (r >> 4) * 2 + (c >> 5), rr = r & 15, cc = c & 31, ob = rr * 64 + cc * 2; return st * 1024 + (ob ^ (((ob >> 9) & 1) << 5)); }
__host__ __device__ __forceinline__ void stage_rc(int b, int& R, int& C) { const int st = b / 1024, sb = b % 1024, swz = sb ^ (((sb >> 9) & 1) << 5); R = (st >> 1) * 16 + swz / 64; C = (st & 1) * 32 + (swz % 64) / 2; }
__host__ __device__ __forceinline__ int perm32(int rho) { const int n = rho >> 4, i = rho & 15; return 8 * (i >> 2) + 4 * n + (i & 3); }

struct Unit { int pm, pn; };
struct Gemm { const bf16_t* A; const bf16_t* Bt; int M, N, K; };

struct StaticOrder {
    int nM, nN, nwg, G, c;
    __host__ __device__ void init(int M, int N, int G_, int c_) { nM = M / BM; nN = N / BM; nwg = nM * nN; G = G_; c = c_; }
    __host__ __device__ bool next(int i, Unit& u) const {
        const long L = (long)i * G + c; if (L >= nwg) return false;
        int wgid = (int)L; { const int q = nwg / NXCD, r = nwg % NXCD, xcd = wgid % NXCD, off = wgid / NXCD; wgid = (xcd < r ? xcd * (q + 1) : r * (q + 1) + (xcd - r) * q) + off; }
        const int nig = WGM * nN, gid = wgid / nig, fm = gid * WGM, gsz = (nM - fm) < WGM ? (nM - fm) : WGM;
        u.pm = fm + ((wgid % nig) % gsz); u.pn = (wgid % nig) / gsz; return true;
    }
    __device__ __forceinline__ void a_ready(const Unit&) const {}
    __device__ __forceinline__ void done(const Unit&) const {}
};

__device__ __forceinline__ unsigned cvt_pk_bf16(float lo, float hi) { unsigned r; asm volatile("v_cvt_pk_bf16_f32 %0, %1, %2" : "=v"(r) : "v"(lo), "v"(hi)); return r; }
typedef float f32x2 __attribute__((ext_vector_type(2)));
template <class Epi, class Sched, bool ALIGN_EPI = false, bool SP2 = false>
__device__ __forceinline__ void gemm_phase(PG8_LAS unsigned char* lds, const Gemm g, const Sched& S, const Epi& E) {
    const int tid = threadIdx.x, wid = __builtin_amdgcn_readfirstlane(tid >> 6), lane = tid & 63, wr = wid >> 2, wc = wid & 3, fr = lane & 15, fq = lane >> 4;
    const int K = g.K, nt = K / BK;
    unsigned voffA[2], voffB[2];
#pragma unroll
    for (int i = 0; i < 2; ++i) { int R, C; stage_rc(tid * 16 + i * 8192, R, C); const int Rb = Epi::PERM ? ((R & ~31) + perm32(R & 31)) : R;
        voffA[i] = (unsigned)(R * K + C) * 2u; voffB[i] = (unsigned)(Rb * K + C) * 2u; }
    const size_t kstep = (size_t)(BK * 2);
    const size_t hstep = (size_t)HALF * K * 2;
    const size_t tstep = 2 * hstep;
    const unsigned ldsw = (unsigned)wid * 1024u;
    const int aoff = lds_byte(wr * 64 + fr, fq * 8), boff = lds_byte(wc * 32 + fr, fq * 8);
#define PG8_SA(b, h) (((b) * 2 + (h)) * HTB)
#define PG8_SB(b, h) ((4 + (b) * 2 + (h)) * HTB)
#define PG8_STAGE(bufoff, gbase, voff) do { _Pragma("unroll") for (int _i = 0; _i < 2; ++_i) \
        __builtin_amdgcn_global_load_lds((const unsigned*)((const char*)(gbase) + (voff)[_i]), (PG8_LAS unsigned*)(lds + (bufoff) + ldsw + _i * 8192), 16, 0, 0); } while (0)
#define PG8_LDA(dst, b, h) do { _Pragma("unroll") for (int m = 0; m < 4; ++m) _Pragma("unroll") for (int k = 0; k < 2; ++k) dst[m][k] = *(const PG8_LAS bf16x8*)(lds + PG8_SA(b, h) + aoff + m * 2048 + k * 1024); } while (0)
#define PG8_LDB(dst, b, h) do { _Pragma("unroll") for (int n = 0; n < 2; ++n) _Pragma("unroll") for (int k = 0; k < 2; ++k) dst[n][k] = *(const PG8_LAS bf16x8*)(lds + PG8_SB(b, h) + boff + n * 2048 + k * 1024); } while (0)
#define PG8_MMA(ai, bj, At, Bt) do { __builtin_amdgcn_s_setprio(1); _Pragma("unroll") for (int m = 0; m < 4; ++m) _Pragma("unroll") for (int n = 0; n < 2; ++n) _Pragma("unroll") for (int k = 0; k < 2; ++k) \
        acc[ai][bj][m][n] = __builtin_amdgcn_mfma_f32_16x16x32_bf16(Bt[n][k], At[m][k], acc[ai][bj][m][n], 0, 0, 0); __builtin_amdgcn_s_setprio(0); } while (0)
#define PG8_WAIT_V(n) asm volatile("s_waitcnt vmcnt(" #n ")" ::: "memory")
#define PG8_WAIT_L(n) asm volatile("s_waitcnt lgkmcnt(" #n ")" ::: "memory")
#define PG8_BAR __builtin_amdgcn_s_barrier()
#define PG8_SCHED __builtin_amdgcn_sched_barrier(0)
    Unit cur, nxt; int ui = 0;
    if (!S.next(0, cur)) return;
    f32x4 acc[2][2][4][2];
#pragma unroll
    for (int a = 0; a < 2; ++a)
#pragma unroll
        for (int b = 0; b < 2; ++b)
#pragma unroll
            for (int m = 0; m < 4; ++m)
#pragma unroll
                for (int n = 0; n < 2; ++n) acc[a][b][m][n] = (f32x4){0.f, 0.f, 0.f, 0.f};
    bf16x8 At[4][2], B0[2][2], B1[2][2];
    const char* cA = (const char*)g.A + (size_t)cur.pm * tstep; const char* cB = (const char*)g.Bt + (size_t)cur.pn * tstep;
    S.a_ready(cur);
    if constexpr (SP2) {
        PG8_STAGE(PG8_SB(0, 0), cB, voffB); PG8_STAGE(PG8_SB(0, 1), cB + hstep, voffB); PG8_STAGE(PG8_SA(0, 0), cA, voffA); PG8_STAGE(PG8_SA(0, 1), cA + hstep, voffA);
        if (wr == 1) PG8_BAR;
        PG8_WAIT_V(2); PG8_BAR;
        PG8_STAGE(PG8_SB(1, 0), cB + kstep, voffB); PG8_STAGE(PG8_SA(1, 0), cA + kstep, voffA); PG8_STAGE(PG8_SB(1, 1), cB + hstep + kstep, voffB);
        PG8_WAIT_V(6); PG8_BAR;
    } else {
        PG8_STAGE(PG8_SB(0, 0), cB, voffB); PG8_STAGE(PG8_SA(0, 0), cA, voffA); PG8_STAGE(PG8_SB(0, 1), cB + hstep, voffB); PG8_STAGE(PG8_SA(0, 1), cA + hstep, voffA);
        if (wr == 1) PG8_BAR;
        PG8_WAIT_V(4); PG8_BAR;
        PG8_STAGE(PG8_SB(1, 0), cB + kstep, voffB); PG8_STAGE(PG8_SA(1, 0), cA + kstep, voffA); PG8_STAGE(PG8_SB(1, 1), cB + hstep + kstep, voffB);
        PG8_WAIT_V(6); PG8_BAR;
    }
    for (;;) {
        const bool has_next = S.next(ui + 1, nxt);
        const char* nA = has_next ? (const char*)g.A + (size_t)nxt.pm * tstep : cA; const char* nB = has_next ? (const char*)g.Bt + (size_t)nxt.pn * tstep : cB;
        for (int t = 0; t < nt; t += 2) {
            const bool last = (t == nt - 2);
            const char* a1 = cA + (size_t)(t + 1) * kstep;
            const char* a2 = last ? nA : cA + (size_t)(t + 2) * kstep; const char* b2 = last ? nB : cB + (size_t)(t + 2) * kstep;
            const char* a3 = a2 + kstep; const char* b3 = b2 + kstep;
            if (last && has_next) S.a_ready(nxt);
            if constexpr (SP2) {
            PG8_LDB(B0, 0, 0); PG8_LDB(B1, 0, 1); PG8_SCHED; PG8_LDA(At, 0, 0); PG8_STAGE(PG8_SA(1, 1), a1 + hstep, voffA);
            PG8_WAIT_V(8); PG8_WAIT_L(0); PG8_BAR; PG8_MMA(0, 0, At, B0); PG8_MMA(0, 1, At, B1); PG8_BAR; PG8_SCHED;
            PG8_LDA(At, 0, 1); PG8_STAGE(PG8_SB(0, 0), b2, voffB); PG8_STAGE(PG8_SB(0, 1), b2 + hstep, voffB); PG8_STAGE(PG8_SA(0, 0), a2, voffA);
            PG8_WAIT_V(8); PG8_WAIT_L(0); PG8_BAR; PG8_MMA(1, 0, At, B0); PG8_MMA(1, 1, At, B1); PG8_BAR; PG8_SCHED;
            PG8_LDB(B0, 1, 0); PG8_LDB(B1, 1, 1); PG8_SCHED; PG8_LDA(At, 1, 0); PG8_STAGE(PG8_SA(0, 1), a2 + hstep, voffA);
            PG8_WAIT_V(8); PG8_WAIT_L(0); PG8_BAR; PG8_MMA(0, 0, At, B0); PG8_MMA(0, 1, At, B1); PG8_BAR; PG8_SCHED;
            PG8_LDA(At, 1, 1); PG8_STAGE(PG8_SB(1, 0), b3, voffB); PG8_STAGE(PG8_SB(1, 1), b3 + hstep, voffB); PG8_STAGE(PG8_SA(1, 0), a3, voffA);
            PG8_WAIT_V(8); PG8_WAIT_L(0); PG8_BAR; PG8_MMA(1, 0, At, B0); PG8_MMA(1, 1, At, B1); PG8_BAR; PG8_SCHED;
            } else {
            PG8_LDB(B0, 0, 0); PG8_SCHED; PG8_LDA(At, 0, 0); PG8_STAGE(PG8_SA(1, 1), a1 + hstep, voffA);
            PG8_WAIT_L(8); PG8_BAR; PG8_WAIT_L(0); PG8_MMA(0, 0, At, B0); PG8_BAR; PG8_SCHED;
            PG8_LDB(B1, 0, 1); PG8_STAGE(PG8_SB(0, 0), b2, voffB);
            PG8_BAR; PG8_WAIT_L(0); PG8_MMA(0, 1, At, B1); PG8_BAR;
            PG8_LDA(At, 0, 1); PG8_STAGE(PG8_SA(0, 0), a2, voffA);
            PG8_BAR; PG8_WAIT_L(0); PG8_MMA(1, 0, At, B0); PG8_BAR; PG8_SCHED;
            PG8_STAGE(PG8_SB(0, 1), b2 + hstep, voffB);
            PG8_WAIT_V(6); PG8_BAR; PG8_MMA(1, 1, At, B1); PG8_BAR;
            PG8_LDB(B0, 1, 0); PG8_SCHED; PG8_LDA(At, 1, 0); PG8_STAGE(PG8_SA(0, 1), a2 + hstep, voffA);
            PG8_WAIT_L(8); PG8_BAR; PG8_WAIT_L(0); PG8_MMA(0, 0, At, B0); PG8_BAR; PG8_SCHED;
            PG8_LDB(B1, 1, 1); PG8_STAGE(PG8_SB(1, 0), b3, voffB);
            PG8_BAR; PG8_WAIT_L(0); PG8_MMA(0, 1, At, B1); PG8_BAR;
            PG8_LDA(At, 1, 1); PG8_STAGE(PG8_SA(1, 0), a3, voffA);
            PG8_BAR; PG8_WAIT_L(0); PG8_MMA(1, 0, At, B0); PG8_BAR; PG8_SCHED;
            PG8_STAGE(PG8_SB(1, 1), b3 + hstep, voffB);
            PG8_WAIT_V(6); PG8_BAR; PG8_MMA(1, 1, At, B1); PG8_BAR;
            }
        }
        if constexpr (ALIGN_EPI) { if (wr == 0) PG8_BAR; }
        if constexpr (!Epi::AFTER_DRAIN) { E(acc, cur, wr, wc, fr, fq); S.done(cur); }
        if (!has_next) break;
#pragma unroll
        for (int a = 0; a < 2; ++a)
#pragma unroll
            for (int b = 0; b < 2; ++b)
#pragma unroll
                for (int m = 0; m < 4; ++m)
#pragma unroll
                    for (int n = 0; n < 2; ++n) acc[a][b][m][n] = (f32x4){0.f, 0.f, 0.f, 0.f};
        cur = nxt; cA = nA; cB = nB; ++ui;
        if constexpr (ALIGN_EPI) { if (wr == 1) PG8_BAR; }
    }
    PG8_WAIT_V(0);
    if constexpr (!ALIGN_EPI) { if (wr == 0) PG8_BAR; }
    PG8_BAR;
    if constexpr (Epi::AFTER_DRAIN) { E.fused(acc, cur, wr, wc, fr, fq, lds, wid, lane); S.done(cur); }
#undef PG8_SA
#undef PG8_SB
#undef PG8_STAGE
#undef PG8_LDA
#undef PG8_LDB
#undef PG8_MMA
#undef PG8_WAIT_V
#undef PG8_WAIT_L
#undef PG8_BAR
#undef PG8_SCHED
}
}
namespace pg8 {
__device__ __forceinline__ u32x4 pack8(const f32x4 a, const f32x4 b) { u32x4 w; w.x = cvt_pk_bf16(a[0], a[1]); w.y = cvt_pk_bf16(a[2], a[3]); w.z = cvt_pk_bf16(b[0], b[1]); w.w = cvt_pk_bf16(b[2], b[3]); return w; }

struct EpiInProj {
    static constexpr bool PERM = true, AFTER_DRAIN = false;
    bf16_t* Q; bf16_t* KV; bf16_t* Z; bf16_t* BG; float* G; const float* qn; const float* kn;
    __device__ __forceinline__ void operator()(const f32x4 (&acc)[2][2][4][2], const Unit& u, int wr, int wc, int fr, int fq) const {
        const int pn = u.pn; const int row0 = u.pm * BM + wr * 64 + fr;
        if (pn <= 4) {
            const bool donorm = (pn < 2) || (pn >= 3 && wc < 2);
            const float* nw = (pn < 2) ? qn : kn;
            const float sc = (pn < 2) ? (0.125f * 1.4426950408889634f) : 1.0f;
            f32x4 w4[2][2];
#pragma unroll
            for (int bj = 0; bj < 2; ++bj)
#pragma unroll
                for (int n = 0; n < 2; ++n) { f32x4 t = *(const f32x4*)(nw + 32 * bj + 8 * fq + 4 * n); w4[bj][n] = donorm ? t * sc : (f32x4){1.f, 1.f, 1.f, 1.f}; }
            bf16_t* base; size_t rstride;
            if (pn < 2) { base = Q + (4 * pn + wc) * 64 + 8 * fq; rstride = 512; }
            else { const int ti = (pn - 2) * 2 + (wc >> 1), g = wc & 1; base = KV + (size_t)ti * ((size_t)4 * 2 * 8192 * 64) + 8 * fq; rstride = 64;
                   base += (size_t)g * 8192 * 64; }
#pragma unroll
            for (int ai = 0; ai < 2; ++ai)
#pragma unroll
                for (int m = 0; m < 4; ++m) {
                    const int r = row0 + ai * HALF + m * 16;
                    float rs = 1.f;
                    if (donorm) {
                        float ss = 0.f;
#pragma unroll
                        for (int bj = 0; bj < 2; ++bj)
#pragma unroll
                            for (int n = 0; n < 2; ++n) { const f32x4 x = acc[ai][bj][m][n]; ss += (x[0] * x[0] + x[1] * x[1]) + (x[2] * x[2] + x[3] * x[3]); }
                        ss += __shfl_xor(ss, 16); ss += __shfl_xor(ss, 32);
                        rs = 1.0f / sqrtf(ss * (1.0f / 64.0f) + 1e-6f);
                    }
                    size_t off;
                    if (pn < 2) off = (size_t)r * 512;
                    else { const int b = r >> 13, t = r & 8191; off = ((size_t)(b * 2) * 8192 + t) * 64; }
#pragma unroll
                    for (int bj = 0; bj < 2; ++bj) {
                        const f32x4 v0 = acc[ai][bj][m][0] * rs * w4[bj][0], v1 = acc[ai][bj][m][1] * rs * w4[bj][1];
                        *(u32x4*)(base + off + 32 * bj) = pack8(v0, v1);
                    }
                }
        } else if (pn <= 8) {
            bf16_t* base = Z + 128 * (pn - 5) + 32 * wc + 8 * fq;
#pragma unroll
            for (int ai = 0; ai < 2; ++ai)
#pragma unroll
                for (int m = 0; m < 4; ++m) {
                    const int r = row0 + ai * HALF + m * 16;
                    const f32x4 v0 = acc[ai][0][m][0] * acc[ai][1][m][0], v1 = acc[ai][0][m][1] * acc[ai][1][m][1];
                    *(u32x4*)(base + (size_t)r * 512) = pack8(v0, v1);
                }
        } else if (pn <= 10) {
            bf16_t* base = BG + 256 * (pn - 9) + 32 * wc + 8 * fq;
#pragma unroll
            for (int ai = 0; ai < 2; ++ai)
#pragma unroll
                for (int m = 0; m < 4; ++m) {
                    const int r = row0 + ai * HALF + m * 16;
#pragma unroll
                    for (int bj = 0; bj < 2; ++bj) *(u32x4*)(base + (size_t)r * 512 + 128 * bj) = pack8(acc[ai][bj][m][0], acc[ai][bj][m][1]);
                }
        } else {
            if (wc == 0 && fq < 3) {
#pragma unroll
                for (int ai = 0; ai < 2; ++ai)
#pragma unroll
                    for (int m = 0; m < 4; ++m) {
                        const int r = row0 + ai * HALF + m * 16;
#pragma unroll
                        for (int n = 0; n < 2; ++n) { const f32x4 x = acc[ai][0][m][n]; f32x4 s;
#pragma unroll
                            for (int e = 0; e < 4; ++e) s[e] = 1.0f / (1.0f + __expf(-x[e]));
                            *(f32x4*)(G + (size_t)r * 32 + 8 * fq + 4 * n) = s; }
                    }
            }
        }
    }
};

struct EpiOutProj {
    static constexpr bool PERM = true, AFTER_DRAIN = false;
    const float* x; bf16_t* X1B; bf16_t* A2; float* RSS; const float* mod; const float* n2;
    __device__ __forceinline__ void operator()(const f32x4 (&acc)[2][2][4][2], const Unit& u, int wr, int wc, int fr, int fq) const {
        const int row0 = u.pm * BM + wr * 64 + fr; const int b = (u.pm * BM) >> 13;
        const int col0 = u.pn * BM + wc * 32 + 8 * fq;
        f32x4 g1[2][2], a2[2][2];
#pragma unroll
        for (int bj = 0; bj < 2; ++bj)
#pragma unroll
            for (int n = 0; n < 2; ++n) { const int c = col0 + 128 * bj + 4 * n;
                g1[bj][n] = *(const f32x4*)(mod + (size_t)b * 6144 + 2 * 1024 + c);
                const f32x4 s2 = *(const f32x4*)(mod + (size_t)b * 6144 + 4 * 1024 + c), nn = *(const f32x4*)(n2 + c);
                a2[bj][n] = nn * (s2 + 1.0f); }
#pragma unroll
        for (int ai = 0; ai < 2; ++ai)
#pragma unroll
          for (int mh = 0; mh < 2; ++mh) {
            f32x4 xv[2][2][2];
#pragma unroll
            for (int mm = 0; mm < 2; ++mm)
#pragma unroll
                for (int bj = 0; bj < 2; ++bj) { const size_t off = (size_t)(row0 + ai * HALF + (2 * mh + mm) * 16) * 1024 + col0 + 128 * bj; xv[mm][bj][0] = *(const f32x4*)(x + off); xv[mm][bj][1] = *(const f32x4*)(x + off + 4); }
#pragma unroll
            for (int mm = 0; mm < 2; ++mm)
#pragma unroll
                for (int bj = 0; bj < 2; ++bj) asm volatile("" : "+v"(xv[mm][bj][0]), "+v"(xv[mm][bj][1]));
#pragma unroll
            for (int mm = 0; mm < 2; ++mm) {
                const int m = 2 * mh + mm;
                const int r = row0 + ai * HALF + m * 16; float ss = 0.f;
#pragma unroll
                for (int bj = 0; bj < 2; ++bj) {
                    const size_t off = (size_t)r * 1024 + col0 + 128 * bj;
                    const f32x4 ya = xv[mm][bj][0] + g1[bj][0] * acc[ai][bj][m][0], yb = xv[mm][bj][1] + g1[bj][1] * acc[ai][bj][m][1];
                    *(u32x4*)(X1B + off) = pack8(ya, yb);
                    ss += (ya[0] * ya[0] + ya[1] * ya[1]) + (ya[2] * ya[2] + ya[3] * ya[3]) + (yb[0] * yb[0] + yb[1] * yb[1]) + (yb[2] * yb[2] + yb[3] * yb[3]);
                    *(u32x4*)(A2 + off) = pack8(ya * a2[bj][0], yb * a2[bj][1]);
                }
                ss += __shfl_xor(ss, 16); ss += __shfl_xor(ss, 32);
                if (fq == 0) RSS[(size_t)r * 16 + u.pn * 4 + wc] = ss;
            }
          }
    }
};

struct EpiFF1 {
    static constexpr bool PERM = true, AFTER_DRAIN = false;
    bf16_t* HID; const float* RSS; const float* bff1;
    __device__ __forceinline__ void operator()(const f32x4 (&acc)[2][2][4][2], const Unit& u, int wr, int wc, int fr, int fq) const {
        const int row0 = u.pm * BM + wr * 64 + fr; const int b = (u.pm * BM) >> 13;
        const int col0 = u.pn * BM + wc * 32 + 8 * fq;
        f32x4 bv[2][2];
#pragma unroll
        for (int bj = 0; bj < 2; ++bj)
#pragma unroll
            for (int n = 0; n < 2; ++n) bv[bj][n] = *(const f32x4*)(bff1 + (size_t)b * 4096 + col0 + 128 * bj + 4 * n);
#pragma unroll
        for (int ai = 0; ai < 2; ++ai) {
            f32x4 sv[4][4];
#pragma unroll
            for (int m = 0; m < 4; ++m)
#pragma unroll
                for (int q = 0; q < 4; ++q) sv[m][q] = *(const f32x4*)(RSS + (size_t)(row0 + ai * HALF + m * 16) * 16 + 4 * q);
#pragma unroll
            for (int m = 0; m < 4; ++m) asm volatile("" : "+v"(sv[m][0]), "+v"(sv[m][1]), "+v"(sv[m][2]), "+v"(sv[m][3]));
#pragma unroll
            for (int m = 0; m < 4; ++m) {
                const int r = row0 + ai * HALF + m * 16;
                const f32x4 st = (sv[m][0] + sv[m][1]) + (sv[m][2] + sv[m][3]);
                const float rs = 1.0f / sqrtf(((st[0] + st[1]) + (st[2] + st[3])) * (1.0f / 1024.0f) + 1e-6f);
#pragma unroll
                for (int bj = 0; bj < 2; ++bj) {
                    f32x4 h0 = acc[ai][bj][m][0] * rs + bv[bj][0], h1 = acc[ai][bj][m][1] * rs + bv[bj][1];
#pragma unroll
                    for (int e = 0; e < 4; ++e) { const float a = fmaxf(h0[e], 0.f), c = fmaxf(h1[e], 0.f); h0[e] = a * a; h1[e] = c * c; }
                    *(u32x4*)(HID + (size_t)r * 4096 + col0 + 128 * bj) = pack8(h0, h1);
                }
            }
        }
    }
};

struct EpiFF2 {
    static constexpr bool PERM = true, AFTER_DRAIN = false;
    const bf16_t* X1B; const float* mod; float* dst;
    __device__ __forceinline__ void operator()(const f32x4 (&acc)[2][2][4][2], const Unit& u, int wr, int wc, int fr, int fq) const {
        const int row0 = u.pm * BM + wr * 64 + fr; const int b = (u.pm * BM) >> 13;
        const int col0 = u.pn * BM + wc * 32 + 8 * fq;
        f32x4 g2[2][2];
#pragma unroll
        for (int bj = 0; bj < 2; ++bj)
#pragma unroll
            for (int n = 0; n < 2; ++n) g2[bj][n] = *(const f32x4*)(mod + (size_t)b * 6144 + 5 * 1024 + col0 + 128 * bj + 4 * n);
#pragma unroll
        for (int ai = 0; ai < 2; ++ai) {
            u32x4 xv[4][2];
#pragma unroll
            for (int m = 0; m < 4; ++m)
#pragma unroll
                for (int bj = 0; bj < 2; ++bj) { const size_t off = (size_t)(row0 + ai * HALF + m * 16) * 1024 + col0 + 128 * bj; xv[m][bj] = *(const u32x4*)(X1B + off); }
#pragma unroll
            for (int m = 0; m < 4; ++m)
#pragma unroll
                for (int bj = 0; bj < 2; ++bj) asm volatile("" : "+v"(xv[m][bj]));
#pragma unroll
            for (int m = 0; m < 4; ++m)
#pragma unroll
                for (int bj = 0; bj < 2; ++bj) {
                    const size_t off = (size_t)(row0 + ai * HALF + m * 16) * 1024 + col0 + 128 * bj;
                    const u32x4 w = xv[m][bj];
                    const f32x4 xa = {__builtin_bit_cast(float, w.x << 16), __builtin_bit_cast(float, w.x & 0xffff0000u), __builtin_bit_cast(float, w.y << 16), __builtin_bit_cast(float, w.y & 0xffff0000u)};
                    const f32x4 xb = {__builtin_bit_cast(float, w.z << 16), __builtin_bit_cast(float, w.z & 0xffff0000u), __builtin_bit_cast(float, w.w << 16), __builtin_bit_cast(float, w.w & 0xffff0000u)};
                    *(f32x4*)(dst + off) = xa + g2[bj][0] * acc[ai][bj][m][0]; *(f32x4*)(dst + off + 4) = xb + g2[bj][1] * acc[ai][bj][m][1];
                }
        }
    }
};
}

#ifndef MK_N_LAUNCHES
#define MK_N_LAUNCHES 1
#endif
constexpr int NWAVES = 8;
constexpr int N_PHASES = 8;
constexpr int BATCH = 4, T = 8192, D = 1024, M = BATCH * T, FF = 4096, NIN = 3072, INCOLS = 2840;
constexpr int NCMP = 511;
constexpr float LOG2E = 1.4426950408889634f;
constexpr size_t MiB = 1u << 20;
constexpr size_t WS_CTL = 0, CTL_ZERO_BYTES = 32 * 1024;
constexpr size_t WS_MOD = 1 * MiB;
constexpr size_t WS_BFF1 = 1 * MiB + 128 * 1024;
constexpr size_t WS_PEP = 1 * MiB + 256 * 1024;
constexpr size_t WS_RSS = 2 * MiB;
constexpr size_t WS_G = 4 * MiB;
constexpr size_t WS_WIN = 8 * MiB;
constexpr size_t WS_WOUT = 14 * MiB;
constexpr size_t WS_W1 = 16 * MiB;
constexpr size_t WS_W2 = 24 * MiB;
constexpr size_t WS_CW1K = 32 * MiB, WS_CW1V = 33 * MiB;
constexpr size_t WS_CW2K = 34 * MiB, WS_CW2V = 34 * MiB + 64 * 1024;
constexpr size_t WS_KC = 35 * MiB, WS_VC = 35 * MiB + 512 * 1024;
constexpr size_t WS_A2 = 36 * MiB;
constexpr size_t WS_H = 100 * MiB;
constexpr size_t WS_Q = 164 * MiB;
constexpr size_t WS_KV = 196 * MiB;
constexpr size_t KV_TENS = (size_t)4 * 2 * 8192 * 64;
constexpr size_t WS_Z = 244 * MiB;
constexpr size_t WS_BG = 276 * MiB;
constexpr size_t WS_MIX = 308 * MiB;
constexpr size_t WS_HID = 100 * MiB;
constexpr size_t WS_X1B = 380 * MiB;
constexpr size_t WS_END = 444 * MiB;
constexpr int CW_BAR = 4096;

constexpr int RING_BYTES = 131072;
constexpr int LDSCTL_OFF = 151 * 1024, MISC_OFF = LDSCTL_OFF + 320;
constexpr int LDS_BYTES = 152 * 1024;

#define GAS __attribute__((address_space(1)))
#define LAS __attribute__((address_space(3)))
typedef unsigned short bf16;
typedef unsigned v4u __attribute__((ext_vector_type(4)));
typedef float f32x4 __attribute__((ext_vector_type(4)));
typedef float f32x16 __attribute__((ext_vector_type(16)));
typedef short bf16x8 __attribute__((ext_vector_type(8)));
typedef short s16x4 __attribute__((ext_vector_type(4)));
typedef GAS unsigned gu32;
#define RLX_AGENT __ATOMIC_RELAXED, __HIP_MEMORY_SCOPE_AGENT
#define LDS_WAIT() asm volatile("s_waitcnt lgkmcnt(0)" ::: "memory")
#define VM_WAIT() asm volatile("s_waitcnt vmcnt(0)" ::: "memory")
__device__ __forceinline__ unsigned f2bf(float f) { unsigned u = __builtin_bit_cast(unsigned, f); return (u + 0x7fffu + ((u >> 16) & 1u)) >> 16; }
__device__ __forceinline__ unsigned pk2(float lo, float hi) { return f2bf(lo) | (f2bf(hi) << 16); }
__device__ __forceinline__ float bf2f(unsigned short h) { return __builtin_bit_cast(float, (unsigned)h << 16); }
#define XB_TMO      128
#define XB_XCNT(j)  (256  + 64 * (j))
#define XB_XSUB(j)  (1280 + 64 * (j))
#define XB_XGEN(j)  (2304 + 64 * (j))
#define XB_TOP      3328
#define XB_TOPGEN   3392
#define XCD_BAR_WORDS 3456
#define XB_SPIN_CAP (1u << 18)

__device__ __forceinline__ unsigned xb_ld(unsigned* p)              { return __hip_atomic_load(p, __ATOMIC_RELAXED, __HIP_MEMORY_SCOPE_AGENT); }
__device__ __forceinline__ unsigned xb_add(unsigned* p, unsigned v) { return __hip_atomic_fetch_add(p, v, __ATOMIC_RELAXED, __HIP_MEMORY_SCOPE_AGENT); }
__device__ __forceinline__ unsigned xb_xcc_id() { return (unsigned)__builtin_amdgcn_s_getreg((3 << 11) | 20) & 0xFu; }
#define XB_SPIN(cond, bar) do { unsigned _sp = 0; while (cond) { __builtin_amdgcn_s_sleep(1); \
    if ((++_sp & 255u) == 0u) { if (xb_ld(&(bar)[XB_TMO])) break; if (_sp > XB_SPIN_CAP) { atomicAdd(&(bar)[XB_TMO], 1u); break; } } } } while (0)

struct XcdBarrier {
    unsigned* bar; unsigned x;
    volatile LAS unsigned* st;
};

__device__ __forceinline__ XcdBarrier xcd_barrier_post(unsigned* bar, volatile LAS unsigned* st) {
    XcdBarrier b; b.bar = bar; b.x = xb_xcc_id(); b.st = st;
    if (threadIdx.x == 0) (void)xb_add(&bar[XB_XCNT(b.x)], 1u);
    return b;
}
__device__ __forceinline__ void xcd_barrier_complete(unsigned* bar, unsigned x, unsigned& nloc, unsigned& nx) {
    const unsigned G = gridDim.x * gridDim.y * gridDim.z;
    unsigned sum, cnt, mine, sp = 0u;
    for (;;) {
        sum = 0u; cnt = 0u; mine = 0u;
#pragma unroll
        for (unsigned j = 0; j < 16; ++j) { const unsigned c = xb_ld(&bar[XB_XCNT(j)]); sum += c; cnt += (c > 0u) ? 1u : 0u; mine = (j == x) ? c : mine; }
        if (sum == G) break;
        __builtin_amdgcn_s_sleep(1);
        if ((++sp & 255u) == 0u) { if (xb_ld(&bar[XB_TMO])) break; if (sp > XB_SPIN_CAP) { atomicAdd(&bar[XB_TMO], 1u); break; } }
    }
    nloc = mine > 0u ? mine : 1u; nx = cnt > 0u ? cnt : 1u;
}

__device__ __forceinline__ void xcd_barrier(const XcdBarrier& b) {
    asm volatile("s_waitcnt vmcnt(0)" ::: "memory");
    __syncthreads();
    if (threadIdx.x == 0) {
        unsigned* bar = b.bar;
        __builtin_amdgcn_s_waitcnt(0);
        unsigned nloc = b.st[0], nx = b.st[1];
        if (nloc == 0u) { xcd_barrier_complete(bar, b.x, nloc, nx); b.st[0] = nloc; b.st[1] = nx; }
        const unsigned old = xb_add(&bar[XB_XSUB(b.x)], 1u);
        const unsigned gen = old / nloc;
        if (old + 1u == (gen + 1u) * nloc) {
            __builtin_amdgcn_fence(__ATOMIC_RELEASE, "agent");
            asm volatile("s_waitcnt vmcnt(0)" ::: "memory");
            const unsigned og = xb_add(&bar[XB_TOP], 1u);
            const unsigned tg = og / nx;
            if (og + 1u == (tg + 1u) * nx) xb_add(&bar[XB_TOPGEN], 1u);
            else XB_SPIN(xb_ld(&bar[XB_TOPGEN]) == tg, bar);
            __builtin_amdgcn_fence(__ATOMIC_ACQUIRE, "agent");
            xb_add(&bar[XB_XGEN(b.x)], 1u);
            asm volatile("s_waitcnt vmcnt(0)" ::: "memory");
        } else {
            XB_SPIN(xb_ld(&bar[XB_XGEN(b.x)]) == gen, bar);
            __builtin_amdgcn_fence(__ATOMIC_ACQUIRE, "agent");
            asm volatile("s_waitcnt vmcnt(0)" ::: "memory");
        }
    }
    __syncthreads();
}

struct Frame {
    LAS unsigned char* lds;
    volatile LAS unsigned* MISC;
    gu32* ctl;
    int tid, lane, wave;
    int vcu, G;
    const float* in[20];
    float* out;
    unsigned char* ws;
    unsigned long long tp_t0, tp_acc;
};
#ifdef ATP_A
#define ATP(F, id) do { if ((id) == ATP_A) (F).tp_t0 = __builtin_amdgcn_s_memrealtime(); if ((id) == ATP_B) (F).tp_acc += __builtin_amdgcn_s_memrealtime() - (F).tp_t0; } while (0)
#else
#define ATP(F, id) do {} while (0)
#endif
__device__ __forceinline__ float wave_sum(float v) {
#pragma unroll
    for (int o = 1; o < 64; o <<= 1) v += __shfl_xor(v, o);
    return v;
}

__device__ __forceinline__ void p0_transpose_item(const float* W, int K, int N, int nsrc0, int nvalid, bf16* WT, int drow0, int kb, LAS float* scr, int lane) {
    const int k0 = 64 * kb; const int nl = lane & 31;
    float tv[32];
#pragma unroll
    for (int i = 0; i < 32; ++i) { const int kk = 2 * i + (lane >> 5); tv[i] = (nl < nvalid) ? W[(size_t)(k0 + kk) * N + nsrc0 + nl] : 0.f; }
#pragma unroll
    for (int i = 0; i < 32; ++i) { const int kk = 2 * i + (lane >> 5); scr[kk * 33 + nl] = tv[i]; }
    LDS_WAIT(); asm volatile("" ::: "memory");
    const int c = lane & 7;
#pragma unroll
    for (int j = 0; j < 4; ++j) { const int n = (lane >> 3) + 8 * j; const LAS float* s = scr + (8 * c) * 33 + n;
        v4u o; o.x = pk2(s[0 * 33], s[1 * 33]); o.y = pk2(s[2 * 33], s[3 * 33]); o.z = pk2(s[4 * 33], s[5 * 33]); o.w = pk2(s[6 * 33], s[7 * 33]);
        *(GAS v4u*)(WT + (size_t)(drow0 + n) * K + k0 + 8 * c) = o; }
    LDS_WAIT(); asm volatile("" ::: "memory");
}
__device__ __forceinline__ void win_src(int rb, int& src0, int& nvalid) {
    const int pn = rb >> 3, q = rb & 7, bj = q >> 2, wc = q & 3; nvalid = 32;
    if (pn < 2) src0 = (4 * pn + wc) * 64 + 32 * bj;
    else if (pn < 5) src0 = 512 + (pn - 2) * 256 + (wc >> 1) * 128 + (wc & 1) * 64 + 32 * bj;
    else if (pn < 9) src0 = (bj == 0 ? 1304 : 2328) + 128 * (pn - 5) + 32 * wc;
    else if (pn < 11) src0 = 1816 + 256 * (pn - 9) + 32 * q;
    else { src0 = 1280; nvalid = (q == 0) ? 24 : 0; }
}
__device__ __forceinline__ void p0_phase(Frame& F) {
    const int bid = blockIdx.x;
    for (int it = bid; it < 224; it += F.G) {
      if (it < 192) {
        const int cb = it;
        LAS float* sc = (LAS float*)(F.lds);
        LAS float* red = (LAS float*)(F.lds + 16384);
        const float* c = F.in[1];
        for (int i = F.tid; i < 4096; i += 512) { const float v = c[i]; sc[i] = v / (1.0f + __expf(-v)); }
        __syncthreads();
        const float* wa = F.in[16]; const int col = 32 * cb + (F.lane & 31), kpar = F.lane >> 5;
        float a0 = 0.f, a1 = 0.f, a2 = 0.f, a3 = 0.f;
#pragma unroll 32
        for (int i = 0; i < 64; ++i) { const int k = 128 * F.wave + 2 * i + kpar; const float w = wa[(size_t)k * 6144 + col];
            a0 += sc[k] * w; a1 += sc[1024 + k] * w; a2 += sc[2048 + k] * w; a3 += sc[3072 + k] * w; }
        a0 += __shfl_xor(a0, 32); a1 += __shfl_xor(a1, 32); a2 += __shfl_xor(a2, 32); a3 += __shfl_xor(a3, 32);
        if (F.lane < 32) { red[(F.wave * 4 + 0) * 32 + F.lane] = a0; red[(F.wave * 4 + 1) * 32 + F.lane] = a1; red[(F.wave * 4 + 2) * 32 + F.lane] = a2; red[(F.wave * 4 + 3) * 32 + F.lane] = a3; }
        __syncthreads();
        if (F.tid < 128) { const int b = F.tid >> 5, cc = F.tid & 31; float s = F.in[17][32 * cb + cc];
#pragma unroll
            for (int w = 0; w < 8; ++w) s += red[(w * 4 + b) * 32 + cc];
            ((float*)(F.ws + WS_MOD))[b * 6144 + 32 * cb + cc] = s; }
        __syncthreads();
      } else {
        const int kv = (it - 192) >> 4, kc = (it - 192) & 15; const float* pe = F.in[kv ? 8 : 5]; const float* w1 = F.in[kv ? 9 : 6];
        if (F.tid < 256) { float s = 0.f;
#pragma unroll 32
            for (int k = 128 * kc; k < 128 * kc + 128; ++k) s += pe[k] * w1[(size_t)k * 256 + F.tid];
            ((float*)(F.ws + WS_PEP))[(kv * 16 + kc) * 256 + F.tid] = s; }
      }
    }
    __syncthreads();
    LAS float* scr = (LAS float*)(F.lds + F.wave * 16384);
    const int gw = F.vcu * NWAVES + F.wave, NGW = F.G * NWAVES;
    constexpr int I_IN = 96 * 16, I_OUT = 32 * 16, I_1 = 128 * 16, I_2 = 32 * 64, I_C1 = 8 * 32, I_C2 = 2 * 4;
    constexpr int NITEMS = I_IN + I_OUT + I_1 + I_2 + 2 * I_C1 + 2 * I_C2;
    for (int it = gw; it < NITEMS; it += NGW) {
        int r = it;
        if (r < I_IN) { const int rb = r >> 4, kb = r & 15; int s0, nv; win_src(rb, s0, nv); p0_transpose_item(F.in[2], D, INCOLS, s0, nv, (bf16*)(F.ws + WS_WIN), 32 * rb, kb, scr, F.lane); continue; } r -= I_IN;
        if (r < I_OUT) { const int rb = r >> 4, kb = r & 15; p0_transpose_item(F.in[13], D, D, 32 * rb, 32, (bf16*)(F.ws + WS_WOUT), 32 * rb, kb, scr, F.lane); continue; } r -= I_OUT;
        if (r < I_1) { const int rb = r >> 4, kb = r & 15; p0_transpose_item(F.in[18], D, FF, 32 * rb, 32, (bf16*)(F.ws + WS_W1), 32 * rb, kb, scr, F.lane); continue; } r -= I_1;
        if (r < I_2) { const int rb = r >> 6, kb = r & 63; p0_transpose_item(F.in[19], FF, D, 32 * rb, 32, (bf16*)(F.ws + WS_W2), 32 * rb, kb, scr, F.lane); continue; } r -= I_2;
        if (r < I_C1) { const int rb = r >> 5, kb = r & 31; p0_transpose_item(F.in[6], 2048, 256, 32 * rb, 32, (bf16*)(F.ws + WS_CW1K), 32 * rb, kb, scr, F.lane); continue; } r -= I_C1;
        if (r < I_C1) { const int rb = r >> 5, kb = r & 31; p0_transpose_item(F.in[9], 2048, 256, 32 * rb, 32, (bf16*)(F.ws + WS_CW1V), 32 * rb, kb, scr, F.lane); continue; } r -= I_C1;
        if (r < I_C2) { const int rb = r >> 2, kb = r & 3; p0_transpose_item(F.in[7], 256, 64, 32 * rb, 32, (bf16*)(F.ws + WS_CW2K), 32 * rb, kb, scr, F.lane); continue; } r -= I_C2;
        { const int rb = r >> 2, kb = r & 3; p0_transpose_item(F.in[10], 256, 64, 32 * rb, 32, (bf16*)(F.ws + WS_CW2V), 32 * rb, kb, scr, F.lane); }
    }
    __syncthreads();
}

__device__ __forceinline__ void p1_phase(Frame& F) {
    const int gw = F.vcu * NWAVES + F.wave, NGW = F.G * NWAVES;
    const float* mod = (const float*)(F.ws + WS_MOD);
    const float* x = F.in[0]; const float* n1 = F.in[14];
    bf16* H = (bf16*)(F.ws + WS_H);
    ATP(F, 10);
    for (int chunk = gw; chunk < M / 16; chunk += NGW) {
        const int r0 = chunk * 16, b = r0 >> 13;
        f32x4 ca[4], cb[4];
#pragma unroll
        for (int j = 0; j < 4; ++j) { const int c = 4 * (F.lane + 64 * j);
            const f32x4 nn = *(const f32x4*)(n1 + c), s1 = *(const f32x4*)(mod + (size_t)b * 6144 + 1024 + c);
            ca[j] = nn * (s1 + 1.0f); cb[j] = *(const f32x4*)(mod + (size_t)b * 6144 + c); }
        for (int rr = 0; rr < 16; rr += 4) {
            f32x4 v[4][4]; float s[4];
#pragma unroll
            for (int q = 0; q < 4; ++q) { const GAS f32x4* xr = (const GAS f32x4*)(x + (size_t)(r0 + rr + q) * D) + F.lane;
#pragma unroll
                for (int j = 0; j < 4; ++j) v[q][j] = xr[64 * j]; }
#pragma unroll
            for (int q = 0; q < 4; ++q) { s[q] = 0.f;
#pragma unroll
                for (int j = 0; j < 4; ++j) s[q] += (v[q][j].x * v[q][j].x + v[q][j].y * v[q][j].y) + (v[q][j].z * v[q][j].z + v[q][j].w * v[q][j].w); }
#pragma unroll
            for (int o = 1; o < 64; o <<= 1) {
#pragma unroll
                for (int q = 0; q < 4; ++q) s[q] += __shfl_xor(s[q], o); }
#pragma unroll
            for (int q = 0; q < 4; ++q) {
                const float rs = 1.0f / sqrtf(s[q] * (1.0f / D) + 1e-6f);
                GAS unsigned long long* o8 = (GAS unsigned long long*)(H + (size_t)(r0 + rr + q) * D) + F.lane;
#pragma unroll
                for (int j = 0; j < 4; ++j) { const f32x4 h = v[q][j] * rs * ca[j] + cb[j];
                    o8[64 * j] = (unsigned long long)pk2(h.x, h.y) | ((unsigned long long)pk2(h.z, h.w) << 32); }
            }
        }
    }
    ATP(F, 11);
    const bf16* W1t = (const bf16*)(F.ws + WS_W1);
    float* bff1 = (float*)(F.ws + WS_BFF1);
    for (int n = gw; n < FF; n += NGW) {
        float a[4] = {0.f, 0.f, 0.f, 0.f};
#pragma unroll
        for (int j = 0; j < 2; ++j) { const int k0 = 8 * F.lane + 512 * j;
            const v4u wv = *(const GAS v4u*)(W1t + (size_t)n * D + k0);
            float w[8]; w[0] = bf2f(wv.x & 0xffff); w[1] = bf2f(wv.x >> 16); w[2] = bf2f(wv.y & 0xffff); w[3] = bf2f(wv.y >> 16); w[4] = bf2f(wv.z & 0xffff); w[5] = bf2f(wv.z >> 16); w[6] = bf2f(wv.w & 0xffff); w[7] = bf2f(wv.w >> 16);
#pragma unroll
            for (int b = 0; b < 4; ++b) { const f32x4 s0 = *(const f32x4*)(mod + (size_t)b * 6144 + 3 * 1024 + k0), s1 = *(const f32x4*)(mod + (size_t)b * 6144 + 3 * 1024 + k0 + 4);
                a[b] += (w[0] * s0[0] + w[1] * s0[1]) + (w[2] * s0[2] + w[3] * s0[3]) + (w[4] * s1[0] + w[5] * s1[1]) + (w[6] * s1[2] + w[7] * s1[3]); } }
#pragma unroll
        for (int b = 0; b < 4; ++b) { const float s = wave_sum(a[b]); if (F.lane == 0) bff1[b * 4096 + n] = s; }
    }
    ATP(F, 12);
}

__device__ __forceinline__ float gelu_tanh(float x) {
    const float u = 0.7978845608028654f * (x + 0.044715f * x * x * x);
    const float e = __expf(2.0f * u);
    const float th = 1.0f - 2.0f / (1.0f + e);
    return 0.5f * x * (1.0f + th);
}
__device__ __forceinline__ void p3_phase(Frame& F) {
    constexpr int AIMG = 0, GSTR = 2064, HIDO = 68224, HSTR = 528, OUTO = 85120, OSTR = 65;
    const int lane = F.lane, w = F.wave, r32 = lane & 31, hi = lane >> 5;
    for (int item = blockIdx.x; item < 256; item += F.G) {
        const int prob = item >> 4, mt = item & 15, kv = prob >> 3, b = (prob >> 1) & 3, g = prob & 1, n0 = 32 * mt;
        const bf16* raw = (const bf16*)(F.ws + WS_KV) + (size_t)kv * KV_TENS + (size_t)(b * 2 + g) * 8192 * 64;
        { v4u av[9];
#pragma unroll
          for (int q = 0; q < 9; ++q) { const int idx = F.tid + 512 * q, gl = idx >> 7, ch = idx & 127, gi = n0 + gl;
              av[q] = (v4u){0u, 0u, 0u, 0u}; if (idx < 33 * 128 && gi < 512) av[q] = *(const GAS v4u*)(raw + (size_t)gi * 1024 + ch * 8); }
#pragma unroll
          for (int q = 0; q < 9; ++q) { const int idx = F.tid + 512 * q, gl = idx >> 7, ch = idx & 127;
              if (idx < 33 * 128) *(LAS v4u*)(F.lds + AIMG + gl * GSTR + ch * 16) = av[q]; } }
        __syncthreads();
        const bf16* W1t = (const bf16*)(F.ws + (kv ? WS_CW1V : WS_CW1K));
        const bf16* bp = W1t + (size_t)(32 * w + r32) * 2048 + 8 * hi;
        const LAS unsigned char* ap = F.lds + AIMG + r32 * GSTR + hi * 16;
        f32x16 acc = {};
#pragma unroll 1
        for (int s0 = 0; s0 < 128; s0 += 32) {
            bf16x8 bfr[32];
#pragma unroll
            for (int j = 0; j < 32; ++j) bfr[j] = *(const GAS bf16x8*)(bp + 16 * (s0 + j));
            const LAS unsigned char* aq = ap + (s0 >= 64 ? GSTR + (s0 - 64) * 32 : s0 * 32);
#pragma unroll
            for (int j = 0; j < 32; ++j) { const bf16x8 af = *(const LAS bf16x8*)(aq + j * 32); acc = __builtin_amdgcn_mfma_f32_32x32x16_bf16(af, bfr[j], acc, 0, 0, 0); }
        }
        { const float* pp = (const float*)(F.ws + WS_PEP) + kv * 16 * 256 + 32 * w + r32; float pb = 0.f;
#pragma unroll
          for (int kc = 0; kc < 16; ++kc) pb += pp[kc * 256];
#pragma unroll
          for (int i = 0; i < 16; ++i) { const int row = (i & 3) + 8 * (i >> 2) + 4 * hi; const float h = gelu_tanh(acc[i] + pb);
              *(LAS unsigned short*)(F.lds + HIDO + row * HSTR + (32 * w + r32) * 2) = (unsigned short)f2bf(h); } }
        __syncthreads();
        if (w < 2) {
            const bf16* W2t = (const bf16*)(F.ws + (kv ? WS_CW2V : WS_CW2K));
            const bf16* bp2 = W2t + (size_t)(32 * w + r32) * 256 + 8 * hi;
            const LAS unsigned char* ap2 = F.lds + HIDO + r32 * HSTR + hi * 16;
            f32x16 a2 = {};
#pragma unroll
            for (int s = 0; s < 16; ++s) { const bf16x8 bf_ = *(const GAS bf16x8*)(bp2 + 16 * s); const bf16x8 af = *(const LAS bf16x8*)(ap2 + s * 32); a2 = __builtin_amdgcn_mfma_f32_32x32x16_bf16(af, bf_, a2, 0, 0, 0); }
#pragma unroll
            for (int i = 0; i < 16; ++i) { const int row = (i & 3) + 8 * (i >> 2) + 4 * hi; *(LAS float*)(F.lds + OUTO + (row * OSTR + 32 * w + r32) * 4) = a2[i]; }
        }
        __syncthreads();
        { const int row = F.tid >> 4, c4 = (F.tid & 15) * 4; const LAS float* op = (const LAS float*)(F.lds + OUTO) + row * OSTR + c4;
          float v0 = op[0], v1 = op[1], v2 = op[2], v3 = op[3];
          if (kv == 0) { float ss = (v0 * v0 + v1 * v1) + (v2 * v2 + v3 * v3); ss += __shfl_xor(ss, 1); ss += __shfl_xor(ss, 2); ss += __shfl_xor(ss, 4); ss += __shfl_xor(ss, 8);
              const float rs = 1.0f / sqrtf(ss * (1.0f / 64.0f) + 1e-6f); const f32x4 kn = *(const f32x4*)(F.in[4] + c4); v0 *= rs * kn[0]; v1 *= rs * kn[1]; v2 *= rs * kn[2]; v3 *= rs * kn[3]; }
          const int n = n0 + row; if (n >= NCMP) { v0 = v1 = v2 = v3 = 0.f; }
          bf16* dst = (bf16*)(F.ws + (kv ? WS_VC : WS_KC)) + ((size_t)(b * 2 + g) * 512 + n) * 64 + c4;
          *(GAS unsigned long long*)dst = (unsigned long long)pk2(v0, v1) | ((unsigned long long)pk2(v2, v3) << 32); }
        __syncthreads();
    }
}

namespace att {
constexpr int SLOT = 16384;
constexpr int L_RING = 0;
constexpr int L_IMP = 49152, IMP_STR = 132;
constexpr int L_OACC = 49152;
constexpr int L_BTAB = L_OACC + 65536;
constexpr int NBT = 960, BT0 = 895;
constexpr int L_WSF = L_BTAB + 4 * NBT * 4;
constexpr int L_SELM = L_WSF + 2048;
constexpr int L_UNI = L_SELM + 1024;
constexpr int L_END = L_UNI + 256;
static_assert(L_END <= LDSCTL_OFF, "attention LDS map");
constexpr float NEG_INF = -INFINITY;
constexpr float THR = 8.0f;

__device__ __forceinline__ int t5_bucket(int n) {
    if (n < 16) return n;
    int b = 16;
    b += (n >= 21); b += (n >= 27); b += (n >= 35); b += (n >= 46); b += (n >= 59); b += (n >= 77); b += (n >= 99); b += (n >= 128);
    b += (n >= 166); b += (n >= 216); b += (n >= 280); b += (n >= 363); b += (n >= 470); b += (n >= 609); b += (n >= 790);
    return b;
}
__device__ __forceinline__ s16x4 vtr(const LAS unsigned char* p) { typedef short v4i16_t __attribute__((ext_vector_type(4))); return __builtin_bit_cast(s16x4, __builtin_amdgcn_ds_read_tr16_b64_v4i16((LAS v4i16_t*)p)); }
__device__ __forceinline__ unsigned cvtpk(float lo, float hi) { typedef float f2 __attribute__((ext_vector_type(2))); typedef __bf16 b2 __attribute__((ext_vector_type(2))); f2 v = {lo, hi}; b2 b = __builtin_convertvector(v, b2); return __builtin_bit_cast(unsigned, b); }
__device__ __forceinline__ float xhalf_max(float a) { auto rr = __builtin_amdgcn_permlane32_swap(__float_as_uint(a), __float_as_uint(a), false, false); return fmaxf(__uint_as_float(rr[0]), __uint_as_float(rr[1])); }
__device__ __forceinline__ float xhalf_sum(float a) { auto rr = __builtin_amdgcn_permlane32_swap(__float_as_uint(a), __float_as_uint(a), false, false); return __uint_as_float(rr[0]) + __uint_as_float(rr[1]); }
__device__ __forceinline__ float quad_sum(float a) {
    a += __int_as_float(__builtin_amdgcn_update_dpp(0, __float_as_int(a), 0xB1, 0xf, 0xf, true));
    a += __int_as_float(__builtin_amdgcn_update_dpp(0, __float_as_int(a), 0x4E, 0xf, 0xf, true));
    return a;
}
__device__ __forceinline__ void glds16(const void* gsrc, unsigned lds_dst) { unsigned keep;
    asm volatile("s_mov_b32 %0, m0\n\ts_mov_b32 m0, %2\n\ts_nop 0\n\tglobal_load_lds_dwordx4 %1, off\n\ts_mov_b32 m0, %0" : "=&s"(keep) : "v"(gsrc), "s"(lds_dst) : "memory"); }
#define ATT_WAIT_BAR(N) asm volatile("s_waitcnt vmcnt(" #N ") lgkmcnt(0)\n\ts_barrier" ::: "memory")
__device__ __forceinline__ void tile_dma(const bf16* Kt, const bf16* Vt, bool hasV, unsigned slot_addr, int w, int lane) {
    glds16(Kt + lane * 64 + w * 8, (unsigned)__builtin_amdgcn_readfirstlane(slot_addr + w * 1024));
    if (hasV) glds16(Vt + (16 * (w & 3) + (lane >> 2)) * 64 + (w >> 2) * 32 + (lane & 3) * 8, (unsigned)__builtin_amdgcn_readfirstlane(slot_addr + 8192 + w * 1024));
}
__device__ __forceinline__ void qk_tile(const LAS unsigned char* buf, const bf16x8 (&qf)[4], float cv, f32x16& p0, f32x16& p1, int r32, int hi) {
    const LAS unsigned char* kp = buf + hi * 1024 + r32 * 16;
    f32x16 c;
#pragma unroll
    for (int i = 0; i < 16; ++i) c[i] = cv;
    bf16x8 k0[4], k1[4];
#pragma unroll
    for (int s = 0; s < 4; ++s) { k0[s] = *(const LAS bf16x8*)(kp + s * 2048); k1[s] = *(const LAS bf16x8*)(kp + s * 2048 + 512); }
    p0 = __builtin_amdgcn_mfma_f32_32x32x16_bf16(k0[0], qf[0], c, 0, 0, 0);
    p1 = __builtin_amdgcn_mfma_f32_32x32x16_bf16(k1[0], qf[0], c, 0, 0, 0);
#pragma unroll
    for (int s = 1; s < 4; ++s) {
        p0 = __builtin_amdgcn_mfma_f32_32x32x16_bf16(k0[s], qf[s], p0, 0, 0, 0);
        p1 = __builtin_amdgcn_mfma_f32_32x32x16_bf16(k1[s], qf[s], p1, 0, 0, 0);
    }
}
template <int KSTEP>
__device__ __forceinline__ void bias_mask(f32x16& p0, f32x16& p1, const LAS float* bt, int dbase, int hi) {
#pragma unroll
    for (int i = 0; i < 16; ++i) {
        const int kl = (i & 3) + 8 * (i >> 2) + 4 * hi;
        const int d0 = dbase - KSTEP * kl, d1 = d0 - KSTEP * 32;
        const int i0 = BT0 - min(max(d0, 0), BT0), i1 = BT0 - min(max(d1, 0), BT0);
        const float b0 = bt[i0], b1 = bt[i1];
        p0[i] = (d0 >= 0) ? p0[i] + b0 : NEG_INF;
        p1[i] = (d1 >= 0) ? p1[i] + b1 : NEG_INF;
        if ((i & 3) == 3) asm volatile("" ::: "memory");
    }
}
template <int MODE>
__device__ __forceinline__ void bias_near(f32x16& p0, f32x16& p1, const LAS float* tb, int dbase, int hi) {
#pragma unroll
    for (int i = 0; i < 16; ++i) {
        const int ko = (i & 3) + 8 * (i >> 2);
        const float b0 = tb[ko], b1 = tb[ko + 32];
        const int d0 = dbase - ko - 4 * hi, d1 = d0 - 32;
        if (MODE == 0) { p0[i] += b0; p1[i] += b1; }
        else if (MODE == 1) { p0[i] = d0 >= 0 ? p0[i] + b0 : NEG_INF; p1[i] = d1 >= 0 ? p1[i] + b1 : NEG_INF; }
        else { p0[i] = d0 < 512 ? p0[i] + b0 : NEG_INF; p1[i] = d1 < 512 ? p1[i] + b1 : NEG_INF; }
        if ((i & 7) == 7) asm volatile("" ::: "memory");
    }
}
__device__ __forceinline__ void bias_near_mode(f32x16& p0, f32x16& p1, const LAS float* tb, int dbase, int hi, int mode) {
    if (mode == 0) bias_near<0>(p0, p1, tb, dbase, hi); else if (mode == 1) bias_near<1>(p0, p1, tb, dbase, hi); else bias_near<2>(p0, p1, tb, dbase, hi);
}
__device__ __forceinline__ float rowmax32(const f32x16& p0, const f32x16& p1) {
    float a = fmaxf(fmaxf(p0[0], p1[0]), p0[1]), b = fmaxf(fmaxf(p1[1], p0[2]), p1[2]);
#pragma unroll
    for (int i = 3; i < 15; i += 2) { a = fmaxf(fmaxf(a, p0[i]), p1[i]); b = fmaxf(fmaxf(b, p0[i + 1]), p1[i + 1]); }
    a = fmaxf(fmaxf(a, p0[15]), p1[15]);
    return xhalf_max(fmaxf(a, b));
}
__device__ __forceinline__ void pv_tile(const LAS unsigned char* buf, const f32x16& p0, const f32x16& p1, f32x16 (&o)[2], int lane, int hi) {
    const LAS unsigned char* vp = buf + 8192 + ((lane >> 4) & 1) * 32 + (lane & 3) * 8 + (4 * hi + ((lane & 15) >> 2)) * 64;
    bf16x8 pa[4];
#pragma unroll
    for (int s = 0; s < 2; ++s) {
        v4u a, c;
        a.x = cvtpk(p0[8 * s + 0], p0[8 * s + 1]); a.y = cvtpk(p0[8 * s + 2], p0[8 * s + 3]); a.z = cvtpk(p0[8 * s + 4], p0[8 * s + 5]); a.w = cvtpk(p0[8 * s + 6], p0[8 * s + 7]);
        c.x = cvtpk(p1[8 * s + 0], p1[8 * s + 1]); c.y = cvtpk(p1[8 * s + 2], p1[8 * s + 3]); c.z = cvtpk(p1[8 * s + 4], p1[8 * s + 5]); c.w = cvtpk(p1[8 * s + 6], p1[8 * s + 7]);
        pa[s] = __builtin_bit_cast(bf16x8, a); pa[2 + s] = __builtin_bit_cast(bf16x8, c);
    }
#pragma unroll
    for (int ks = 0; ks < 4; ++ks)
#pragma unroll
        for (int d0 = 0; d0 < 2; ++d0) {
            const s16x4 lo = vtr(vp + d0 * 4096 + ks * 1024), hh = vtr(vp + d0 * 4096 + ks * 1024 + 512);
            const bf16x8 vf = (bf16x8){lo[0], lo[1], lo[2], lo[3], hh[0], hh[1], hh[2], hh[3]};
            o[d0] = __builtin_amdgcn_mfma_f32_32x32x16_bf16(pa[ks], vf, o[d0], 0, 0, 0);
        }
}
__device__ __forceinline__ void row_to_regs(LAS float* wsf, float v, float (&f)[16], int r32, int hi) {
    if (hi == 0) wsf[r32] = v;
#pragma unroll
    for (int u = 0; u < 4; ++u) { const f32x4 t = *(const LAS f32x4*)(wsf + 8 * u + 4 * hi); f[4 * u] = t[0]; f[4 * u + 1] = t[1]; f[4 * u + 2] = t[2]; f[4 * u + 3] = t[3]; }
}
struct SmState { float m, l; bool have; };
__device__ __forceinline__ void sm_init(SmState& st) { st.m = 0.f; st.l = 0.f; st.have = false; }
template <bool HASO>
__device__ __forceinline__ void sm_rebase(SmState& st, f32x16& p0, f32x16& p1, f32x16 (&o)[2], LAS float* wsf, int r32, int hi) {
    const float mx = rowmax32(p0, p1);
    const bool fin = mx > NEG_INF;
    const bool trig = st.have ? (mx > THR) : fin;
    if (__any(trig)) {
        const float dl = st.have ? fmaxf(mx, 0.f) : (fin ? mx : 0.f);
        const float alpha = st.have ? __builtin_amdgcn_exp2f(-dl) : 1.0f;
        st.m += dl; st.l *= alpha; st.have = st.have || fin;
#pragma unroll
        for (int i = 0; i < 16; ++i) { p0[i] -= dl; p1[i] -= dl; }
        if (HASO) { float f[16]; row_to_regs(wsf, alpha, f, r32, hi);
#pragma unroll
            for (int i = 0; i < 16; ++i) { o[0][i] *= f[i]; o[1][i] *= f[i]; } }
    }
}
__device__ __forceinline__ float exp_sum(f32x16& p0, f32x16& p1) {
    float s0 = 0.f, s1 = 0.f;
#pragma unroll
    for (int i = 0; i < 16; ++i) { p0[i] = __builtin_amdgcn_exp2f(p0[i]); p1[i] = __builtin_amdgcn_exp2f(p1[i]); s0 += p0[i]; s1 += p1[i]; }
    return s0 + s1;
}

__device__ __forceinline__ void build_btab(Frame& F, int g) {
    LAS float* btab = (LAS float*)(F.lds + L_BTAB); const float* rb = F.in[11];
    __syncthreads();
    for (int i = F.tid; i < 4 * NBT; i += 512) { const int rr = i / NBT, d = BT0 - (i - rr * NBT); btab[i] = rb[t5_bucket(d > 0 ? d : 0) * 8 + 4 * g + rr] * LOG2E; }
    __syncthreads();
}
__device__ __forceinline__ void attn_item(Frame& F, int b, int g, int qb) {
    const int tid = F.tid, lane = F.lane, w = F.wave, r32 = lane & 31, hi = lane >> 5, qi = r32 >> 2, r = r32 & 3;
    const int t0 = qb * 64, tl = 8 * w + qi, tpos = t0 + tl;
    ATP(F, 0);
    LAS unsigned char* lds = F.lds;
    const unsigned lds0 = (unsigned)(uintptr_t)lds;
    LAS float* imp = (LAS float*)(lds + L_IMP);
    LAS float* btab = (LAS float*)(lds + L_BTAB);
    LAS float* wsf = (LAS float*)(lds + L_WSF) + w * 64;
    LAS unsigned* selm = (LAS unsigned*)(lds + L_SELM);
    LAS unsigned* uni = (LAS unsigned*)(lds + L_UNI);
    const bf16* KVb = (const bf16*)(F.ws + WS_KV);
    const size_t bgoff = (size_t)(b * 2 + g) * 8192 * 64;
    const bf16* ksb = KVb + 2 * KV_TENS + bgoff; const bf16* vsb = KVb + 3 * KV_TENS + bgoff;
    const bf16* kwb = KVb + 4 * KV_TENS + bgoff; const bf16* vwb = KVb + 5 * KV_TENS + bgoff;
    const bf16* kcb = (const bf16*)(F.ws + WS_KC) + (size_t)(b * 2 + g) * 512 * 64;
    const bf16* vcb = (const bf16*)(F.ws + WS_VC) + (size_t)(b * 2 + g) * 512 * 64;
    for (int i = lane; i < 8 * IMP_STR; i += 64) imp[8 * w * IMP_STR + i] = 0.f;
    if (tid < 64) uni[tid] = 0u;
    bf16x8 qf[4];
    { const bf16* Qp = (const bf16*)(F.ws + WS_Q) + ((size_t)(b * 8192 + tpos) * 512 + (4 * g + r) * 64 + 8 * hi);
#pragma unroll
      for (int s = 0; s < 4; ++s) qf[s] = *(const GAS bf16x8*)(Qp + 16 * s); }
    float gate[3];
    { const float* gp = (const float*)(F.ws + WS_G) + (size_t)(b * 8192 + tpos) * 32 + (4 * g + r) * 3; gate[0] = gp[0]; gate[1] = gp[1]; gate[2] = gp[2]; }
    const float bfar = F.in[11][31 * 8 + 4 * g + r] * LOG2E;
    const LAS float* bt = btab + r * NBT;
    LAS float* oaccp = (LAS float*)(lds + L_OACC) + w * 2048 + lane;
    asm volatile("s_waitcnt vmcnt(0)" ::: "memory");
    __syncthreads();

    ATP(F, 1);
    const int nct = (4 * qb + 3 + 63) >> 6;
    const int dcb = tpos - 31;
    const int ncfar = (t0 - 1829) >= 0 ? min(nct, (t0 - 1829) / 1024 + 1) : 0;
    SmState sc; sm_init(sc);
    f32x16 oc[2]; oc[0] = f32x16{}; oc[1] = f32x16{};
    tile_dma(kcb, vcb, false, lds0 + L_RING, w, lane);
    if (nct > 1) { tile_dma(kcb + 4096, vcb, false, lds0 + L_RING + SLOT, w, lane); ATT_WAIT_BAR(1); } else { ATT_WAIT_BAR(0); }
    for (int c = 0, sl = 0; c < nct; ++c) {
        const int sl2 = sl >= SLOT ? sl - SLOT : sl + 2 * SLOT;
        if (c + 2 < nct) tile_dma(kcb + (size_t)(c + 2) * 4096, vcb, false, lds0 + L_RING + sl2, w, lane);
        f32x16 p0, p1; qk_tile(lds + L_RING + sl, qf, c < ncfar ? bfar - sc.m : -sc.m, p0, p1, r32, hi);
        if (c >= ncfar) bias_mask<16>(p0, p1, bt, dcb - 1024 * c, hi);
        sm_rebase<false>(sc, p0, p1, oc, wsf, r32, hi);
        sc.l += exp_sum(p0, p1);
        if (c + 2 < nct) { ATT_WAIT_BAR(1); } else { ATT_WAIT_BAR(0); }
        sl = sl == 2 * SLOT ? 0 : sl + SLOT;
    }
    ATP(F, 2);
    const float lc = xhalf_sum(sc.l);
    const float ilc = lc > 0.f ? 1.0f / lc : 0.f;
    {
        tile_dma(kcb, vcb, true, lds0 + L_RING, w, lane);
        if (nct > 1) { tile_dma(kcb + 4096, vcb + 4096, true, lds0 + L_RING + SLOT, w, lane); ATT_WAIT_BAR(2); } else { ATT_WAIT_BAR(0); }
        for (int c = 0, sl = 0; c < nct; ++c) {
            const int sl2 = sl >= SLOT ? sl - SLOT : sl + 2 * SLOT;
            if (c + 2 < nct) tile_dma(kcb + (size_t)(c + 2) * 4096, vcb + (size_t)(c + 2) * 4096, true, lds0 + L_RING + sl2, w, lane);
            f32x16 p0, p1; qk_tile(lds + L_RING + sl, qf, c < ncfar ? bfar - sc.m : -sc.m, p0, p1, r32, hi);
            if (c >= ncfar) bias_mask<16>(p0, p1, bt, dcb - 1024 * c, hi);
#pragma unroll
            for (int i = 0; i < 16; ++i) { p0[i] = __builtin_amdgcn_exp2f(p0[i]) * ilc; p1[i] = __builtin_amdgcn_exp2f(p1[i]) * ilc; }
#pragma unroll
            for (int a = 0; a < 2; ++a)
#pragma unroll
                for (int u = 0; u < 4; ++u) {
                    const float x0 = a ? p1[4 * u] : p0[4 * u], x1 = a ? p1[4 * u + 1] : p0[4 * u + 1], x2 = a ? p1[4 * u + 2] : p0[4 * u + 2], x3 = a ? p1[4 * u + 3] : p0[4 * u + 3];
                    const float mainv = quad_sum((x0 + x1) + (x2 + 0.5f * x3)), spill = quad_sum(0.5f * x3);
                    const int j = 16 * c + 8 * a + 2 * u + hi;
                    if (r == 0) { (void)__hip_atomic_fetch_add(&imp[(8 * w + qi) * IMP_STR + j], mainv, __ATOMIC_RELAXED, __HIP_MEMORY_SCOPE_WORKGROUP); if (j + 1 < 128) (void)__hip_atomic_fetch_add(&imp[(8 * w + qi) * IMP_STR + j + 1], spill, __ATOMIC_RELAXED, __HIP_MEMORY_SCOPE_WORKGROUP); }
                }
            pv_tile(lds + L_RING + sl, p0, p1, oc, lane, hi);
            if (c + 2 < nct) { ATT_WAIT_BAR(2); } else { ATT_WAIT_BAR(0); }
            sl = sl == 2 * SLOT ? 0 : sl + SLOT;
        }
    }
    ATP(F, 3);
    for (int pass = 0; pass < 2; ++pass) {
        const int q = 8 * w + 4 * pass + (lane >> 4), t = lane & 15;
        const f32x4 va = *(const LAS f32x4*)(imp + q * IMP_STR + 8 * t), vb = *(const LAS f32x4*)(imp + q * IMP_STR + 8 * t + 4);
        unsigned key[8];
#pragma unroll
        for (int e = 0; e < 8; ++e) { const int j = 8 * t + e; const float v = e < 4 ? va[e] : vb[e - 4];
            const bool val = j <= qb, fo = (j == 0) || (j == qb) || (j == qb - 1);
            key[e] = !val ? 0u : (fo ? 0x7f000000u : __float_as_uint(v) + 1u); }
        unsigned Tt = 0u;
        for (int bit = 30; bit >= 0; --bit) {
            const unsigned cand = Tt | (1u << bit); int cnt = 0;
#pragma unroll
            for (int e = 0; e < 8; ++e) cnt += (key[e] >= cand) ? 1 : 0;
            cnt += __builtin_amdgcn_update_dpp(0, cnt, 0x128, 0xf, 0xf, true);
            cnt += __builtin_amdgcn_update_dpp(0, cnt, 0x124, 0xf, 0xf, true);
            cnt += __builtin_amdgcn_update_dpp(0, cnt, 0x122, 0xf, 0xf, true);
            cnt += __builtin_amdgcn_update_dpp(0, cnt, 0x121, 0xf, 0xf, true);
            if (cnt >= 16) Tt = cand;
        }
        int ngt = 0, neq = 0;
#pragma unroll
        for (int e = 0; e < 8; ++e) { ngt += (key[e] > Tt) ? 1 : 0; neq += (key[e] == Tt) ? 1 : 0; }
        ngt += __builtin_amdgcn_update_dpp(0, ngt, 0x128, 0xf, 0xf, true); ngt += __builtin_amdgcn_update_dpp(0, ngt, 0x124, 0xf, 0xf, true);
        ngt += __builtin_amdgcn_update_dpp(0, ngt, 0x122, 0xf, 0xf, true); ngt += __builtin_amdgcn_update_dpp(0, ngt, 0x121, 0xf, 0xf, true);
        const int need = 16 - ngt;
        int inc = neq;
        inc += __builtin_amdgcn_update_dpp(0, inc, 0x111, 0xf, 0xf, true);
        inc += __builtin_amdgcn_update_dpp(0, inc, 0x112, 0xf, 0xf, true);
        inc += __builtin_amdgcn_update_dpp(0, inc, 0x114, 0xf, 0xf, true);
        inc += __builtin_amdgcn_update_dpp(0, inc, 0x118, 0xf, 0xf, true);
        int pre = inc - neq; unsigned bits = 0u;
#pragma unroll
        for (int e = 0; e < 8; ++e) { const bool eq = key[e] == Tt; const bool sel = (key[e] != 0u) && ((key[e] > Tt) || (eq && pre < need)); pre += eq ? 1 : 0; bits |= sel ? (1u << e) : 0u; }
        unsigned word = bits << ((t & 3) * 8);
        word |= (unsigned)__builtin_amdgcn_update_dpp(0, (int)word, 0xB1, 0xf, 0xf, true);
        word |= (unsigned)__builtin_amdgcn_update_dpp(0, (int)word, 0x4E, 0xf, 0xf, true);
        if ((t & 3) == 0) { selm[q * 4 + (t >> 2)] = word; (void)__hip_atomic_fetch_or(&uni[w * 4 + (t >> 2)], word, __ATOMIC_RELAXED, __HIP_MEMORY_SCOPE_WORKGROUP); (void)__hip_atomic_fetch_or(&uni[32 + (t >> 2)], word, __ATOMIC_RELAXED, __HIP_MEMORY_SCOPE_WORKGROUP); }
    }
    __syncthreads();
    { float f[16]; row_to_regs(wsf, gate[0], f, r32, hi);
#pragma unroll
      for (int i = 0; i < 16; ++i) { oaccp[i * 64] = oc[0][i] * f[i]; oaccp[(16 + i) * 64] = oc[1][i] * f[i]; } }
    unsigned mym[4], bu[4], wuv[4];
#pragma unroll
    for (int k = 0; k < 4; ++k) { mym[k] = selm[(8 * w + qi) * 4 + k]; bu[k] = __builtin_amdgcn_readfirstlane(uni[32 + k]); wuv[k] = __builtin_amdgcn_readfirstlane(uni[w * 4 + k]); }
    ATP(F, 4);
#ifndef REP_SEL
#define REP_SEL 1
#endif
#ifndef REP_WIN
#define REP_WIN 1
#endif
#ifndef REP_CMP
#define REP_CMP 1
#endif
    for (int rep_ = 0; rep_ < REP_SEL; ++rep_) {
        f32x16 o[2]; o[0] = f32x16{}; o[1] = f32x16{}; SmState ss; sm_init(ss);
#define NEXT_SEL(from, dst) do { dst = -1; for (int j_ = (from); j_ <= qb; ++j_) if ((bu[j_ >> 5] >> (j_ & 31)) & 1u) { dst = j_; break; } } while (0)
        int j0, j1, j2;
        NEXT_SEL(0, j0); j1 = -1; j2 = -1; if (j0 >= 0) NEXT_SEL(j0 + 1, j1);
        if (j0 >= 0) tile_dma(ksb + (size_t)j0 * 4096, vsb + (size_t)j0 * 4096, true, lds0 + L_RING, w, lane);
        if (j1 >= 0) { tile_dma(ksb + (size_t)j1 * 4096, vsb + (size_t)j1 * 4096, true, lds0 + L_RING + SLOT, w, lane); ATT_WAIT_BAR(2); } else { ATT_WAIT_BAR(0); }
        int sl = 0;
        while (j0 >= 0) {
            const int sl2 = sl >= SLOT ? sl - SLOT : sl + 2 * SLOT;
            j2 = -1; if (j1 >= 0) NEXT_SEL(j1 + 1, j2);
            if (j2 >= 0) tile_dma(ksb + (size_t)j2 * 4096, vsb + (size_t)j2 * 4096, true, lds0 + L_RING + sl2, w, lane);
            if ((wuv[j0 >> 5] >> (j0 & 31)) & 1u) {
                const bool mine = (mym[j0 >> 5] >> (j0 & 31)) & 1u;
                const bool nearj = qb - j0 < 14;
                f32x16 p0, p1; qk_tile(lds + L_RING + sl, qf, mine ? (nearj ? -ss.m - bfar : -ss.m) : NEG_INF, p0, p1, r32, hi);
                if (nearj) bias_near_mode(p0, p1, bt + (BT0 - (tpos - 64 * j0)) + 4 * hi, tpos - 64 * j0, hi, j0 == qb ? 1 : 0);
                sm_rebase<true>(ss, p0, p1, o, wsf, r32, hi);
                ss.l += exp_sum(p0, p1);
                pv_tile(lds + L_RING + sl, p0, p1, o, lane, hi);
            }
            if (j2 >= 0) { ATT_WAIT_BAR(2); } else { ATT_WAIT_BAR(0); }
            sl = sl == 2 * SLOT ? 0 : sl + SLOT;
            j0 = j1; j1 = j2;
        }
#undef NEXT_SEL
        const float ls = xhalf_sum(ss.l);
        float f[16]; row_to_regs(wsf, ls > 0.f ? gate[1] / (ls * REP_SEL) : 0.f, f, r32, hi);
#pragma unroll
        for (int i = 0; i < 16; ++i) { oaccp[i * 64] += o[0][i] * f[i]; oaccp[(16 + i) * 64] += o[1][i] * f[i]; }
    }
    ATP(F, 5);
    {
        f32x16 o[2]; o[0] = f32x16{}; o[1] = f32x16{}; SmState sw; sm_init(sw);
        const int jf = qb >= 8 ? qb - 8 : 0;
        tile_dma(kwb + (size_t)jf * 4096, vwb + (size_t)jf * 4096, true, lds0 + L_RING, w, lane);
        if (jf + 1 <= qb) { tile_dma(kwb + (size_t)(jf + 1) * 4096, vwb + (size_t)(jf + 1) * 4096, true, lds0 + L_RING + SLOT, w, lane); ATT_WAIT_BAR(2); } else { ATT_WAIT_BAR(0); }
        for (int j = jf, sl = 0; j <= qb; ++j) {
            const int sl2 = sl >= SLOT ? sl - SLOT : sl + 2 * SLOT;
            if (j + 2 <= qb) tile_dma(kwb + (size_t)(j + 2) * 4096, vwb + (size_t)(j + 2) * 4096, true, lds0 + L_RING + sl2, w, lane);
            f32x16 p0, p1; qk_tile(lds + L_RING + sl, qf, -sw.m, p0, p1, r32, hi);
            bias_near_mode(p0, p1, bt + (BT0 - (tpos - 64 * j)) + 4 * hi, tpos - 64 * j, hi, j == qb ? 1 : (j == qb - 8 ? 2 : 0));
            sm_rebase<true>(sw, p0, p1, o, wsf, r32, hi);
            sw.l += exp_sum(p0, p1);
            pv_tile(lds + L_RING + sl, p0, p1, o, lane, hi);
            if (j + 2 <= qb) { ATT_WAIT_BAR(2); } else { ATT_WAIT_BAR(0); }
            sl = sl == 2 * SLOT ? 0 : sl + SLOT;
        }
        const float lw = xhalf_sum(sw.l);
        float f[16]; row_to_regs(wsf, lw > 0.f ? gate[2] / lw : 0.f, f, r32, hi);
#pragma unroll
        for (int i = 0; i < 16; ++i) { o[0][i] = oaccp[i * 64] + o[0][i] * f[i]; o[1][i] = oaccp[(16 + i) * 64] + o[1][i] * f[i]; }
        asm volatile("" ::: "memory");
        LAS unsigned short* stg = (LAS unsigned short*)(lds + L_OACC + w * 8192);
#pragma unroll
        for (int i = 0; i < 16; ++i) { const int orow = (i & 3) + 8 * (i >> 2) + 4 * hi;
            stg[orow * 64 + r32] = (unsigned short)f2bf(o[0][i]); stg[orow * 64 + 32 + r32] = (unsigned short)f2bf(o[1][i]); }
        LDS_WAIT();
        bf16* MIX = (bf16*)(F.ws + WS_MIX);
#pragma unroll
        for (int i = 0; i < 4; ++i) { const int row = i * 8 + (lane >> 3), ch = lane & 7; const v4u v = *(const LAS v4u*)(stg + row * 64 + ch * 8);
            *(GAS v4u*)(MIX + (size_t)(b * 8192 + t0 + 8 * w + (row >> 2)) * 1024 + (4 * g + (row & 3)) * 64 + ch * 8) = v; }
    }
    __syncthreads();
    ATP(F, 6);
}
}

__device__ __forceinline__ void p4_phase(Frame& F) {
    {
        const bf16* Z = (const bf16*)(F.ws + WS_Z); const bf16* BG = (const bf16*)(F.ws + WS_BG); bf16* MIX = (bf16*)(F.ws + WS_MIX);
        const float* cw = F.in[12];
        const int ch = F.tid & 63, rsub = F.tid >> 6;
        f32x4 w0a = *(const f32x4*)(cw + 8 * ch), w0b = *(const f32x4*)(cw + 8 * ch + 4), w1a = *(const f32x4*)(cw + 512 + 8 * ch), w1b = *(const f32x4*)(cw + 512 + 8 * ch + 4), w2a = *(const f32x4*)(cw + 1024 + 8 * ch), w2b = *(const f32x4*)(cw + 1024 + 8 * ch + 4);
        for (int rb = blockIdx.x; rb < M / 8; rb += F.G) {
            const int row = 8 * rb + rsub, t = row & 8191;
            const v4u z2 = *(const GAS v4u*)(Z + (size_t)row * 512 + 8 * ch);
            v4u z1 = (v4u){0u, 0u, 0u, 0u}, z0 = (v4u){0u, 0u, 0u, 0u};
            if (t >= 1) z1 = *(const GAS v4u*)(Z + (size_t)(row - 1) * 512 + 8 * ch);
            if (t >= 2) z0 = *(const GAS v4u*)(Z + (size_t)(row - 2) * 512 + 8 * ch);
            const v4u bg = *(const GAS v4u*)(BG + (size_t)row * 512 + 8 * ch);
            float o[8];
#define CV(k, comp, sh, wa, wi) o[k] = bf2f((unsigned short)((bg.comp >> sh) & 0xffff)) * (w0##wa[wi] * bf2f((unsigned short)((z0.comp >> sh) & 0xffff)) + w1##wa[wi] * bf2f((unsigned short)((z1.comp >> sh) & 0xffff)) + w2##wa[wi] * bf2f((unsigned short)((z2.comp >> sh) & 0xffff)))
            CV(0, x, 0, a, 0); CV(1, x, 16, a, 1); CV(2, y, 0, a, 2); CV(3, y, 16, a, 3); CV(4, z, 0, b, 0); CV(5, z, 16, b, 1); CV(6, w, 0, b, 2); CV(7, w, 16, b, 3);
#undef CV
            v4u ov; ov.x = pk2(o[0], o[1]); ov.y = pk2(o[2], o[3]); ov.z = pk2(o[4], o[5]); ov.w = pk2(o[6], o[7]);
            *(GAS v4u*)(MIX + (size_t)row * 1024 + 512 + 8 * ch) = ov;
        }
    }
    asm volatile("s_waitcnt vmcnt(0)" ::: "memory");
    if (F.G == 256) {
        const int bg = blockIdx.x & 7, s_ = blockIdx.x >> 3;
        att::build_btab(F, bg & 1);
        att::attn_item(F, bg >> 1, bg & 1, 127 - s_);
        att::attn_item(F, bg >> 1, bg & 1, 64 + s_);
        att::attn_item(F, bg >> 1, bg & 1, 63 - s_);
        att::attn_item(F, bg >> 1, bg & 1, s_);
    } else {
        for (int rd = 0; rd * F.G < 1024; ++rd) {
            const int pos = (rd & 1) ? (F.G - 1 - (int)blockIdx.x) : (int)blockIdx.x;
            const int k = rd * F.G + pos; if (k >= 1024) continue;
            const int qb = 127 - (k >> 3), bg = k & 7;
            att::build_btab(F, bg & 1);
            att::attn_item(F, bg >> 1, bg & 1, qb);
        }
    }
}

struct Args { const float* in[20]; float* out; unsigned char* ws; int ph_lo, ph_hi; };
__global__ void __launch_bounds__(NWAVES * 64, 2) mk_fwd(Args args) {
    extern __shared__ __attribute__((aligned(16))) unsigned char lds[];
    Frame F;
    F.lds = (LAS unsigned char*)lds;
    F.MISC = (volatile LAS unsigned*)(F.lds + MISC_OFF);
    F.tid = threadIdx.x; F.lane = F.tid & 63; F.wave = __builtin_amdgcn_readfirstlane(F.tid >> 6);
    F.G = gridDim.x; { const int bx = blockIdx.x; F.vcu = (F.G % 8 == 0) ? (bx % 8) * (F.G / 8) + bx / 8 : bx; }
    F.tp_t0 = 0; F.tp_acc = 0; F.ws = args.ws; F.out = args.out; F.ctl = (gu32*)(args.ws + WS_CTL);
#pragma unroll
    for (int i = 0; i < 20; ++i) F.in[i] = args.in[i];
    for (int u = F.tid; u < (LDS_BYTES - LDSCTL_OFF) / 4; u += NWAVES * 64) ((LAS unsigned*)(F.lds + LDSCTL_OFF))[u] = 0u;
    __syncthreads();
    const int lo = args.ph_lo, hi = args.ph_hi;
    const bool one = (hi - lo) > 1;
    XcdBarrier bar; bar.bar = (unsigned*)(F.ctl + CW_BAR); bar.x = 0; bar.st = nullptr;
    if (one) bar = xcd_barrier_post((unsigned*)(F.ctl + CW_BAR), F.MISC + 8);
#ifdef ONLY_PHASE
#define IN(k) ((k) == ONLY_PHASE && lo <= (k) && (k) < hi)
#else
#define IN(k) (lo <= (k) && (k) < hi)
#endif
#ifndef REP_MASK
#define REP_MASK 0
#endif
#define REPS(k) for (int rep_ = 0; rep_ < 1 + ((REP_MASK >> (k)) & 1); ++rep_)
#define SEAM(k) do { if (IN(k) && IN((k) + 1)) xcd_barrier(bar); } while (0)
    unsigned char* ws = args.ws;
#ifdef PROBE_PHASE
    unsigned long long tp0_ = 0, tp1_ = 0;
#define TPS(k) do { if ((k) == PROBE_PHASE) tp0_ = __builtin_amdgcn_s_memrealtime(); if ((k) == PROBE_END) tp1_ = __builtin_amdgcn_s_memrealtime(); } while (0)
#else
#define TPS(k) do {} while (0)
#endif
    TPS(0);
    if (IN(0)) { REPS(0) p0_phase(F); SEAM(0); }
    TPS(1);
    if (IN(1)) { REPS(1) p1_phase(F); SEAM(1); }
#ifdef XTRA_BAR
    for (int xb_ = 0; xb_ < XTRA_BAR; ++xb_) xcd_barrier(bar);
#endif
    TPS(2);
    if (IN(2)) {
        pg8::Gemm g{(const pg8::bf16_t*)(ws + WS_H), (const pg8::bf16_t*)(ws + WS_WIN), M, NIN, D}; pg8::StaticOrder S; S.init(M, NIN, F.G, (int)blockIdx.x);
        pg8::EpiInProj E{(pg8::bf16_t*)(ws + WS_Q), (pg8::bf16_t*)(ws + WS_KV), (pg8::bf16_t*)(ws + WS_Z), (pg8::bf16_t*)(ws + WS_BG), (float*)(ws + WS_G), F.in[3], F.in[4]};
        pg8::gemm_phase<pg8::EpiInProj, pg8::StaticOrder, true, true>(F.lds, g, S, E);
#ifdef DUP_P2
        pg8::gemm_phase<pg8::EpiInProj, pg8::StaticOrder, true, true>(F.lds, g, S, E);
#endif
        SEAM(2);
    }
    TPS(3);
    if (IN(3)) { REPS(3) p3_phase(F); SEAM(3); }
    TPS(4);
    if (IN(4)) { REPS(4) p4_phase(F); SEAM(4); }
    TPS(5);
    if (IN(5)) {
        pg8::Gemm g{(const pg8::bf16_t*)(ws + WS_MIX), (const pg8::bf16_t*)(ws + WS_WOUT), M, D, D}; pg8::StaticOrder S; S.init(M, D, F.G, (int)blockIdx.x);
        pg8::EpiOutProj E{F.in[0], (pg8::bf16_t*)(ws + WS_X1B), (pg8::bf16_t*)(ws + WS_A2), (float*)(ws + WS_RSS), (const float*)(ws + WS_MOD), F.in[15]};
        REPS(5) pg8::gemm_phase<pg8::EpiOutProj, pg8::StaticOrder, true, true>(F.lds, g, S, E);
        SEAM(5);
    }
    TPS(6);
    if (IN(6)) {
        pg8::Gemm g{(const pg8::bf16_t*)(ws + WS_A2), (const pg8::bf16_t*)(ws + WS_W1), M, FF, D}; pg8::StaticOrder S; S.init(M, FF, F.G, (int)blockIdx.x);
        pg8::EpiFF1 E{(pg8::bf16_t*)(ws + WS_HID), (const float*)(ws + WS_RSS), (const float*)(ws + WS_BFF1)};
        REPS(6) pg8::gemm_phase<pg8::EpiFF1, pg8::StaticOrder, true, true>(F.lds, g, S, E);
        SEAM(6);
    }
    TPS(7);
    if (IN(7)) {
        pg8::Gemm g{(const pg8::bf16_t*)(ws + WS_HID), (const pg8::bf16_t*)(ws + WS_W2), M, D, FF}; pg8::StaticOrder S; S.init(M, D, F.G, (int)blockIdx.x);
#ifdef DUP_P7
        { pg8::EpiFF2 E0{(const pg8::bf16_t*)(ws + WS_X1B), (const float*)(ws + WS_MOD), (float*)(ws + (size_t)100 * MiB)};
          pg8::gemm_phase<pg8::EpiFF2, pg8::StaticOrder, true, true>(F.lds, g, S, E0); }
#endif
        pg8::EpiFF2 E{(const pg8::bf16_t*)(ws + WS_X1B), (const float*)(ws + WS_MOD), F.out};
        pg8::gemm_phase<pg8::EpiFF2, pg8::StaticOrder, true, true>(F.lds, g, S, E);
    }
    TPS(8);
#ifdef ATP_A
    if (blockIdx.x == 0 && F.tid == 0) { const unsigned long long until = __builtin_amdgcn_s_memrealtime() + (unsigned long long)ATP_MULT * F.tp_acc;
        while (__builtin_amdgcn_s_memrealtime() < until) __builtin_amdgcn_s_sleep(8); }
#endif
#ifdef PROBE_PHASE
    if (blockIdx.x == 0 && F.tid == 0) { const unsigned long long until = __builtin_amdgcn_s_memrealtime() + (unsigned long long)PROBE_MULT * (tp1_ - tp0_);
        while (__builtin_amdgcn_s_memrealtime() < until) __builtin_amdgcn_s_sleep(8); }
#endif
#undef IN
#undef SEAM
}

extern "C" void kernel_launch(void* const* d_in, const int* in_sizes, int n_in, void* d_out, int out_size, void* d_ws, size_t ws_size, hipStream_t stream) {
    static int grid = 0;
    if (grid == 0) {
        if (n_in != 20 || in_sizes[0] != M * D || out_size != M * D || ws_size < WS_END) { fprintf(stderr, "kernel_launch: unexpected problem shape (n_in %d, in0 %d, out %d, ws %zu)\n", n_in, n_in > 0 ? in_sizes[0] : -1, out_size, ws_size); grid = -1; return; }
        int dev = 0, cus = 0, per_cu = 0;
        if (hipGetDevice(&dev) != hipSuccess || hipDeviceGetAttribute(&cus, hipDeviceAttributeMultiprocessorCount, dev) != hipSuccess) { grid = -1; return; }
        if (hipFuncSetAttribute((const void*)mk_fwd, hipFuncAttributeMaxDynamicSharedMemorySize, LDS_BYTES) != hipSuccess) { fprintf(stderr, "kernel_launch: hipFuncSetAttribute failed\n"); grid = -1; return; }
        if (hipOccupancyMaxActiveBlocksPerMultiprocessor(&per_cu, (const void*)mk_fwd, NWAVES * 64, LDS_BYTES) != hipSuccess || per_cu < 1) { fprintf(stderr, "kernel_launch: occupancy query says %d blocks per CU\n", per_cu); (void)hipGetLastError(); per_cu = 1; }
        grid = cus * 1;
        if (per_cu < 1) grid = -1;
    }
    if (grid < 0) return;
    (void)hipMemsetAsync((char*)d_ws + WS_CTL, 0, CTL_ZERO_BYTES, stream);
    Args a{};
    for (int i = 0; i < 20; ++i) a.in[i] = (const float*)d_in[i];
    a.out = (float*)d_out; a.ws = (unsigned char*)d_ws;
    if (MK_N_LAUNCHES == 1) {
        a.ph_lo = 0; a.ph_hi = N_PHASES;
        void* kargs[] = {&a};
        hipError_t e = hipLaunchCooperativeKernel((const void*)mk_fwd, dim3(grid), dim3(NWAVES * 64), kargs, LDS_BYTES, stream);
        if (e != hipSuccess) fprintf(stderr, "kernel_launch: cooperative launch failed: %s (grid %d)\n", hipGetErrorString(e), grid);
    } else {
        for (int p = 0; p < N_PHASES; ++p) { a.ph_lo = p; a.ph_hi = p + 1; hipLaunchKernelGGL(mk_fwd, dim3(grid), dim3(NWAVES * 64), LDS_BYTES, stream, a); }
    }
}
```

```cpp
#include <hip/hip_runtime.h>
#include <hip/hip_bf16.h>
#include <cstdio>
#include <cstdint>
#include <cmath>
namespace pg8 {
#define PG8_LAS __attribute__((address_space(3)))
typedef unsigned short bf16_t;
typedef short bf16x8 __attribute__((ext_vector_type(8)));
typedef float f32x4 __attribute__((ext_vector_type(4)));
typedef unsigned u32x4 __attribute__((ext_vector_type(4)));
constexpr int BM = 256, BK = 64, HALF = 128, HTB = HALF * BK * 2  , STAGE_BYTES = 8 * HTB, NXCD = 8, WGM = 8;

__host__ __device__ __forceinline__ int lds_byte(int r, int c) { const int st = (r >> 4) * 2 + (c >> 5), rr = r & 15, cc = c & 31, ob = rr * 64 + cc * 2; return st * 1024 + (ob ^ (((ob >> 9) & 1) << 5)); }
__host__ __device__ __forceinline__ void stage_rc(int b, int& R, int& C) { const int st = b / 1024, sb = b % 1024, swz = sb ^ (((sb >> 9) & 1) << 5); R = (st >> 1) * 16 + swz / 64; C = (st & 1) * 32 + (swz % 64) / 2; }
__host__ __device__ __forceinline__ int perm32(int rho) { const int n = rho >> 4, i = rho & 15; return 8 * (i >> 2) + 4 * n + (i & 3); }

struct Unit { int pm, pn; };
struct Gemm { const bf16_t* A; const bf16_t* Bt; int M, N, K; };

struct StaticOrder {
    int nM, nN, nwg, G, c;
    __host__ __device__ void init(int M, int N, int G_, int c_) { nM = M / BM; nN = N / BM; nwg = nM * nN; G = G_; c = c_; }
    __host__ __device__ bool next(int i, Unit& u) const {
        const long L = (long)i * G + c; if (L >= nwg) return false;
        int wgid = (int)L; { const int q = nwg / NXCD, r = nwg % NXCD, xcd = wgid % NXCD, off = wgid / NXCD; wgid = (xcd < r ? xcd * (q + 1) : r * (q + 1) + (xcd - r) * q) + off; }
        const int nig = WGM * nN, gid = wgid / nig, fm = gid * WGM, gsz = (nM - fm) < WGM ? (nM - fm) : WGM;
        u.pm = fm + ((wgid % nig) % gsz); u.pn = (wgid % nig) / gsz; return true;
    }
    __device__ __forceinline__ void a_ready(const Unit&) const {}
    __device__ __forceinline__ void done(const Unit&) const {}
};

__device__ __forceinline__ unsigned cvt_pk_bf16(float lo, float hi) { unsigned r; asm volatile("v_cvt_pk_bf16_f32 %0, %1, %2" : "=v"(r) : "v"(lo), "v"(hi)); return r; }
typedef float f32x2 __attribute__((ext_vector_type(2)));
template <class Epi, class Sched, bool ALIGN_EPI = false, bool SP2 = false>
__device__ __forceinline__ void gemm_phase(PG8_LAS unsigned char* lds, const Gemm g, const Sched& S, const Epi& E) {
    const int tid = threadIdx.x, wid = __builtin_amdgcn_readfirstlane(tid >> 6), lane = tid & 63, wr = wid >> 2, wc = wid & 3, fr = lane & 15, fq = lane >> 4;
    const int K = g.K, nt = K / BK;
    unsigned voffA[2], voffB[2];
#pragma unroll
    for (int i = 0; i < 2; ++i) { int R, C; stage_rc(tid * 16 + i * 8192, R, C); const int Rb = Epi::PERM ? ((R & ~31) + perm32(R & 31)) : R;
        voffA[i] = (unsigned)(R * K + C) * 2u; voffB[i] = (unsigned)(Rb * K + C) * 2u; }
    const size_t kstep = (size_t)(BK * 2);
    const size_t hstep = (size_t)HALF * K * 2;
    const size_t tstep = 2 * hstep;
    const unsigned ldsw = (unsigned)wid * 1024u;
    const int aoff = lds_byte(wr * 64 + fr, fq * 8), boff = lds_byte(wc * 32 + fr, fq * 8);
#define PG8_SA(b, h) (((b) * 2 + (h)) * HTB)
#define PG8_SB(b, h) ((4 + (b) * 2 + (h)) * HTB)
#define PG8_STAGE(bufoff, gbase, voff) do { _Pragma("unroll") for (int _i = 0; _i < 2; ++_i) \
        __builtin_amdgcn_global_load_lds((const unsigned*)((const char*)(gbase) + (voff)[_i]), (PG8_LAS unsigned*)(lds + (bufoff) + ldsw + _i * 8192), 16, 0, 0); } while (0)
#define PG8_LDA(dst, b, h) do { _Pragma("unroll") for (int m = 0; m < 4; ++m) _Pragma("unroll") for (int k = 0; k < 2; ++k) dst[m][k] = *(const PG8_LAS bf16x8*)(lds + PG8_SA(b, h) + aoff + m * 2048 + k * 1024); } while (0)
#define PG8_LDB(dst, b, h) do { _Pragma("unroll") for (int n = 0; n < 2; ++n) _Pragma("unroll") for (int k = 0; k < 2; ++k) dst[n][k] = *(const PG8_LAS bf16x8*)(lds + PG8_SB(b, h) + boff + n * 2048 + k * 1024); } while (0)
#define PG8_MMA(ai, bj, At, Bt) do { __builtin_amdgcn_s_setprio(1); _Pragma("unroll") for (int m = 0; m < 4; ++m) _Pragma("unroll") for (int n = 0; n < 2; ++n) _Pragma("unroll") for (int k = 0; k < 2; ++k) \
        acc[ai][bj][m][n] = __builtin_amdgcn_mfma_f32_16x16x32_bf16(Bt[n][k], At[m][k], acc[ai][bj][m][n], 0, 0, 0); __builtin_amdgcn_s_setprio(0); } while (0)
#define PG8_WAIT_V(n) asm volatile("s_waitcnt vmcnt(" #n ")" ::: "memory")
#define PG8_WAIT_L(n) asm volatile("s_waitcnt lgkmcnt(" #n ")" ::: "memory")
#define PG8_BAR __builtin_amdgcn_s_barrier()
#define PG8_SCHED __builtin_amdgcn_sched_barrier(0)
    Unit cur, nxt; int ui = 0;
    if (!S.next(0, cur)) return;
    f32x4 acc[2][2][4][2];
#pragma unroll
    for (int a = 0; a < 2; ++a)
#pragma unroll
        for (int b = 0; b < 2; ++b)
#pragma unroll
            for (int m = 0; m < 4; ++m)
#pragma unroll
                for (int n = 0; n < 2; ++n) acc[a][b][m][n] = (f32x4){0.f, 0.f, 0.f, 0.f};
    bf16x8 At[4][2], B0[2][2], B1[2][2];
    const char* cA = (const char*)g.A + (size_t)cur.pm * tstep; const char* cB = (const char*)g.Bt + (size_t)cur.pn * tstep;
    S.a_ready(cur);
    if constexpr (SP2) {
        PG8_STAGE(PG8_SB(0, 0), cB, voffB); PG8_STAGE(PG8_SB(0, 1), cB + hstep, voffB); PG8_STAGE(PG8_SA(0, 0), cA, voffA); PG8_STAGE(PG8_SA(0, 1), cA + hstep, voffA);
        if (wr == 1) PG8_BAR;
        PG8_WAIT_V(2); PG8_BAR;
        PG8_STAGE(PG8_SB(1, 0), cB + kstep, voffB); PG8_STAGE(PG8_SA(1, 0), cA + kstep, voffA); PG8_STAGE(PG8_SB(1, 1), cB + hstep + kstep, voffB);
        PG8_WAIT_V(6); PG8_BAR;
    } else {
        PG8_STAGE(PG8_SB(0, 0), cB, voffB); PG8_STAGE(PG8_SA(0, 0), cA, voffA); PG8_STAGE(PG8_SB(0, 1), cB + hstep, voffB); PG8_STAGE(PG8_SA(0, 1), cA + hstep, voffA);
        if (wr == 1) PG8_BAR;
        PG8_WAIT_V(4); PG8_BAR;
        PG8_STAGE(PG8_SB(1, 0), cB + kstep, voffB); PG8_STAGE(PG8_SA(1, 0), cA + kstep, voffA); PG8_STAGE(PG8_SB(1, 1), cB + hstep + kstep, voffB);
        PG8_WAIT_V(6); PG8_BAR;
    }
    for (;;) {
        const bool has_next = S.next(ui + 1, nxt);
        const char* nA = has_next ? (const char*)g.A + (size_t)nxt.pm * tstep : cA; const char* nB = has_next ? (const char*)g.Bt + (size_t)nxt.pn * tstep : cB;
        for (int t = 0; t < nt; t += 2) {
            const bool last = (t == nt - 2);
            const char* a1 = cA + (size_t)(t + 1) * kstep;
            const char* a2 = last ? nA : cA + (size_t)(t + 2) * kstep; const char* b2 = last ? nB : cB + (size_t)(t + 2) * kstep;
            const char* a3 = a2 + kstep; const char* b3 = b2 + kstep;
            if (last && has_next) S.a_ready(nxt);
            if constexpr (SP2) {
            PG8_LDB(B0, 0, 0); PG8_LDB(B1, 0, 1); PG8_SCHED; PG8_LDA(At, 0, 0); PG8_STAGE(PG8_SA(1, 1), a1 + hstep, voffA);
            PG8_WAIT_V(8); PG8_WAIT_L(0); PG8_BAR; PG8_MMA(0, 0, At, B0); PG8_MMA(0, 1, At, B1); PG8_BAR; PG8_SCHED;
            PG8_LDA(At, 0, 1); PG8_STAGE(PG8_SB(0, 0), b2, voffB); PG8_STAGE(PG8_SB(0, 1), b2 + hstep, voffB); PG8_STAGE(PG8_SA(0, 0), a2, voffA);
            PG8_WAIT_V(8); PG8_WAIT_L(0); PG8_BAR; PG8_MMA(1, 0, At, B0); PG8_MMA(1, 1, At, B1); PG8_BAR; PG8_SCHED;
            PG8_LDB(B0, 1, 0); PG8_LDB(B1, 1, 1); PG8_SCHED; PG8_LDA(At, 1, 0); PG8_STAGE(PG8_SA(0, 1), a2 + hstep, voffA);
            PG8_WAIT_V(8); PG8_WAIT_L(0); PG8_BAR; PG8_MMA(0, 0, At, B0); PG8_MMA(0, 1, At, B1); PG8_BAR; PG8_SCHED;
            PG8_LDA(At, 1, 1); PG8_STAGE(PG8_SB(1, 0), b3, voffB); PG8_STAGE(PG8_SB(1, 1), b3 + hstep, voffB); PG8_STAGE(PG8_SA(1, 0), a3, voffA);
            PG8_WAIT_V(8); PG8_WAIT_L(0); PG8_BAR; PG8_MMA(1, 0, At, B0); PG8_MMA(1, 1, At, B1); PG8_BAR; PG8_SCHED;
            } else {
            PG8_LDB(B0, 0, 0); PG8_SCHED; PG8_LDA(At, 0, 0); PG8_STAGE(PG8_SA(1, 1), a1 + hstep, voffA);
            PG8_WAIT_L(8); PG8_BAR; PG8_WAIT_L(0); PG8_MMA(0, 0, At, B0); PG8_BAR; PG8_SCHED;
            PG8_LDB(B1, 0, 1); PG8_STAGE(PG8_SB(0, 0), b2, voffB);
            PG8_BAR; PG8_WAIT_L(0); PG8_MMA(0, 1, At, B1); PG8_BAR;
            PG8_LDA(At, 0, 1); PG8_STAGE(PG8_SA(0, 0), a2, voffA);
            PG8_BAR; PG8_WAIT_L(0); PG8_MMA(1, 0, At, B0); PG8_BAR; PG8_SCHED;
            PG8_STAGE(PG8_SB(0, 1), b2 + hstep, voffB);
            PG8_WAIT_V(6); PG8_BAR; PG8_MMA(1, 1, At, B1); PG8_BAR;
            PG8_LDB(B0, 1, 0); PG8_SCHED; PG8_LDA(At, 1, 0); PG8_STAGE(PG8_SA(0, 1), a2 + hstep, voffA);
            PG8_WAIT_L(8); PG8_BAR; PG8_WAIT_L(0); PG8_MMA(0, 0, At, B0); PG8_BAR; PG8_SCHED;
            PG8_LDB(B1, 1, 1); PG8_STAGE(PG8_SB(1, 0), b3, voffB);
            PG8_BAR; PG8_WAIT_L(0); PG8_MMA(0, 1, At, B1); PG8_BAR;
            PG8_LDA(At, 1, 1); PG8_STAGE(PG8_SA(1, 0), a3, voffA);
            PG8_BAR; PG8_WAIT_L(0); PG8_MMA(1, 0, At, B0); PG8_BAR; PG8_SCHED;
            PG8_STAGE(PG8_SB(1, 1), b3 + hstep, voffB);
            PG8_WAIT_V(6); PG8_BAR; PG8_MMA(1, 1, At, B1); PG8_BAR;
            }
        }
        if constexpr (ALIGN_EPI) { if (wr == 0) PG8_BAR; }
        if constexpr (!Epi::AFTER_DRAIN) { E(acc, cur, wr, wc, fr, fq); S.done(cur); }
        if (!has_next) break;
#pragma unroll
        for (int a = 0; a < 2; ++a)
#pragma unroll
            for (int b = 0; b < 2; ++b)
#pragma unroll
                for (int m = 0; m < 4; ++m)
#pragma unroll
                    for (int n = 0; n < 2; ++n) acc[a][b][m][n] = (f32x4){0.f, 0.f, 0.f, 0.f};
        cur = nxt; cA = nA; cB = nB; ++ui;
        if constexpr (ALIGN_EPI) { if (wr == 1) PG8_BAR; }
    }
    PG8_WAIT_V(0);
    if constexpr (!ALIGN_EPI) { if (wr == 0) PG8_BAR; }
    PG8_BAR;
    if constexpr (Epi::AFTER_DRAIN) { E.fused(acc, cur, wr, wc, fr, fq, lds, wid, lane); S.done(cur); }
#undef PG8_SA
#undef PG8_SB
#undef PG8_STAGE
#undef PG8_LDA
#undef PG8_LDB
#undef PG8_MMA
#undef PG8_WAIT_V
#undef PG8_WAIT_L
#undef PG8_BAR
#undef PG8_SCHED
}
}
namespace pg8 {
__device__ __forceinline__ void st16_wt(void* p, u32x4 v) {
#ifdef USE_WT_STORES
    asm volatile("global_store_dwordx4 %0, %1, off sc1\n\ts_nop 1" :: "v"(p), "v"(v) : "memory");
#else
    *(u32x4*)p = v;
#endif
}
__device__ __forceinline__ u32x4 pack8(const f32x4 a, const f32x4 b) { u32x4 w; w.x = cvt_pk_bf16(a[0], a[1]); w.y = cvt_pk_bf16(a[2], a[3]); w.z = cvt_pk_bf16(b[0], b[1]); w.w = cvt_pk_bf16(b[2], b[3]); return w; }

struct EpiInProj {
    static constexpr bool PERM = true, AFTER_DRAIN = false;
    bf16_t* Q; bf16_t* KV; bf16_t* Z; bf16_t* BG; float* G; const float* qn; const float* kn;
    __device__ __forceinline__ void operator()(const f32x4 (&acc)[2][2][4][2], const Unit& u, int wr, int wc, int fr, int fq) const {
        const int pn = u.pn; const int row0 = u.pm * BM + wr * 64 + fr;
        if (pn <= 4) {
            const bool donorm = (pn < 2) || (pn >= 3 && wc < 2);
            const float* nw = (pn < 2) ? qn : kn;
            const float sc = (pn < 2) ? (0.125f * 1.4426950408889634f) : 1.0f;
            f32x4 w4[2][2];
#pragma unroll
            for (int bj = 0; bj < 2; ++bj)
#pragma unroll
                for (int n = 0; n < 2; ++n) { f32x4 t = *(const f32x4*)(nw + 32 * bj + 8 * fq + 4 * n); w4[bj][n] = donorm ? t * sc : (f32x4){1.f, 1.f, 1.f, 1.f}; }
            bf16_t* base; size_t rstride;
            if (pn < 2) { base = Q + (4 * pn + wc) * 64 + 8 * fq; rstride = 512; }
            else { const int ti = (pn - 2) * 2 + (wc >> 1), g = wc & 1; base = KV + (size_t)ti * ((size_t)4 * 2 * 8192 * 64) + 8 * fq; rstride = 64;
                   base += (size_t)g * 8192 * 64; }
#pragma unroll
            for (int ai = 0; ai < 2; ++ai)
#pragma unroll
                for (int m = 0; m < 4; ++m) {
                    const int r = row0 + ai * HALF + m * 16;
                    float rs = 1.f;
                    if (donorm) {
                        float ss = 0.f;
#pragma unroll
                        for (int bj = 0; bj < 2; ++bj)
#pragma unroll
                            for (int n = 0; n < 2; ++n) { const f32x4 x = acc[ai][bj][m][n]; ss += (x[0] * x[0] + x[1] * x[1]) + (x[2] * x[2] + x[3] * x[3]); }
                        ss += __shfl_xor(ss, 16); ss += __shfl_xor(ss, 32);
                        rs = 1.0f / sqrtf(ss * (1.0f / 64.0f) + 1e-6f);
                    }
                    size_t off;
                    if (pn < 2) off = (size_t)r * 512;
                    else { const int b = r >> 13, t = r & 8191; off = ((size_t)(b * 2) * 8192 + t) * 64; }
#pragma unroll
                    for (int bj = 0; bj < 2; ++bj) {
                        const f32x4 v0 = acc[ai][bj][m][0] * rs * w4[bj][0], v1 = acc[ai][bj][m][1] * rs * w4[bj][1];
                        st16_wt(base + off + 32 * bj, pack8(v0, v1));
                    }
                }
        } else if (pn <= 8) {
            bf16_t* base = Z + 128 * (pn - 5) + 32 * wc + 8 * fq;
#pragma unroll
            for (int ai = 0; ai < 2; ++ai)
#pragma unroll
                for (int m = 0; m < 4; ++m) {
                    const int r = row0 + ai * HALF + m * 16;
                    const f32x4 v0 = acc[ai][0][m][0] * acc[ai][1][m][0], v1 = acc[ai][0][m][1] * acc[ai][1][m][1];
                    st16_wt(base + (size_t)r * 512, pack8(v0, v1));
                }
        } else if (pn <= 10) {
            bf16_t* base = BG + 256 * (pn - 9) + 32 * wc + 8 * fq;
#pragma unroll
            for (int ai = 0; ai < 2; ++ai)
#pragma unroll
                for (int m = 0; m < 4; ++m) {
                    const int r = row0 + ai * HALF + m * 16;
#pragma unroll
                    for (int bj = 0; bj < 2; ++bj) st16_wt(base + (size_t)r * 512 + 128 * bj, pack8(acc[ai][bj][m][0], acc[ai][bj][m][1]));
                }
        } else {
            if (wc == 0 && fq < 3) {
#pragma unroll
                for (int ai = 0; ai < 2; ++ai)
#pragma unroll
                    for (int m = 0; m < 4; ++m) {
                        const int r = row0 + ai * HALF + m * 16;
#pragma unroll
                        for (int n = 0; n < 2; ++n) { const f32x4 x = acc[ai][0][m][n]; f32x4 s;
#pragma unroll
                            for (int e = 0; e < 4; ++e) s[e] = 1.0f / (1.0f + __expf(-x[e]));
                            *(f32x4*)(G + (size_t)r * 32 + 8 * fq + 4 * n) = s; }
                    }
            }
        }
    }
};

struct EpiOutProj {
    static constexpr bool PERM = true, AFTER_DRAIN = false;
    const float* x; bf16_t* X1B; bf16_t* A2; float* RSS; const float* mod; const float* n2;
    __device__ __forceinline__ void operator()(const f32x4 (&acc)[2][2][4][2], const Unit& u, int wr, int wc, int fr, int fq) const {
        const int row0 = u.pm * BM + wr * 64 + fr; const int b = (u.pm * BM) >> 13;
        const int col0 = u.pn * BM + wc * 32 + 8 * fq;
        f32x4 g1[2][2], a2[2][2];
#pragma unroll
        for (int bj = 0; bj < 2; ++bj)
#pragma unroll
            for (int n = 0; n < 2; ++n) { const int c = col0 + 128 * bj + 4 * n;
                g1[bj][n] = *(const f32x4*)(mod + (size_t)b * 6144 + 2 * 1024 + c);
                const f32x4 s2 = *(const f32x4*)(mod + (size_t)b * 6144 + 4 * 1024 + c), nn = *(const f32x4*)(n2 + c);
                a2[bj][n] = nn * (s2 + 1.0f); }
#pragma unroll
        for (int ai = 0; ai < 2; ++ai)
#pragma unroll
          for (int mh = 0; mh < 2; ++mh) {
            f32x4 xv[2][2][2];
#pragma unroll
            for (int mm = 0; mm < 2; ++mm)
#pragma unroll
                for (int bj = 0; bj < 2; ++bj) { const size_t off = (size_t)(row0 + ai * HALF + (2 * mh + mm) * 16) * 1024 + col0 + 128 * bj; xv[mm][bj][0] = *(const f32x4*)(x + off); xv[mm][bj][1] = *(const f32x4*)(x + off + 4); }
#pragma unroll
            for (int mm = 0; mm < 2; ++mm)
#pragma unroll
                for (int bj = 0; bj < 2; ++bj) asm volatile("" : "+v"(xv[mm][bj][0]), "+v"(xv[mm][bj][1]));
#pragma unroll
            for (int mm = 0; mm < 2; ++mm) {
                const int m = 2 * mh + mm;
                const int r = row0 + ai * HALF + m * 16; float ss = 0.f;
#pragma unroll
                for (int bj = 0; bj < 2; ++bj) {
                    const size_t off = (size_t)r * 1024 + col0 + 128 * bj;
                    const f32x4 ya = xv[mm][bj][0] + g1[bj][0] * acc[ai][bj][m][0], yb = xv[mm][bj][1] + g1[bj][1] * acc[ai][bj][m][1];
                    st16_wt(X1B + off, pack8(ya, yb));
                    ss += (ya[0] * ya[0] + ya[1] * ya[1]) + (ya[2] * ya[2] + ya[3] * ya[3]) + (yb[0] * yb[0] + yb[1] * yb[1]) + (yb[2] * yb[2] + yb[3] * yb[3]);
                    st16_wt(A2 + off, pack8(ya * a2[bj][0], yb * a2[bj][1]));
                }
                ss += __shfl_xor(ss, 16); ss += __shfl_xor(ss, 32);
                if (fq == 0) RSS[(size_t)r * 16 + u.pn * 4 + wc] = ss;
            }
          }
    }
};

struct EpiFF1 {
    static constexpr bool PERM = true, AFTER_DRAIN = false;
    bf16_t* HID; const float* RSS; const float* bff1;
    __device__ __forceinline__ void operator()(const f32x4 (&acc)[2][2][4][2], const Unit& u, int wr, int wc, int fr, int fq) const {
        const int row0 = u.pm * BM + wr * 64 + fr; const int b = (u.pm * BM) >> 13;
        const int col0 = u.pn * BM + wc * 32 + 8 * fq;
        f32x4 bv[2][2];
#pragma unroll
        for (int bj = 0; bj < 2; ++bj)
#pragma unroll
            for (int n = 0; n < 2; ++n) bv[bj][n] = *(const f32x4*)(bff1 + (size_t)b * 4096 + col0 + 128 * bj + 4 * n);
#pragma unroll
        for (int ai = 0; ai < 2; ++ai) {
            f32x4 sv[4][4];
#pragma unroll
            for (int m = 0; m < 4; ++m)
#pragma unroll
                for (int q = 0; q < 4; ++q) sv[m][q] = *(const f32x4*)(RSS + (size_t)(row0 + ai * HALF + m * 16) * 16 + 4 * q);
#pragma unroll
            for (int m = 0; m < 4; ++m) asm volatile("" : "+v"(sv[m][0]), "+v"(sv[m][1]), "+v"(sv[m][2]), "+v"(sv[m][3]));
#pragma unroll
            for (int m = 0; m < 4; ++m) {
                const int r = row0 + ai * HALF + m * 16;
                const f32x4 st = (sv[m][0] + sv[m][1]) + (sv[m][2] + sv[m][3]);
                const float rs = 1.0f / sqrtf(((st[0] + st[1]) + (st[2] + st[3])) * (1.0f / 1024.0f) + 1e-6f);
#pragma unroll
                for (int bj = 0; bj < 2; ++bj) {
                    f32x4 h0 = acc[ai][bj][m][0] * rs + bv[bj][0], h1 = acc[ai][bj][m][1] * rs + bv[bj][1];
#pragma unroll
                    for (int e = 0; e < 4; ++e) { const float a = fmaxf(h0[e], 0.f), c = fmaxf(h1[e], 0.f); h0[e] = a * a; h1[e] = c * c; }
                    st16_wt(HID + (size_t)r * 4096 + col0 + 128 * bj, pack8(h0, h1));
                }
            }
        }
    }
};

struct EpiFF2 {
    static constexpr bool PERM = true, AFTER_DRAIN = false;
    const bf16_t* X1B; const float* mod; float* dst;
    __device__ __forceinline__ void operator()(const f32x4 (&acc)[2][2][4][2], const Unit& u, int wr, int wc, int fr, int fq) const {
        const int row0 = u.pm * BM + wr * 64 + fr; const int b = (u.pm * BM) >> 13;
        const int col0 = u.pn * BM + wc * 32 + 8 * fq;
        f32x4 g2[2][2];
#pragma unroll
        for (int bj = 0; bj < 2; ++bj)
#pragma unroll
            for (int n = 0; n < 2; ++n) g2[bj][n] = *(const f32x4*)(mod + (size_t)b * 6144 + 5 * 1024 + col0 + 128 * bj + 4 * n);
#pragma unroll
        for (int ai = 0; ai < 2; ++ai) {
            u32x4 xv[4][2];
#pragma unroll
            for (int m = 0; m < 4; ++m)
#pragma unroll
                for (int bj = 0; bj < 2; ++bj) { const size_t off = (size_t)(row0 + ai * HALF + m * 16) * 1024 + col0 + 128 * bj; xv[m][bj] = *(const u32x4*)(X1B + off); }
#pragma unroll
            for (int m = 0; m < 4; ++m)
#pragma unroll
                for (int bj = 0; bj < 2; ++bj) asm volatile("" : "+v"(xv[m][bj]));
#pragma unroll
            for (int m = 0; m < 4; ++m)
#pragma unroll
                for (int bj = 0; bj < 2; ++bj) {
                    const size_t off = (size_t)(row0 + ai * HALF + m * 16) * 1024 + col0 + 128 * bj;
                    const u32x4 w = xv[m][bj];
                    const f32x4 xa = {__builtin_bit_cast(float, w.x << 16), __builtin_bit_cast(float, w.x & 0xffff0000u), __builtin_bit_cast(float, w.y << 16), __builtin_bit_cast(float, w.y & 0xffff0000u)};
                    const f32x4 xb = {__builtin_bit_cast(float, w.z << 16), __builtin_bit_cast(float, w.z & 0xffff0000u), __builtin_bit_cast(float, w.w << 16), __builtin_bit_cast(float, w.w & 0xffff0000u)};
                    *(f32x4*)(dst + off) = xa + g2[bj][0] * acc[ai][bj][m][0]; *(f32x4*)(dst + off + 4) = xb + g2[bj][1] * acc[ai][bj][m][1];
                }
        }
    }
};
}

#ifndef MK_N_LAUNCHES
#define MK_N_LAUNCHES 1
#endif
constexpr int NWAVES = 8;
constexpr int N_PHASES = 8;
constexpr int BATCH = 4, T = 8192, D = 1024, M = BATCH * T, FF = 4096, NIN = 3072, INCOLS = 2840;
constexpr int NCMP = 511;
constexpr float LOG2E = 1.4426950408889634f;
constexpr size_t MiB = 1u << 20;
constexpr size_t WS_CTL = 0, CTL_ZERO_BYTES = 32 * 1024;
constexpr size_t WS_MOD = 1 * MiB;
constexpr size_t WS_BFF1 = 1 * MiB + 128 * 1024;
constexpr size_t WS_PEP = 1 * MiB + 256 * 1024;
constexpr size_t WS_RSS = 2 * MiB;
constexpr size_t WS_G = 4 * MiB;
constexpr size_t WS_WIN = 8 * MiB;
constexpr size_t WS_WOUT = 14 * MiB;
constexpr size_t WS_W1 = 16 * MiB;
constexpr size_t WS_W2 = 24 * MiB;
constexpr size_t WS_CW1K = 32 * MiB, WS_CW1V = 33 * MiB;
constexpr size_t WS_CW2K = 34 * MiB, WS_CW2V = 34 * MiB + 64 * 1024;
constexpr size_t WS_KC = 35 * MiB, WS_VC = 35 * MiB + 512 * 1024;
constexpr size_t WS_A2 = 36 * MiB;
constexpr size_t WS_H = 100 * MiB;
constexpr size_t WS_Q = 164 * MiB;
constexpr size_t WS_KV = 196 * MiB;
constexpr size_t KV_TENS = (size_t)4 * 2 * 8192 * 64;
constexpr size_t WS_Z = 244 * MiB;
constexpr size_t WS_BG = 276 * MiB;
constexpr size_t WS_MIX = 308 * MiB;
constexpr size_t WS_HID = 100 * MiB;
constexpr size_t WS_X1B = 380 * MiB;
constexpr size_t WS_END = 444 * MiB;
constexpr int CW_BAR = 4096;
constexpr int CW_QHEAD = 1024;

constexpr int RING_BYTES = 131072;
constexpr int LDSCTL_OFF = 151 * 1024, MISC_OFF = LDSCTL_OFF + 320;
constexpr int LDS_BYTES = 152 * 1024;

#define GAS __attribute__((address_space(1)))
#define LAS __attribute__((address_space(3)))
typedef unsigned short bf16;
typedef unsigned v4u __attribute__((ext_vector_type(4)));
typedef float f32x4 __attribute__((ext_vector_type(4)));
typedef float f32x16 __attribute__((ext_vector_type(16)));
typedef short bf16x8 __attribute__((ext_vector_type(8)));
typedef short s16x4 __attribute__((ext_vector_type(4)));
typedef GAS unsigned gu32;
#define RLX_AGENT __ATOMIC_RELAXED, __HIP_MEMORY_SCOPE_AGENT
#define LDS_WAIT() asm volatile("s_waitcnt lgkmcnt(0)" ::: "memory")
#define VM_WAIT() asm volatile("s_waitcnt vmcnt(0)" ::: "memory")
__device__ __forceinline__ unsigned f2bf(float f) { unsigned u = __builtin_bit_cast(unsigned, f); return (u + 0x7fffu + ((u >> 16) & 1u)) >> 16; }
__device__ __forceinline__ unsigned pk2(float lo, float hi) { return f2bf(lo) | (f2bf(hi) << 16); }
__device__ __forceinline__ float bf2f(unsigned short h) { return __builtin_bit_cast(float, (unsigned)h << 16); }
#define XB_TMO      128
#define XB_XCNT(j)  (256  + 64 * (j))
#define XB_XSUB(j)  (1280 + 64 * (j))
#define XB_XGEN(j)  (2304 + 64 * (j))
#define XB_TOP      3328
#define XB_TOPGEN   3392
#define XCD_BAR_WORDS 3456
#define XB_SPIN_CAP (1u << 18)

__device__ __forceinline__ unsigned xb_ld(unsigned* p)              { return __hip_atomic_load(p, __ATOMIC_RELAXED, __HIP_MEMORY_SCOPE_AGENT); }
__device__ __forceinline__ unsigned xb_add(unsigned* p, unsigned v) { return __hip_atomic_fetch_add(p, v, __ATOMIC_RELAXED, __HIP_MEMORY_SCOPE_AGENT); }
__device__ __forceinline__ unsigned xb_xcc_id() { return (unsigned)__builtin_amdgcn_s_getreg((3 << 11) | 20) & 0xFu; }
#define XB_SPIN(cond, bar) do { unsigned _sp = 0; while (cond) { __builtin_amdgcn_s_sleep(1); \
    if ((++_sp & 255u) == 0u) { if (xb_ld(&(bar)[XB_TMO])) break; if (_sp > XB_SPIN_CAP) { atomicAdd(&(bar)[XB_TMO], 1u); break; } } } } while (0)

struct XcdBarrier {
    unsigned* bar; unsigned x;
    volatile LAS unsigned* st;
};

__device__ __forceinline__ XcdBarrier xcd_barrier_post(unsigned* bar, volatile LAS unsigned* st) {
    XcdBarrier b; b.bar = bar; b.x = xb_xcc_id(); b.st = st;
    if (threadIdx.x == 0) (void)xb_add(&bar[XB_XCNT(b.x)], 1u);
    return b;
}
__device__ __forceinline__ void xcd_barrier_complete(unsigned* bar, unsigned x, unsigned& nloc, unsigned& nx) {
    const unsigned G = gridDim.x * gridDim.y * gridDim.z;
    unsigned sum, cnt, mine, sp = 0u;
    for (;;) {
        sum = 0u; cnt = 0u; mine = 0u;
#pragma unroll
        for (unsigned j = 0; j < 16; ++j) { const unsigned c = xb_ld(&bar[XB_XCNT(j)]); sum += c; cnt += (c > 0u) ? 1u : 0u; mine = (j == x) ? c : mine; }
        if (sum == G) break;
        __builtin_amdgcn_s_sleep(1);
        if ((++sp & 255u) == 0u) { if (xb_ld(&bar[XB_TMO])) break; if (sp > XB_SPIN_CAP) { atomicAdd(&bar[XB_TMO], 1u); break; } }
    }
    nloc = mine > 0u ? mine : 1u; nx = cnt > 0u ? cnt : 1u;
}

__device__ __forceinline__ void xcd_barrier(const XcdBarrier& b) {
    asm volatile("s_waitcnt vmcnt(0)" ::: "memory");
    __syncthreads();
    if (threadIdx.x == 0) {
        unsigned* bar = b.bar;
        __builtin_amdgcn_s_waitcnt(0);
        unsigned nloc = b.st[0], nx = b.st[1];
        if (nloc == 0u) { xcd_barrier_complete(bar, b.x, nloc, nx); b.st[0] = nloc; b.st[1] = nx; }
        const unsigned old = xb_add(&bar[XB_XSUB(b.x)], 1u);
        const unsigned gen = old / nloc;
        if (old + 1u == (gen + 1u) * nloc) {
            __builtin_amdgcn_fence(__ATOMIC_RELEASE, "agent");
            asm volatile("s_waitcnt vmcnt(0)" ::: "memory");
            const unsigned og = xb_add(&bar[XB_TOP], 1u);
            const unsigned tg = og / nx;
            if (og + 1u == (tg + 1u) * nx) xb_add(&bar[XB_TOPGEN], 1u);
            else XB_SPIN(xb_ld(&bar[XB_TOPGEN]) == tg, bar);
            __builtin_amdgcn_fence(__ATOMIC_ACQUIRE, "agent");
            xb_add(&bar[XB_XGEN(b.x)], 1u);
            asm volatile("s_waitcnt vmcnt(0)" ::: "memory");
        } else {
            XB_SPIN(xb_ld(&bar[XB_XGEN(b.x)]) == gen, bar);
            __builtin_amdgcn_fence(__ATOMIC_ACQUIRE, "agent");
            asm volatile("s_waitcnt vmcnt(0)" ::: "memory");
        }
    }
    __syncthreads();
}

struct Frame {
    LAS unsigned char* lds;
    volatile LAS unsigned* MISC;
    gu32* ctl;
    int tid, lane, wave;
    int vcu, G;
    const float* in[20];
    float* out;
    unsigned char* ws;
    unsigned long long tp_t0, tp_acc;
};
#ifdef ATP_A
#define ATP(F, id) do { if ((id) == ATP_A) (F).tp_t0 = __builtin_amdgcn_s_memrealtime(); if ((id) == ATP_B) (F).tp_acc += __builtin_amdgcn_s_memrealtime() - (F).tp_t0; } while (0)
#else
#define ATP(F, id) do {} while (0)
#endif
__device__ __forceinline__ float wave_sum(float v) {
#pragma unroll
    for (int o = 1; o < 64; o <<= 1) v += __shfl_xor(v, o);
    return v;
}

__device__ __forceinline__ void p0_transpose_item(const float* W, int K, int N, int nsrc0, int nvalid, bf16* WT, int drow0, int kb, LAS float* scr, int lane) {
    const int k0 = 64 * kb; const int nl = lane & 31;
    float tv[32];
#pragma unroll
    for (int i = 0; i < 32; ++i) { const int kk = 2 * i + (lane >> 5); tv[i] = (nl < nvalid) ? W[(size_t)(k0 + kk) * N + nsrc0 + nl] : 0.f; }
#pragma unroll
    for (int i = 0; i < 32; ++i) { const int kk = 2 * i + (lane >> 5); scr[kk * 33 + nl] = tv[i]; }
    LDS_WAIT(); asm volatile("" ::: "memory");
    const int c = lane & 7;
#pragma unroll
    for (int j = 0; j < 4; ++j) { const int n = (lane >> 3) + 8 * j; const LAS float* s = scr + (8 * c) * 33 + n;
        v4u o; o.x = pk2(s[0 * 33], s[1 * 33]); o.y = pk2(s[2 * 33], s[3 * 33]); o.z = pk2(s[4 * 33], s[5 * 33]); o.w = pk2(s[6 * 33], s[7 * 33]);
        *(GAS v4u*)(WT + (size_t)(drow0 + n) * K + k0 + 8 * c) = o; }
    LDS_WAIT(); asm volatile("" ::: "memory");
}
__device__ __forceinline__ void win_src(int rb, int& src0, int& nvalid) {
    const int pn = rb >> 3, q = rb & 7, bj = q >> 2, wc = q & 3; nvalid = 32;
    if (pn < 2) src0 = (4 * pn + wc) * 64 + 32 * bj;
    else if (pn < 5) src0 = 512 + (pn - 2) * 256 + (wc >> 1) * 128 + (wc & 1) * 64 + 32 * bj;
    else if (pn < 9) src0 = (bj == 0 ? 1304 : 2328) + 128 * (pn - 5) + 32 * wc;
    else if (pn < 11) src0 = 1816 + 256 * (pn - 9) + 32 * q;
    else { src0 = 1280; nvalid = (q == 0) ? 24 : 0; }
}
__device__ __forceinline__ void p0_phase(Frame& F) {
    const int bid = blockIdx.x;
    ATP(F, 60);
    for (int it = bid; it < 224; it += F.G) {
      if (it < 192) {
        const int cb = it;
        LAS float* sc = (LAS float*)(F.lds);
        LAS float* red = (LAS float*)(F.lds + 16384);
        const float* c = F.in[1];
        for (int i = F.tid; i < 4096; i += 512) { const float v = c[i]; sc[i] = v / (1.0f + __expf(-v)); }
        __syncthreads();
        const float* wa = F.in[16]; const int col = 32 * cb + (F.lane & 31), kpar = F.lane >> 5;
        float a0 = 0.f, a1 = 0.f, a2 = 0.f, a3 = 0.f;
#pragma unroll 32
        for (int i = 0; i < 64; ++i) { const int k = 128 * F.wave + 2 * i + kpar; const float w = wa[(size_t)k * 6144 + col];
            a0 += sc[k] * w; a1 += sc[1024 + k] * w; a2 += sc[2048 + k] * w; a3 += sc[3072 + k] * w; }
        a0 += __shfl_xor(a0, 32); a1 += __shfl_xor(a1, 32); a2 += __shfl_xor(a2, 32); a3 += __shfl_xor(a3, 32);
        if (F.lane < 32) { red[(F.wave * 4 + 0) * 32 + F.lane] = a0; red[(F.wave * 4 + 1) * 32 + F.lane] = a1; red[(F.wave * 4 + 2) * 32 + F.lane] = a2; red[(F.wave * 4 + 3) * 32 + F.lane] = a3; }
        __syncthreads();
        if (F.tid < 128) { const int b = F.tid >> 5, cc = F.tid & 31; float s = F.in[17][32 * cb + cc];
#pragma unroll
            for (int w = 0; w < 8; ++w) s += red[(w * 4 + b) * 32 + cc];
            ((float*)(F.ws + WS_MOD))[b * 6144 + 32 * cb + cc] = s; }
        __syncthreads();
      } else {
        const int kv = (it - 192) >> 4, kc = (it - 192) & 15; const float* pe = F.in[kv ? 8 : 5]; const float* w1 = F.in[kv ? 9 : 6];
        if (F.tid < 256) { float s = 0.f;
#pragma unroll 32
            for (int k = 128 * kc; k < 128 * kc + 128; ++k) s += pe[k] * w1[(size_t)k * 256 + F.tid];
            ((float*)(F.ws + WS_PEP))[(kv * 16 + kc) * 256 + F.tid] = s; }
      }
    }
    __syncthreads();
    ATP(F, 61);
    LAS float* scr = (LAS float*)(F.lds + F.wave * 16384);
    const int gw = F.vcu * NWAVES + F.wave, NGW = F.G * NWAVES;
    constexpr int I_IN = 96 * 16, I_OUT = 32 * 16, I_1 = 128 * 16, I_2 = 32 * 64, I_C1 = 8 * 32, I_C2 = 2 * 4;
    constexpr int NITEMS = I_IN + I_OUT + I_1 + I_2 + 2 * I_C1 + 2 * I_C2;
    for (int it = gw; it < NITEMS; it += NGW) {
        int r = it;
        if (r < I_IN) { const int rb = r % 96, kb = r / 96; int s0, nv; win_src(rb, s0, nv); p0_transpose_item(F.in[2], D, INCOLS, s0, nv, (bf16*)(F.ws + WS_WIN), 32 * rb, kb, scr, F.lane); continue; } r -= I_IN;
        if (r < I_OUT) { const int rb = r & 31, kb = r >> 5; p0_transpose_item(F.in[13], D, D, 32 * rb, 32, (bf16*)(F.ws + WS_WOUT), 32 * rb, kb, scr, F.lane); continue; } r -= I_OUT;
        if (r < I_1) { const int rb = r & 127, kb = r >> 7; p0_transpose_item(F.in[18], D, FF, 32 * rb, 32, (bf16*)(F.ws + WS_W1), 32 * rb, kb, scr, F.lane); continue; } r -= I_1;
        if (r < I_2) { const int rb = r & 31, kb = r >> 5; p0_transpose_item(F.in[19], FF, D, 32 * rb, 32, (bf16*)(F.ws + WS_W2), 32 * rb, kb, scr, F.lane); continue; } r -= I_2;
        if (r < I_C1) { const int rb = r & 7, kb = r >> 3; p0_transpose_item(F.in[6], 2048, 256, 32 * rb, 32, (bf16*)(F.ws + WS_CW1K), 32 * rb, kb, scr, F.lane); continue; } r -= I_C1;
        if (r < I_C1) { const int rb = r & 7, kb = r >> 3; p0_transpose_item(F.in[9], 2048, 256, 32 * rb, 32, (bf16*)(F.ws + WS_CW1V), 32 * rb, kb, scr, F.lane); continue; } r -= I_C1;
        if (r < I_C2) { const int rb = r & 1, kb = r >> 1; p0_transpose_item(F.in[7], 256, 64, 32 * rb, 32, (bf16*)(F.ws + WS_CW2K), 32 * rb, kb, scr, F.lane); continue; } r -= I_C2;
        { const int rb = r & 1, kb = r >> 1; p0_transpose_item(F.in[10], 256, 64, 32 * rb, 32, (bf16*)(F.ws + WS_CW2V), 32 * rb, kb, scr, F.lane); }
    }
    __syncthreads();
}

__device__ __forceinline__ void p1_phase(Frame& F) {
    const int gw = F.vcu * NWAVES + F.wave, NGW = F.G * NWAVES;
    const float* mod = (const float*)(F.ws + WS_MOD);
    const float* x = F.in[0]; const float* n1 = F.in[14];
    bf16* H = (bf16*)(F.ws + WS_H);
    ATP(F, 10);
    for (int chunk = gw; chunk < M / 16; chunk += NGW) {
        const int r0 = chunk * 16, b = r0 >> 13;
        f32x4 ca[4], cb[4];
#pragma unroll
        for (int j = 0; j < 4; ++j) { const int c = 4 * (F.lane + 64 * j);
            const f32x4 nn = *(const f32x4*)(n1 + c), s1 = *(const f32x4*)(mod + (size_t)b * 6144 + 1024 + c);
            ca[j] = nn * (s1 + 1.0f); cb[j] = *(const f32x4*)(mod + (size_t)b * 6144 + c); }
        for (int rr = 0; rr < 16; rr += 4) {
            f32x4 v[4][4]; float s[4];
#pragma unroll
            for (int q = 0; q < 4; ++q) { const GAS f32x4* xr = (const GAS f32x4*)(x + (size_t)(r0 + rr + q) * D) + F.lane;
#pragma unroll
                for (int j = 0; j < 4; ++j) v[q][j] = xr[64 * j]; }
#pragma unroll
            for (int q = 0; q < 4; ++q) { s[q] = 0.f;
#pragma unroll
                for (int j = 0; j < 4; ++j) s[q] += (v[q][j].x * v[q][j].x + v[q][j].y * v[q][j].y) + (v[q][j].z * v[q][j].z + v[q][j].w * v[q][j].w); }
#pragma unroll
            for (int o = 1; o < 64; o <<= 1) {
#pragma unroll
                for (int q = 0; q < 4; ++q) s[q] += __shfl_xor(s[q], o); }
#pragma unroll
            for (int q = 0; q < 4; ++q) {
                const float rs = 1.0f / sqrtf(s[q] * (1.0f / D) + 1e-6f);
                GAS unsigned long long* o8 = (GAS unsigned long long*)(H + (size_t)(r0 + rr + q) * D) + F.lane;
#pragma unroll
                for (int j = 0; j < 4; ++j) { const f32x4 h = v[q][j] * rs * ca[j] + cb[j];
                    o8[64 * j] = (unsigned long long)pk2(h.x, h.y) | ((unsigned long long)pk2(h.z, h.w) << 32); }
            }
        }
    }
    ATP(F, 11);
    const bf16* W1t = (const bf16*)(F.ws + WS_W1);
    float* bff1 = (float*)(F.ws + WS_BFF1);
    for (int n = gw; n < FF; n += NGW) {
        float a[4] = {0.f, 0.f, 0.f, 0.f};
#pragma unroll
        for (int j = 0; j < 2; ++j) { const int k0 = 8 * F.lane + 512 * j;
            const v4u wv = *(const GAS v4u*)(W1t + (size_t)n * D + k0);
            float w[8]; w[0] = bf2f(wv.x & 0xffff); w[1] = bf2f(wv.x >> 16); w[2] = bf2f(wv.y & 0xffff); w[3] = bf2f(wv.y >> 16); w[4] = bf2f(wv.z & 0xffff); w[5] = bf2f(wv.z >> 16); w[6] = bf2f(wv.w & 0xffff); w[7] = bf2f(wv.w >> 16);
#pragma unroll
            for (int b = 0; b < 4; ++b) { const f32x4 s0 = *(const f32x4*)(mod + (size_t)b * 6144 + 3 * 1024 + k0), s1 = *(const f32x4*)(mod + (size_t)b * 6144 + 3 * 1024 + k0 + 4);
                a[b] += (w[0] * s0[0] + w[1] * s0[1]) + (w[2] * s0[2] + w[3] * s0[3]) + (w[4] * s1[0] + w[5] * s1[1]) + (w[6] * s1[2] + w[7] * s1[3]); } }
#pragma unroll
        for (int b = 0; b < 4; ++b) { const float s = wave_sum(a[b]); if (F.lane == 0) bff1[b * 4096 + n] = s; }
    }
    ATP(F, 12);
}

__device__ __forceinline__ float gelu_tanh(float x) {
    const float u = 0.7978845608028654f * (x + 0.044715f * x * x * x);
    const float e = __expf(2.0f * u);
    const float th = 1.0f - 2.0f / (1.0f + e);
    return 0.5f * x * (1.0f + th);
}
__device__ __forceinline__ void p3_phase(Frame& F) {
    constexpr int AIMG = 0, GSTR = 2064, HIDO = 68224, HSTR = 528, OUTO = 85120, OSTR = 65;
    const int lane = F.lane, w = F.wave, r32 = lane & 31, hi = lane >> 5;
    for (int item = blockIdx.x; item < 256; item += F.G) {
        const int prob = item >> 4, mt = item & 15, kv = prob >> 3, b = (prob >> 1) & 3, g = prob & 1, n0 = 32 * mt;
        const bf16* raw = (const bf16*)(F.ws + WS_KV) + (size_t)kv * KV_TENS + (size_t)(b * 2 + g) * 8192 * 64;
        ATP(F, 30);
        { v4u av[9];
#pragma unroll
          for (int q = 0; q < 9; ++q) { const int idx = F.tid + 512 * q, gl = idx >> 7, ch = idx & 127, gi = n0 + gl;
              av[q] = (v4u){0u, 0u, 0u, 0u}; if (idx < 33 * 128 && gi < 512) av[q] = *(const GAS v4u*)(raw + (size_t)gi * 1024 + ch * 8); }
#pragma unroll
          for (int q = 0; q < 9; ++q) { const int idx = F.tid + 512 * q, gl = idx >> 7, ch = idx & 127;
              if (idx < 33 * 128) *(LAS v4u*)(F.lds + AIMG + gl * GSTR + ch * 16) = av[q]; } }
        __syncthreads();
        ATP(F, 31);
        const bf16* W1t = (const bf16*)(F.ws + (kv ? WS_CW1V : WS_CW1K));
        const bf16* bp = W1t + (size_t)(32 * w + r32) * 2048 + 8 * hi;
        const LAS unsigned char* ap = F.lds + AIMG + r32 * GSTR + hi * 16;
        f32x16 acc = {};
#pragma unroll 1
        for (int s0 = 0; s0 < 128; s0 += 32) {
            bf16x8 bfr[32];
#pragma unroll
            for (int j = 0; j < 32; ++j) bfr[j] = *(const GAS bf16x8*)(bp + 16 * (s0 + j));
#pragma unroll
            for (int j = 0; j < 32; ++j) asm volatile("" : "+v"(bfr[j]));
            const LAS unsigned char* aq = ap + (s0 >= 64 ? GSTR + (s0 - 64) * 32 : s0 * 32);
#pragma unroll
            for (int j = 0; j < 32; ++j) { const bf16x8 af = *(const LAS bf16x8*)(aq + j * 32); acc = __builtin_amdgcn_mfma_f32_32x32x16_bf16(af, bfr[j], acc, 0, 0, 0); }
        }
        ATP(F, 32);
        { const float* pp = (const float*)(F.ws + WS_PEP) + kv * 16 * 256 + 32 * w + r32; float pb = 0.f;
#pragma unroll
          for (int kc = 0; kc < 16; ++kc) pb += pp[kc * 256];
#pragma unroll
          for (int i = 0; i < 16; ++i) { const int row = (i & 3) + 8 * (i >> 2) + 4 * hi; const float h = gelu_tanh(acc[i] + pb);
              *(LAS unsigned short*)(F.lds + HIDO + row * HSTR + (32 * w + r32) * 2) = (unsigned short)f2bf(h); } }
        __syncthreads();
        if (w < 2) {
            const bf16* W2t = (const bf16*)(F.ws + (kv ? WS_CW2V : WS_CW2K));
            const bf16* bp2 = W2t + (size_t)(32 * w + r32) * 256 + 8 * hi;
            const LAS unsigned char* ap2 = F.lds + HIDO + r32 * HSTR + hi * 16;
            f32x16 a2 = {};
#pragma unroll
            for (int s = 0; s < 16; ++s) { const bf16x8 bf_ = *(const GAS bf16x8*)(bp2 + 16 * s); const bf16x8 af = *(const LAS bf16x8*)(ap2 + s * 32); a2 = __builtin_amdgcn_mfma_f32_32x32x16_bf16(af, bf_, a2, 0, 0, 0); }
#pragma unroll
            for (int i = 0; i < 16; ++i) { const int row = (i & 3) + 8 * (i >> 2) + 4 * hi; *(LAS float*)(F.lds + OUTO + (row * OSTR + 32 * w + r32) * 4) = a2[i]; }
        }
        __syncthreads();
        { const int row = F.tid >> 4, c4 = (F.tid & 15) * 4; const LAS float* op = (const LAS float*)(F.lds + OUTO) + row * OSTR + c4;
          float v0 = op[0], v1 = op[1], v2 = op[2], v3 = op[3];
          if (kv == 0) { float ss = (v0 * v0 + v1 * v1) + (v2 * v2 + v3 * v3); ss += __shfl_xor(ss, 1); ss += __shfl_xor(ss, 2); ss += __shfl_xor(ss, 4); ss += __shfl_xor(ss, 8);
              const float rs = 1.0f / sqrtf(ss * (1.0f / 64.0f) + 1e-6f); const f32x4 kn = *(const f32x4*)(F.in[4] + c4); v0 *= rs * kn[0]; v1 *= rs * kn[1]; v2 *= rs * kn[2]; v3 *= rs * kn[3]; }
          const int n = n0 + row; if (n >= NCMP) { v0 = v1 = v2 = v3 = 0.f; }
          bf16* dst = (bf16*)(F.ws + (kv ? WS_VC : WS_KC)) + ((size_t)(b * 2 + g) * 512 + n) * 64 + c4;
          *(GAS unsigned long long*)dst = (unsigned long long)pk2(v0, v1) | ((unsigned long long)pk2(v2, v3) << 32); }
        __syncthreads();
        ATP(F, 33);
    }
}

namespace att {
constexpr int SLOT = 16384;
constexpr int L_RING = 0;
constexpr int L_IMP = 49152, IMP_STR = 132;
constexpr int L_OACC = 49152;
constexpr int L_BTAB = L_OACC + 65536;
constexpr int NBT = 960, BT0 = 895;
constexpr int L_WSF = L_BTAB + 8 * NBT * 4;
constexpr int L_SELM = L_WSF + 2048;
constexpr int L_UNI = L_SELM + 1024;
constexpr int L_END = L_UNI + 256;
static_assert(L_END <= LDSCTL_OFF, "attention LDS map");
constexpr float NEG_INF = -INFINITY;
constexpr float THR = 8.0f;

__device__ __forceinline__ int t5_bucket(int n) {
    if (n < 16) return n;
    int b = 16;
    b += (n >= 21); b += (n >= 27); b += (n >= 35); b += (n >= 46); b += (n >= 59); b += (n >= 77); b += (n >= 99); b += (n >= 128);
    b += (n >= 166); b += (n >= 216); b += (n >= 280); b += (n >= 363); b += (n >= 470); b += (n >= 609); b += (n >= 790);
    return b;
}
__device__ __forceinline__ s16x4 vtr(const LAS unsigned char* p) { typedef short v4i16_t __attribute__((ext_vector_type(4))); return __builtin_bit_cast(s16x4, __builtin_amdgcn_ds_read_tr16_b64_v4i16((LAS v4i16_t*)p)); }
__device__ __forceinline__ unsigned cvtpk(float lo, float hi) { typedef float f2 __attribute__((ext_vector_type(2))); typedef __bf16 b2 __attribute__((ext_vector_type(2))); f2 v = {lo, hi}; b2 b = __builtin_convertvector(v, b2); return __builtin_bit_cast(unsigned, b); }
__device__ __forceinline__ float xhalf_max(float a) { auto rr = __builtin_amdgcn_permlane32_swap(__float_as_uint(a), __float_as_uint(a), false, false); return fmaxf(__uint_as_float(rr[0]), __uint_as_float(rr[1])); }
__device__ __forceinline__ float xhalf_sum(float a) { auto rr = __builtin_amdgcn_permlane32_swap(__float_as_uint(a), __float_as_uint(a), false, false); return __uint_as_float(rr[0]) + __uint_as_float(rr[1]); }
__device__ __forceinline__ float quad_sum(float a) {
    a += __int_as_float(__builtin_amdgcn_update_dpp(0, __float_as_int(a), 0xB1, 0xf, 0xf, true));
    a += __int_as_float(__builtin_amdgcn_update_dpp(0, __float_as_int(a), 0x4E, 0xf, 0xf, true));
    return a;
}
__device__ __forceinline__ void glds16(const void* gsrc, unsigned lds_dst) { unsigned keep;
    asm volatile("s_mov_b32 %0, m0\n\ts_mov_b32 m0, %2\n\ts_nop 0\n\tglobal_load_lds_dwordx4 %1, off\n\ts_mov_b32 m0, %0" : "=&s"(keep) : "v"(gsrc), "s"(lds_dst) : "memory"); }
#define ATT_WAIT_BAR(N) asm volatile("s_waitcnt vmcnt(" #N ") lgkmcnt(0)\n\ts_barrier" ::: "memory")
__device__ __forceinline__ void tile_dma(const bf16* Kt, const bf16* Vt, bool hasV, unsigned slot_addr, int w, int lane) {
    glds16(Kt + lane * 64 + w * 8, (unsigned)__builtin_amdgcn_readfirstlane(slot_addr + w * 1024));
    if (hasV) glds16(Vt + (16 * (w & 3) + (lane >> 2)) * 64 + (w >> 2) * 32 + (lane & 3) * 8, (unsigned)__builtin_amdgcn_readfirstlane(slot_addr + 8192 + w * 1024));
}
__device__ __forceinline__ void qk_tile(const LAS unsigned char* buf, const bf16x8 (&qf)[4], float cv, f32x16& p0, f32x16& p1, int r32, int hi) {
    const LAS unsigned char* kp = buf + hi * 1024 + r32 * 16;
    f32x16 c;
#pragma unroll
    for (int i = 0; i < 16; ++i) c[i] = cv;
    bf16x8 k0[4], k1[4];
#pragma unroll
    for (int s = 0; s < 4; ++s) { k0[s] = *(const LAS bf16x8*)(kp + s * 2048); k1[s] = *(const LAS bf16x8*)(kp + s * 2048 + 512); }
#ifndef NO_K_PIN
    __builtin_amdgcn_sched_barrier(0);
#endif
#ifdef ATT_PRIO
    __builtin_amdgcn_s_setprio(1);
#endif
    p0 = __builtin_amdgcn_mfma_f32_32x32x16_bf16(k0[0], qf[0], c, 0, 0, 0);
    p1 = __builtin_amdgcn_mfma_f32_32x32x16_bf16(k1[0], qf[0], c, 0, 0, 0);
#pragma unroll
    for (int s = 1; s < 4; ++s) {
        p0 = __builtin_amdgcn_mfma_f32_32x32x16_bf16(k0[s], qf[s], p0, 0, 0, 0);
        p1 = __builtin_amdgcn_mfma_f32_32x32x16_bf16(k1[s], qf[s], p1, 0, 0, 0);
    }
#ifdef ATT_PRIO
    __builtin_amdgcn_s_setprio(0);
#endif
}
template <int KSTEP>
__device__ __forceinline__ void bias_mask(f32x16& p0, f32x16& p1, const LAS float* bt, int dbase, int hi) {
#pragma unroll
    for (int i = 0; i < 16; ++i) {
        const int kl = (i & 3) + 8 * (i >> 2) + 4 * hi;
        const int d0 = dbase - KSTEP * kl, d1 = d0 - KSTEP * 32;
        const int i0 = BT0 - min(max(d0, 0), BT0), i1 = BT0 - min(max(d1, 0), BT0);
        const float b0 = bt[i0], b1 = bt[i1];
        p0[i] = (d0 >= 0) ? p0[i] + b0 : NEG_INF;
        p1[i] = (d1 >= 0) ? p1[i] + b1 : NEG_INF;
        if ((i & 3) == 3) asm volatile("" ::: "memory");
    }
}
template <int MODE>
__device__ __forceinline__ void bias_near(f32x16& p0, f32x16& p1, const LAS float* tb, int dbase, int hi) {
#pragma unroll
    for (int i = 0; i < 16; ++i) {
        const int ko = (i & 3) + 8 * (i >> 2);
        const float b0 = tb[ko], b1 = tb[ko + 32];
        const int d0 = dbase - ko - 4 * hi, d1 = d0 - 32;
        if (MODE == 0) { p0[i] += b0; p1[i] += b1; }
        else if (MODE == 1) { p0[i] = d0 >= 0 ? p0[i] + b0 : NEG_INF; p1[i] = d1 >= 0 ? p1[i] + b1 : NEG_INF; }
        else { p0[i] = d0 < 512 ? p0[i] + b0 : NEG_INF; p1[i] = d1 < 512 ? p1[i] + b1 : NEG_INF; }
        if ((i & 7) == 7) asm volatile("" ::: "memory");
    }
}
__device__ __forceinline__ void bias_near_mode(f32x16& p0, f32x16& p1, const LAS float* tb, int dbase, int hi, int mode) {
    if (mode == 0) bias_near<0>(p0, p1, tb, dbase, hi); else if (mode == 1) bias_near<1>(p0, p1, tb, dbase, hi); else bias_near<2>(p0, p1, tb, dbase, hi);
}
__device__ __forceinline__ float rowmax32(const f32x16& p0, const f32x16& p1) {
    float a = fmaxf(fmaxf(p0[0], p1[0]), p0[1]), b = fmaxf(fmaxf(p1[1], p0[2]), p1[2]);
#pragma unroll
    for (int i = 3; i < 15; i += 2) { a = fmaxf(fmaxf(a, p0[i]), p1[i]); b = fmaxf(fmaxf(b, p0[i + 1]), p1[i + 1]); }
    a = fmaxf(fmaxf(a, p0[15]), p1[15]);
    return xhalf_max(fmaxf(a, b));
}
__device__ __forceinline__ void pv_tile(const LAS unsigned char* buf, const f32x16& p0, const f32x16& p1, f32x16 (&o)[2], int lane, int hi) {
    const LAS unsigned char* vp = buf + 8192 + ((lane >> 4) & 1) * 32 + (lane & 3) * 8 + (4 * hi + ((lane & 15) >> 2)) * 64;
    bf16x8 pa[4];
#pragma unroll
    for (int s = 0; s < 2; ++s) {
        v4u a, c;
        a.x = cvtpk(p0[8 * s + 0], p0[8 * s + 1]); a.y = cvtpk(p0[8 * s + 2], p0[8 * s + 3]); a.z = cvtpk(p0[8 * s + 4], p0[8 * s + 5]); a.w = cvtpk(p0[8 * s + 6], p0[8 * s + 7]);
        c.x = cvtpk(p1[8 * s + 0], p1[8 * s + 1]); c.y = cvtpk(p1[8 * s + 2], p1[8 * s + 3]); c.z = cvtpk(p1[8 * s + 4], p1[8 * s + 5]); c.w = cvtpk(p1[8 * s + 6], p1[8 * s + 7]);
        pa[s] = __builtin_bit_cast(bf16x8, a); pa[2 + s] = __builtin_bit_cast(bf16x8, c);
    }
#pragma unroll
    for (int ks = 0; ks < 4; ++ks)
#pragma unroll
        for (int d0 = 0; d0 < 2; ++d0) {
            const s16x4 lo = vtr(vp + d0 * 4096 + ks * 1024), hh = vtr(vp + d0 * 4096 + ks * 1024 + 512);
            const bf16x8 vf = (bf16x8){lo[0], lo[1], lo[2], lo[3], hh[0], hh[1], hh[2], hh[3]};
            o[d0] = __builtin_amdgcn_mfma_f32_32x32x16_bf16(pa[ks], vf, o[d0], 0, 0, 0);
        }
}
struct VFrags { s16x4 lo[4][2], hh[4][2]; };
__device__ __forceinline__ void v_read(VFrags& vf, const LAS unsigned char* buf, int lane, int hi) {
    const LAS unsigned char* vp = buf + 8192 + ((lane >> 4) & 1) * 32 + (lane & 3) * 8 + (4 * hi + ((lane & 15) >> 2)) * 64;
#pragma unroll
    for (int ks = 0; ks < 4; ++ks)
#pragma unroll
        for (int d0 = 0; d0 < 2; ++d0) { vf.lo[ks][d0] = vtr(vp + d0 * 4096 + ks * 1024); vf.hh[ks][d0] = vtr(vp + d0 * 4096 + ks * 1024 + 512); }
}
__device__ __forceinline__ void pv_tile_pre(const VFrags& vf, const f32x16& p0, const f32x16& p1, f32x16 (&o)[2]) {
    bf16x8 pa[4];
#pragma unroll
    for (int s = 0; s < 2; ++s) {
        v4u a, c;
        a.x = cvtpk(p0[8 * s + 0], p0[8 * s + 1]); a.y = cvtpk(p0[8 * s + 2], p0[8 * s + 3]); a.z = cvtpk(p0[8 * s + 4], p0[8 * s + 5]); a.w = cvtpk(p0[8 * s + 6], p0[8 * s + 7]);
        c.x = cvtpk(p1[8 * s + 0], p1[8 * s + 1]); c.y = cvtpk(p1[8 * s + 2], p1[8 * s + 3]); c.z = cvtpk(p1[8 * s + 4], p1[8 * s + 5]); c.w = cvtpk(p1[8 * s + 6], p1[8 * s + 7]);
        pa[s] = __builtin_bit_cast(bf16x8, a); pa[2 + s] = __builtin_bit_cast(bf16x8, c);
    }
#pragma unroll
    for (int ks = 0; ks < 4; ++ks)
#pragma unroll
        for (int d0 = 0; d0 < 2; ++d0) {
            const bf16x8 v = (bf16x8){vf.lo[ks][d0][0], vf.lo[ks][d0][1], vf.lo[ks][d0][2], vf.lo[ks][d0][3], vf.hh[ks][d0][0], vf.hh[ks][d0][1], vf.hh[ks][d0][2], vf.hh[ks][d0][3]};
            o[d0] = __builtin_amdgcn_mfma_f32_32x32x16_bf16(pa[ks], v, o[d0], 0, 0, 0);
        }
}
__device__ __forceinline__ float exp_pv(const VFrags& vf, f32x16& p0, f32x16& p1, f32x16 (&o)[2]) {
    float s0 = 0.f, s1 = 0.f;
#pragma unroll
    for (int i = 0; i < 16; ++i) { p0[i] = __builtin_amdgcn_exp2f(p0[i]); s0 += p0[i]; }
    bf16x8 pa[2];
#pragma unroll
    for (int s = 0; s < 2; ++s) { v4u a; a.x = cvtpk(p0[8 * s + 0], p0[8 * s + 1]); a.y = cvtpk(p0[8 * s + 2], p0[8 * s + 3]); a.z = cvtpk(p0[8 * s + 4], p0[8 * s + 5]); a.w = cvtpk(p0[8 * s + 6], p0[8 * s + 7]); pa[s] = __builtin_bit_cast(bf16x8, a); }
#pragma unroll
    for (int ks = 0; ks < 2; ++ks)
#pragma unroll
        for (int d0 = 0; d0 < 2; ++d0) {
            const bf16x8 v = (bf16x8){vf.lo[ks][d0][0], vf.lo[ks][d0][1], vf.lo[ks][d0][2], vf.lo[ks][d0][3], vf.hh[ks][d0][0], vf.hh[ks][d0][1], vf.hh[ks][d0][2], vf.hh[ks][d0][3]};
            o[d0] = __builtin_amdgcn_mfma_f32_32x32x16_bf16(pa[ks], v, o[d0], 0, 0, 0);
        }
#pragma unroll
    for (int i = 0; i < 16; ++i) { p1[i] = __builtin_amdgcn_exp2f(p1[i]); s1 += p1[i]; }
#pragma unroll
    for (int s = 0; s < 2; ++s) { v4u a; a.x = cvtpk(p1[8 * s + 0], p1[8 * s + 1]); a.y = cvtpk(p1[8 * s + 2], p1[8 * s + 3]); a.z = cvtpk(p1[8 * s + 4], p1[8 * s + 5]); a.w = cvtpk(p1[8 * s + 6], p1[8 * s + 7]); pa[s] = __builtin_bit_cast(bf16x8, a); }
#pragma unroll
    for (int ks = 2; ks < 4; ++ks)
#pragma unroll
        for (int d0 = 0; d0 < 2; ++d0) {
            const bf16x8 v = (bf16x8){vf.lo[ks][d0][0], vf.lo[ks][d0][1], vf.lo[ks][d0][2], vf.lo[ks][d0][3], vf.hh[ks][d0][0], vf.hh[ks][d0][1], vf.hh[ks][d0][2], vf.hh[ks][d0][3]};
            o[d0] = __builtin_amdgcn_mfma_f32_32x32x16_bf16(pa[ks - 2], v, o[d0], 0, 0, 0);
        }
    return s0 + s1;
}
__device__ __forceinline__ void row_to_regs(LAS float* wsf, float v, float (&f)[16], int r32, int hi) {
    if (hi == 0) wsf[r32] = v;
#pragma unroll
    for (int u = 0; u < 4; ++u) { const f32x4 t = *(const LAS f32x4*)(wsf + 8 * u + 4 * hi); f[4 * u] = t[0]; f[4 * u + 1] = t[1]; f[4 * u + 2] = t[2]; f[4 * u + 3] = t[3]; }
}
struct SmState { float m, l; bool have; };
__device__ __forceinline__ void sm_init(SmState& st) { st.m = 0.f; st.l = 0.f; st.have = false; }
template <bool HASO>
__device__ __forceinline__ void sm_rebase(SmState& st, f32x16& p0, f32x16& p1, f32x16 (&o)[2], LAS float* wsf, int r32, int hi) {
    const float mx = rowmax32(p0, p1);
    const bool fin = mx > NEG_INF;
    const bool trig = st.have ? (mx > THR) : fin;
    if (__any(trig)) {
        const float dl = st.have ? fmaxf(mx, 0.f) : (fin ? mx : 0.f);
        const float alpha = st.have ? __builtin_amdgcn_exp2f(-dl) : 1.0f;
        st.m += dl; st.l *= alpha; st.have = st.have || fin;
#pragma unroll
        for (int i = 0; i < 16; ++i) { p0[i] -= dl; p1[i] -= dl; }
        if (HASO) { float f[16]; row_to_regs(wsf, alpha, f, r32, hi);
#pragma unroll
            for (int i = 0; i < 16; ++i) { o[0][i] *= f[i]; o[1][i] *= f[i]; } }
    }
}
__device__ __forceinline__ float exp_sum(f32x16& p0, f32x16& p1) {
    float s0 = 0.f, s1 = 0.f;
#pragma unroll
    for (int i = 0; i < 16; ++i) { p0[i] = __builtin_amdgcn_exp2f(p0[i]); p1[i] = __builtin_amdgcn_exp2f(p1[i]); s0 += p0[i]; s1 += p1[i]; }
    return s0 + s1;
}

__device__ __forceinline__ void build_btab(Frame& F) {
    LAS float* btab = (LAS float*)(F.lds + L_BTAB); const float* rb = F.in[11];
    __syncthreads();
    for (int i = F.tid; i < 8 * NBT; i += 512) { const int hh = i / NBT, d = BT0 - (i - hh * NBT); btab[i] = rb[t5_bucket(d > 0 ? d : 0) * 8 + hh] * LOG2E; }
    __syncthreads();
}
__device__ __forceinline__ void attn_item(Frame& F, int b, int g, int qb) {
    const int tid = F.tid, lane = F.lane, w = F.wave, r32 = lane & 31, hi = lane >> 5, qi = r32 >> 2, r = r32 & 3;
    const int t0 = qb * 64, tl = 8 * w + qi, tpos = t0 + tl;
    ATP(F, 0);
    LAS unsigned char* lds = F.lds;
    const unsigned lds0 = (unsigned)(uintptr_t)lds;
    LAS float* imp = (LAS float*)(lds + L_IMP);
    LAS float* btab = (LAS float*)(lds + L_BTAB);
    LAS float* wsf = (LAS float*)(lds + L_WSF) + w * 64;
    LAS unsigned* selm = (LAS unsigned*)(lds + L_SELM);
    LAS unsigned* uni = (LAS unsigned*)(lds + L_UNI);
    const bf16* KVb = (const bf16*)(F.ws + WS_KV);
    const size_t bgoff = (size_t)(b * 2 + g) * 8192 * 64;
    const bf16* ksb = KVb + 2 * KV_TENS + bgoff; const bf16* vsb = KVb + 3 * KV_TENS + bgoff;
    const bf16* kwb = KVb + 4 * KV_TENS + bgoff; const bf16* vwb = KVb + 5 * KV_TENS + bgoff;
    const bf16* kcb = (const bf16*)(F.ws + WS_KC) + (size_t)(b * 2 + g) * 512 * 64;
    const bf16* vcb = (const bf16*)(F.ws + WS_VC) + (size_t)(b * 2 + g) * 512 * 64;
    for (int i = lane; i < 8 * IMP_STR; i += 64) imp[8 * w * IMP_STR + i] = 0.f;
    if (tid < 64) uni[tid] = 0u;
    bf16x8 qf[4];
    { const bf16* Qp = (const bf16*)(F.ws + WS_Q) + ((size_t)(b * 8192 + tpos) * 512 + (4 * g + r) * 64 + 8 * hi);
#pragma unroll
      for (int s = 0; s < 4; ++s) qf[s] = *(const GAS bf16x8*)(Qp + 16 * s); }
    float gate[3];
    { const float* gp = (const float*)(F.ws + WS_G) + (size_t)(b * 8192 + tpos) * 32 + (4 * g + r) * 3; gate[0] = gp[0]; gate[1] = gp[1]; gate[2] = gp[2]; }
    const float bfar = F.in[11][31 * 8 + 4 * g + r] * LOG2E;
    const LAS float* bt = btab + (4 * g + r) * NBT;
    LAS float* oaccp = (LAS float*)(lds + L_OACC) + w * 2048 + lane;
    asm volatile("s_waitcnt vmcnt(0)" ::: "memory");
    __syncthreads();

    ATP(F, 1);
    const int nct = (4 * qb + 3 + 63) >> 6;
    const int dcb = tpos - 31;
    const int ncfar = (t0 - 1829) >= 0 ? min(nct, (t0 - 1829) / 1024 + 1) : 0;
    SmState sc; sm_init(sc);
    f32x16 oc[2]; oc[0] = f32x16{}; oc[1] = f32x16{};
    tile_dma(kcb, vcb, false, lds0 + L_RING, w, lane);
    if (nct > 1) { tile_dma(kcb + 4096, vcb, false, lds0 + L_RING + SLOT, w, lane); ATT_WAIT_BAR(1); } else { ATT_WAIT_BAR(0); }
    for (int c = 0, sl = 0; c < nct; ++c) {
        const int sl2 = sl >= SLOT ? sl - SLOT : sl + 2 * SLOT;
        if (c + 2 < nct) tile_dma(kcb + (size_t)(c + 2) * 4096, vcb, false, lds0 + L_RING + sl2, w, lane);
        f32x16 p0, p1; qk_tile(lds + L_RING + sl, qf, c < ncfar ? bfar - sc.m : -sc.m, p0, p1, r32, hi);
        if (c >= ncfar) bias_mask<16>(p0, p1, bt, dcb - 1024 * c, hi);
        sm_rebase<false>(sc, p0, p1, oc, wsf, r32, hi);
        sc.l += exp_sum(p0, p1);
        if (c + 2 < nct) { ATT_WAIT_BAR(1); } else { ATT_WAIT_BAR(0); }
        sl = sl == 2 * SLOT ? 0 : sl + SLOT;
    }
    ATP(F, 2);
    const float lc = xhalf_sum(sc.l);
    const float ilc = lc > 0.f ? 1.0f / lc : 0.f;
    {
        tile_dma(kcb, vcb, true, lds0 + L_RING, w, lane);
        if (nct > 1) { tile_dma(kcb + 4096, vcb + 4096, true, lds0 + L_RING + SLOT, w, lane); ATT_WAIT_BAR(2); } else { ATT_WAIT_BAR(0); }
        for (int c = 0, sl = 0; c < nct; ++c) {
            const int sl2 = sl >= SLOT ? sl - SLOT : sl + 2 * SLOT;
            if (c + 2 < nct) tile_dma(kcb + (size_t)(c + 2) * 4096, vcb + (size_t)(c + 2) * 4096, true, lds0 + L_RING + sl2, w, lane);
            VFrags vf; v_read(vf, lds + L_RING + sl, lane, hi);
            f32x16 p0, p1; qk_tile(lds + L_RING + sl, qf, c < ncfar ? bfar - sc.m : -sc.m, p0, p1, r32, hi);
            if (c >= ncfar) bias_mask<16>(p0, p1, bt, dcb - 1024 * c, hi);
#pragma unroll
            for (int i = 0; i < 16; ++i) { p0[i] = __builtin_amdgcn_exp2f(p0[i]) * ilc; p1[i] = __builtin_amdgcn_exp2f(p1[i]) * ilc; }
#pragma unroll
            for (int a = 0; a < 2; ++a)
#pragma unroll
                for (int u = 0; u < 4; ++u) {
                    const float x0 = a ? p1[4 * u] : p0[4 * u], x1 = a ? p1[4 * u + 1] : p0[4 * u + 1], x2 = a ? p1[4 * u + 2] : p0[4 * u + 2], x3 = a ? p1[4 * u + 3] : p0[4 * u + 3];
                    const float mainv = quad_sum((x0 + x1) + (x2 + 0.5f * x3)), spill = quad_sum(0.5f * x3);
                    const int j = 16 * c + 8 * a + 2 * u + hi;
                    if (r == 0) { (void)__hip_atomic_fetch_add(&imp[(8 * w + qi) * IMP_STR + j], mainv, __ATOMIC_RELAXED, __HIP_MEMORY_SCOPE_WORKGROUP); if (j + 1 < 128) (void)__hip_atomic_fetch_add(&imp[(8 * w + qi) * IMP_STR + j + 1], spill, __ATOMIC_RELAXED, __HIP_MEMORY_SCOPE_WORKGROUP); }
                }
            pv_tile_pre(vf, p0, p1, oc);
            if (c + 2 < nct) { ATT_WAIT_BAR(2); } else { ATT_WAIT_BAR(0); }
            sl = sl == 2 * SLOT ? 0 : sl + SLOT;
        }
    }
    ATP(F, 3);
    for (int pass = 0; pass < 2; ++pass) {
        const int q = 8 * w + 4 * pass + (lane >> 4), t = lane & 15;
        const f32x4 va = *(const LAS f32x4*)(imp + q * IMP_STR + 8 * t), vb = *(const LAS f32x4*)(imp + q * IMP_STR + 8 * t + 4);
        unsigned key[8];
#pragma unroll
        for (int e = 0; e < 8; ++e) { const int j = 8 * t + e; const float v = e < 4 ? va[e] : vb[e - 4];
            const bool val = j <= qb, fo = (j == 0) || (j == qb) || (j == qb - 1);
            key[e] = !val ? 0u : (fo ? 0x7f000000u : __float_as_uint(v) + 1u); }
        unsigned Tt = 0u;
        for (int bit = 30; bit >= 0; --bit) {
            const unsigned cand = Tt | (1u << bit); int cnt = 0;
#pragma unroll
            for (int e = 0; e < 8; ++e) cnt += (key[e] >= cand) ? 1 : 0;
            cnt += __builtin_amdgcn_update_dpp(0, cnt, 0x128, 0xf, 0xf, true);
            cnt += __builtin_amdgcn_update_dpp(0, cnt, 0x124, 0xf, 0xf, true);
            cnt += __builtin_amdgcn_update_dpp(0, cnt, 0x122, 0xf, 0xf, true);
            cnt += __builtin_amdgcn_update_dpp(0, cnt, 0x121, 0xf, 0xf, true);
            if (cnt >= 16) Tt = cand;
        }
        int ngt = 0, neq = 0;
#pragma unroll
        for (int e = 0; e < 8; ++e) { ngt += (key[e] > Tt) ? 1 : 0; neq += (key[e] == Tt) ? 1 : 0; }
        ngt += __builtin_amdgcn_update_dpp(0, ngt, 0x128, 0xf, 0xf, true); ngt += __builtin_amdgcn_update_dpp(0, ngt, 0x124, 0xf, 0xf, true);
        ngt += __builtin_amdgcn_update_dpp(0, ngt, 0x122, 0xf, 0xf, true); ngt += __builtin_amdgcn_update_dpp(0, ngt, 0x121, 0xf, 0xf, true);
        const int need = 16 - ngt;
        int inc = neq;
        inc += __builtin_amdgcn_update_dpp(0, inc, 0x111, 0xf, 0xf, true);
        inc += __builtin_amdgcn_update_dpp(0, inc, 0x112, 0xf, 0xf, true);
        inc += __builtin_amdgcn_update_dpp(0, inc, 0x114, 0xf, 0xf, true);
        inc += __builtin_amdgcn_update_dpp(0, inc, 0x118, 0xf, 0xf, true);
        int pre = inc - neq; unsigned bits = 0u;
#pragma unroll
        for (int e = 0; e < 8; ++e) { const bool eq = key[e] == Tt; const bool sel = (key[e] != 0u) && ((key[e] > Tt) || (eq && pre < need)); pre += eq ? 1 : 0; bits |= sel ? (1u << e) : 0u; }
        unsigned word = bits << ((t & 3) * 8);
        word |= (unsigned)__builtin_amdgcn_update_dpp(0, (int)word, 0xB1, 0xf, 0xf, true);
        word |= (unsigned)__builtin_amdgcn_update_dpp(0, (int)word, 0x4E, 0xf, 0xf, true);
        if ((t & 3) == 0) { selm[q * 4 + (t >> 2)] = word; (void)__hip_atomic_fetch_or(&uni[w * 4 + (t >> 2)], word, __ATOMIC_RELAXED, __HIP_MEMORY_SCOPE_WORKGROUP); (void)__hip_atomic_fetch_or(&uni[32 + (t >> 2)], word, __ATOMIC_RELAXED, __HIP_MEMORY_SCOPE_WORKGROUP); }
    }
    __syncthreads();
    { float f[16]; row_to_regs(wsf, gate[0], f, r32, hi);
#pragma unroll
      for (int i = 0; i < 16; ++i) { oaccp[i * 64] = oc[0][i] * f[i]; oaccp[(16 + i) * 64] = oc[1][i] * f[i]; } }
    unsigned mym[4], bu[4], wuv[4];
#pragma unroll
    for (int k = 0; k < 4; ++k) { mym[k] = selm[(8 * w + qi) * 4 + k]; bu[k] = __builtin_amdgcn_readfirstlane(uni[32 + k]); wuv[k] = __builtin_amdgcn_readfirstlane(uni[w * 4 + k]); }
    ATP(F, 4);
#ifndef REP_SEL
#define REP_SEL 1
#endif
#ifndef REP_WIN
#define REP_WIN 1
#endif
#ifndef REP_CMP
#define REP_CMP 1
#endif
    for (int rep_ = 0; rep_ < REP_SEL; ++rep_) {
        f32x16 o[2]; o[0] = f32x16{}; o[1] = f32x16{}; SmState ss; sm_init(ss);
#define NEXT_SEL(from, dst) do { dst = -1; for (int j_ = (from); j_ <= qb; ++j_) if ((bu[j_ >> 5] >> (j_ & 31)) & 1u) { dst = j_; break; } } while (0)
        int j0, j1, j2;
        NEXT_SEL(0, j0); j1 = -1; j2 = -1; if (j0 >= 0) NEXT_SEL(j0 + 1, j1);
        if (j0 >= 0) tile_dma(ksb + (size_t)j0 * 4096, vsb + (size_t)j0 * 4096, true, lds0 + L_RING, w, lane);
        if (j1 >= 0) { tile_dma(ksb + (size_t)j1 * 4096, vsb + (size_t)j1 * 4096, true, lds0 + L_RING + SLOT, w, lane); ATT_WAIT_BAR(2); } else { ATT_WAIT_BAR(0); }
        int sl = 0;
        while (j0 >= 0) {
            const int sl2 = sl >= SLOT ? sl - SLOT : sl + 2 * SLOT;
            j2 = -1; if (j1 >= 0) NEXT_SEL(j1 + 1, j2);
#ifndef DMA_LATE
            if (j2 >= 0) tile_dma(ksb + (size_t)j2 * 4096, vsb + (size_t)j2 * 4096, true, lds0 + L_RING + sl2, w, lane);
#endif
            if ((wuv[j0 >> 5] >> (j0 & 31)) & 1u) {
                const bool mine = (mym[j0 >> 5] >> (j0 & 31)) & 1u;
                const bool nearj = qb - j0 < 14;
                VFrags vf; v_read(vf, lds + L_RING + sl, lane, hi);
                f32x16 p0, p1; qk_tile(lds + L_RING + sl, qf, mine ? (nearj ? -ss.m - bfar : -ss.m) : NEG_INF, p0, p1, r32, hi);
                if (nearj) bias_near_mode(p0, p1, bt + (BT0 - (tpos - 64 * j0)) + 4 * hi, tpos - 64 * j0, hi, j0 == qb ? 1 : 0);
                sm_rebase<true>(ss, p0, p1, o, wsf, r32, hi);
#ifdef EXP_PV_SPLIT
                ss.l += exp_pv(vf, p0, p1, o);
#else
                ss.l += exp_sum(p0, p1);
                pv_tile_pre(vf, p0, p1, o);
#endif
            }
#ifdef DMA_LATE
            if (j2 >= 0) tile_dma(ksb + (size_t)j2 * 4096, vsb + (size_t)j2 * 4096, true, lds0 + L_RING + sl2, w, lane);
#endif
            ATP(F, 40);
            if (j2 >= 0) { asm volatile("s_waitcnt vmcnt(2) lgkmcnt(0)" ::: "memory"); } else { asm volatile("s_waitcnt vmcnt(0) lgkmcnt(0)" ::: "memory"); }
            ATP(F, 41); ATP(F, 42);
            asm volatile("s_barrier" ::: "memory");
            ATP(F, 43);
            sl = sl == 2 * SLOT ? 0 : sl + SLOT;
            j0 = j1; j1 = j2;
        }
#undef NEXT_SEL
        const float ls = xhalf_sum(ss.l);
        float f[16]; row_to_regs(wsf, ls > 0.f ? gate[1] / (ls * REP_SEL) : 0.f, f, r32, hi);
#pragma unroll
        for (int i = 0; i < 16; ++i) { oaccp[i * 64] += o[0][i] * f[i]; oaccp[(16 + i) * 64] += o[1][i] * f[i]; }
    }
    ATP(F, 5);
    {
        f32x16 o[2]; o[0] = f32x16{}; o[1] = f32x16{}; SmState sw; sm_init(sw);
        const int jf = qb >= 8 ? qb - 8 : 0;
        tile_dma(kwb + (size_t)jf * 4096, vwb + (size_t)jf * 4096, true, lds0 + L_RING, w, lane);
        if (jf + 1 <= qb) { tile_dma(kwb + (size_t)(jf + 1) * 4096, vwb + (size_t)(jf + 1) * 4096, true, lds0 + L_RING + SLOT, w, lane); ATT_WAIT_BAR(2); } else { ATT_WAIT_BAR(0); }
        for (int j = jf, sl = 0; j <= qb; ++j) {
            const int sl2 = sl >= SLOT ? sl - SLOT : sl + 2 * SLOT;
            if (j + 2 <= qb) tile_dma(kwb + (size_t)(j + 2) * 4096, vwb + (size_t)(j + 2) * 4096, true, lds0 + L_RING + sl2, w, lane);
            VFrags vf; v_read(vf, lds + L_RING + sl, lane, hi);
            f32x16 p0, p1; qk_tile(lds + L_RING + sl, qf, -sw.m, p0, p1, r32, hi);
            bias_near_mode(p0, p1, bt + (BT0 - (tpos - 64 * j)) + 4 * hi, tpos - 64 * j, hi, j == qb ? 1 : (j == qb - 8 ? 2 : 0));
            sm_rebase<true>(sw, p0, p1, o, wsf, r32, hi);
            sw.l += exp_sum(p0, p1);
            pv_tile_pre(vf, p0, p1, o);
            if (j + 2 <= qb) { ATT_WAIT_BAR(2); } else { ATT_WAIT_BAR(0); }
            sl = sl == 2 * SLOT ? 0 : sl + SLOT;
        }
        const float lw = xhalf_sum(sw.l);
        float f[16]; row_to_regs(wsf, lw > 0.f ? gate[2] / lw : 0.f, f, r32, hi);
#pragma unroll
        for (int i = 0; i < 16; ++i) { o[0][i] = oaccp[i * 64] + o[0][i] * f[i]; o[1][i] = oaccp[(16 + i) * 64] + o[1][i] * f[i]; }
        asm volatile("" ::: "memory");
        LAS unsigned short* stg = (LAS unsigned short*)(lds + L_OACC + w * 8192);
#pragma unroll
        for (int i = 0; i < 16; ++i) { const int orow = (i & 3) + 8 * (i >> 2) + 4 * hi;
            stg[orow * 64 + r32] = (unsigned short)f2bf(o[0][i]); stg[orow * 64 + 32 + r32] = (unsigned short)f2bf(o[1][i]); }
        LDS_WAIT();
        bf16* MIX = (bf16*)(F.ws + WS_MIX);
#pragma unroll
        for (int i = 0; i < 4; ++i) { const int row = i * 8 + (lane >> 3), ch = lane & 7; const v4u v = *(const LAS v4u*)(stg + row * 64 + ch * 8);
            *(GAS v4u*)(MIX + (size_t)(b * 8192 + t0 + 8 * w + (row >> 2)) * 1024 + (4 * g + (row & 3)) * 64 + ch * 8) = v; }
    }
    __syncthreads();
    ATP(F, 6);
}
}

__device__ __forceinline__ void p4_phase(Frame& F) {
    ATP(F, 20);
    {
        const bf16* Z = (const bf16*)(F.ws + WS_Z); const bf16* BG = (const bf16*)(F.ws + WS_BG); bf16* MIX = (bf16*)(F.ws + WS_MIX);
        const float* cw = F.in[12];
        const int ch = F.tid & 63, rsub = F.tid >> 6;
        f32x4 w0a = *(const f32x4*)(cw + 8 * ch), w0b = *(const f32x4*)(cw + 8 * ch + 4), w1a = *(const f32x4*)(cw + 512 + 8 * ch), w1b = *(const f32x4*)(cw + 512 + 8 * ch + 4), w2a = *(const f32x4*)(cw + 1024 + 8 * ch), w2b = *(const f32x4*)(cw + 1024 + 8 * ch + 4);
        for (int rb = blockIdx.x; rb < M / 8; rb += F.G) {
            const int row = 8 * rb + rsub, t = row & 8191;
            const v4u z2 = *(const GAS v4u*)(Z + (size_t)row * 512 + 8 * ch);
            v4u z1 = (v4u){0u, 0u, 0u, 0u}, z0 = (v4u){0u, 0u, 0u, 0u};
            if (t >= 1) z1 = *(const GAS v4u*)(Z + (size_t)(row - 1) * 512 + 8 * ch);
            if (t >= 2) z0 = *(const GAS v4u*)(Z + (size_t)(row - 2) * 512 + 8 * ch);
            const v4u bg = *(const GAS v4u*)(BG + (size_t)row * 512 + 8 * ch);
            float o[8];
#define CV(k, comp, sh, wa, wi) o[k] = bf2f((unsigned short)((bg.comp >> sh) & 0xffff)) * (w0##wa[wi] * bf2f((unsigned short)((z0.comp >> sh) & 0xffff)) + w1##wa[wi] * bf2f((unsigned short)((z1.comp >> sh) & 0xffff)) + w2##wa[wi] * bf2f((unsigned short)((z2.comp >> sh) & 0xffff)))
            CV(0, x, 0, a, 0); CV(1, x, 16, a, 1); CV(2, y, 0, a, 2); CV(3, y, 16, a, 3); CV(4, z, 0, b, 0); CV(5, z, 16, b, 1); CV(6, w, 0, b, 2); CV(7, w, 16, b, 3);
#undef CV
            v4u ov; ov.x = pk2(o[0], o[1]); ov.y = pk2(o[2], o[3]); ov.z = pk2(o[4], o[5]); ov.w = pk2(o[6], o[7]);
            *(GAS v4u*)(MIX + (size_t)row * 1024 + 512 + 8 * ch) = ov;
        }
    }
    asm volatile("s_waitcnt vmcnt(0)" ::: "memory");
    ATP(F, 21);
    att::build_btab(F);
    if (F.G == 256) {
        static constexpr unsigned char QBTAB[128] = {118,92,63,0,113,98,58,1,114,91,60,2,125,81,57,4,112,84,64,3,126,69,61,6,127,70,62,5,122,74,56,7,115,67,55,14,124,66,54,12,121,73,53,9,123,68,51,13,120,76,52,8,119,75,50,11,108,79,44,18,116,78,43,16,107,71,48,21,110,77,46,17,111,72,47,19,109,82,45,15,117,65,49,20,103,101,42,10,97,87,41,22,104,83,37,24,102,80,36,28,106,59,40,38,100,86,35,26,105,96,27,25,99,85,39,23,93,90,34,29,94,89,33,30,95,88,32,31};
        const int bg = blockIdx.x & 7, s_ = blockIdx.x >> 3;
#pragma unroll 1
        for (int i = 0; i < 4; ++i) att::attn_item(F, bg >> 1, bg & 1, (int)QBTAB[4 * s_ + i]);
    } else {
        for (int rd = 0; rd * F.G < 1024; ++rd) {
            const int pos = (rd & 1) ? (F.G - 1 - (int)blockIdx.x) : (int)blockIdx.x;
            const int k = rd * F.G + pos; if (k >= 1024) continue;
            att::attn_item(F, (k & 7) >> 1, k & 1, 127 - (k >> 3));
        }
    }
}

struct Args { const float* in[20]; float* out; unsigned char* ws; int ph_lo, ph_hi; };
__global__ void __launch_bounds__(NWAVES * 64, 2) mk_fwd(Args args) {
    extern __shared__ __attribute__((aligned(16))) unsigned char lds[];
    Frame F;
    F.lds = (LAS unsigned char*)lds;
    F.MISC = (volatile LAS unsigned*)(F.lds + MISC_OFF);
    F.tid = threadIdx.x; F.lane = F.tid & 63; F.wave = __builtin_amdgcn_readfirstlane(F.tid >> 6);
    F.G = gridDim.x; { const int bx = blockIdx.x; F.vcu = (F.G % 8 == 0) ? (bx % 8) * (F.G / 8) + bx / 8 : bx; }
    F.tp_t0 = 0; F.tp_acc = 0; F.ws = args.ws; F.out = args.out; F.ctl = (gu32*)(args.ws + WS_CTL);
#pragma unroll
    for (int i = 0; i < 20; ++i) F.in[i] = args.in[i];
    for (int u = F.tid; u < (LDS_BYTES - LDSCTL_OFF) / 4; u += NWAVES * 64) ((LAS unsigned*)(F.lds + LDSCTL_OFF))[u] = 0u;
    __syncthreads();
    const int lo = args.ph_lo, hi = args.ph_hi;
    const bool one = (hi - lo) > 1;
    XcdBarrier bar; bar.bar = (unsigned*)(F.ctl + CW_BAR); bar.x = 0; bar.st = nullptr;
    if (one) bar = xcd_barrier_post((unsigned*)(F.ctl + CW_BAR), F.MISC + 8);
#ifdef ONLY_PHASE
#define IN(k) ((k) == ONLY_PHASE && lo <= (k) && (k) < hi)
#else
#define IN(k) (lo <= (k) && (k) < hi)
#endif
#ifndef REP_MASK
#define REP_MASK 0
#endif
#define REPS(k) for (int rep_ = 0; rep_ < 1 + ((REP_MASK >> (k)) & 1); ++rep_)
#define SEAM(k) do { if (IN(k) && IN((k) + 1)) xcd_barrier(bar); } while (0)
    unsigned char* ws = args.ws;
#ifdef PROBE_PHASE
    unsigned long long tp0_ = 0, tp1_ = 0;
#define TPS(k) do { if ((k) == PROBE_PHASE) tp0_ = __builtin_amdgcn_s_memrealtime(); if ((k) == PROBE_END) tp1_ = __builtin_amdgcn_s_memrealtime(); } while (0)
#else
#define TPS(k) do {} while (0)
#endif
    TPS(0);
    if (IN(0)) { REPS(0) p0_phase(F); ATP(F, 62); SEAM(0); ATP(F, 63); }
    TPS(1);
    if (IN(1)) { REPS(1) p1_phase(F); SEAM(1); }
#ifdef XTRA_BAR
    for (int xb_ = 0; xb_ < XTRA_BAR; ++xb_) xcd_barrier(bar);
#endif
    TPS(2);
    if (IN(2)) {
        pg8::Gemm g{(const pg8::bf16_t*)(ws + WS_H), (const pg8::bf16_t*)(ws + WS_WIN), M, NIN, D}; pg8::StaticOrder S; S.init(M, NIN, F.G, (int)blockIdx.x);
        pg8::EpiInProj E{(pg8::bf16_t*)(ws + WS_Q), (pg8::bf16_t*)(ws + WS_KV), (pg8::bf16_t*)(ws + WS_Z), (pg8::bf16_t*)(ws + WS_BG), (float*)(ws + WS_G), F.in[3], F.in[4]};
        pg8::gemm_phase<pg8::EpiInProj, pg8::StaticOrder, true, true>(F.lds, g, S, E);
#ifdef DUP_P2
        pg8::gemm_phase<pg8::EpiInProj, pg8::StaticOrder, true, true>(F.lds, g, S, E);
#endif
        SEAM(2);
    }
    TPS(3);
    if (IN(3)) { REPS(3) p3_phase(F); SEAM(3); }
    TPS(4);
    if (IN(4)) { REPS(4) p4_phase(F); ATP(F, 50); SEAM(4); ATP(F, 51); }
    TPS(5);
    if (IN(5)) {
        pg8::Gemm g{(const pg8::bf16_t*)(ws + WS_MIX), (const pg8::bf16_t*)(ws + WS_WOUT), M, D, D}; pg8::StaticOrder S; S.init(M, D, F.G, (int)blockIdx.x);
        pg8::EpiOutProj E{F.in[0], (pg8::bf16_t*)(ws + WS_X1B), (pg8::bf16_t*)(ws + WS_A2), (float*)(ws + WS_RSS), (const float*)(ws + WS_MOD), F.in[15]};
        REPS(5) pg8::gemm_phase<pg8::EpiOutProj, pg8::StaticOrder, true, true>(F.lds, g, S, E);
        SEAM(5);
    }
    TPS(6);
    if (IN(6)) {
        pg8::Gemm g{(const pg8::bf16_t*)(ws + WS_A2), (const pg8::bf16_t*)(ws + WS_W1), M, FF, D}; pg8::StaticOrder S; S.init(M, FF, F.G, (int)blockIdx.x);
        pg8::EpiFF1 E{(pg8::bf16_t*)(ws + WS_HID), (const float*)(ws + WS_RSS), (const float*)(ws + WS_BFF1)};
        REPS(6) pg8::gemm_phase<pg8::EpiFF1, pg8::StaticOrder, true, true>(F.lds, g, S, E);
        SEAM(6);
    }
    TPS(7);
    if (IN(7)) {
        pg8::Gemm g{(const pg8::bf16_t*)(ws + WS_HID), (const pg8::bf16_t*)(ws + WS_W2), M, D, FF}; pg8::StaticOrder S; S.init(M, D, F.G, (int)blockIdx.x);
#ifdef DUP_P7
        { pg8::EpiFF2 E0{(const pg8::bf16_t*)(ws + WS_X1B), (const float*)(ws + WS_MOD), (float*)(ws + (size_t)100 * MiB)};
          pg8::gemm_phase<pg8::EpiFF2, pg8::StaticOrder, true, true>(F.lds, g, S, E0); }
#endif
        pg8::EpiFF2 E{(const pg8::bf16_t*)(ws + WS_X1B), (const float*)(ws + WS_MOD), F.out};
        pg8::gemm_phase<pg8::EpiFF2, pg8::StaticOrder, true, true>(F.lds, g, S, E);
    }
    TPS(8);
#ifndef PROBE_BLK
#define PROBE_BLK 0
#endif
#ifdef ATP_A
    if (blockIdx.x == PROBE_BLK && F.tid == 0) { const unsigned long long until = __builtin_amdgcn_s_memrealtime() + (unsigned long long)ATP_MULT * F.tp_acc;
        while (__builtin_amdgcn_s_memrealtime() < until) __builtin_amdgcn_s_sleep(8); }
#endif
#ifdef PROBE_PHASE
    if (blockIdx.x == 0 && F.tid == 0) { const unsigned long long until = __builtin_amdgcn_s_memrealtime() + (unsigned long long)PROBE_MULT * (tp1_ - tp0_);
        while (__builtin_amdgcn_s_memrealtime() < until) __builtin_amdgcn_s_sleep(8); }
#endif
#undef IN
#undef SEAM
}

extern "C" void kernel_launch(void* const* d_in, const int* in_sizes, int n_in, void* d_out, int out_size, void* d_ws, size_t ws_size, hipStream_t stream) {
    static int grid = 0;
    if (grid == 0) {
        if (n_in != 20 || in_sizes[0] != M * D || out_size != M * D || ws_size < WS_END) { fprintf(stderr, "kernel_launch: unexpected problem shape (n_in %d, in0 %d, out %d, ws %zu)\n", n_in, n_in > 0 ? in_sizes[0] : -1, out_size, ws_size); grid = -1; return; }
        int dev = 0, cus = 0, per_cu = 0;
        if (hipGetDevice(&dev) != hipSuccess || hipDeviceGetAttribute(&cus, hipDeviceAttributeMultiprocessorCount, dev) != hipSuccess) { grid = -1; return; }
        if (hipFuncSetAttribute((const void*)mk_fwd, hipFuncAttributeMaxDynamicSharedMemorySize, LDS_BYTES) != hipSuccess) { fprintf(stderr, "kernel_launch: hipFuncSetAttribute failed\n"); grid = -1; return; }
        if (hipOccupancyMaxActiveBlocksPerMultiprocessor(&per_cu, (const void*)mk_fwd, NWAVES * 64, LDS_BYTES) != hipSuccess || per_cu < 1) { fprintf(stderr, "kernel_launch: occupancy query says %d blocks per CU\n", per_cu); (void)hipGetLastError(); per_cu = 1; }
        grid = cus * 1;
        if (per_cu < 1) grid = -1;
    }
    if (grid < 0) return;
    (void)hipMemsetAsync((char*)d_ws + WS_CTL, 0, CTL_ZERO_BYTES, stream);
    Args a{};
    for (int i = 0; i < 20; ++i) a.in[i] = (const float*)d_in[i];
    a.out = (float*)d_out; a.ws = (unsigned char*)d_ws;
    if (MK_N_LAUNCHES == 1) {
        a.ph_lo = 0; a.ph_hi = N_PHASES;
        void* kargs[] = {&a};
        hipError_t e = hipLaunchCooperativeKernel((const void*)mk_fwd, dim3(grid), dim3(NWAVES * 64), kargs, LDS_BYTES, stream);
        if (e != hipSuccess) fprintf(stderr, "kernel_launch: cooperative launch failed: %s (grid %d)\n", hipGetErrorString(e), grid);
    } else {
        for (int p = 0; p < N_PHASES; ++p) { a.ph_lo = p; a.ph_hi = p + 1; hipLaunchKernelGGL(mk_fwd, dim3(grid), dim3(NWAVES * 64), LDS_BYTES, stream, a); }
    }
}
```

```cpp
#include <hip/hip_runtime.h>
#include <hip/hip_bf16.h>
#include <cstdio>
#include <cstdint>
#include <cmath>
namespace pg8 {
#define PG8_LAS __attribute__((address_space(3)))
typedef unsigned short bf16_t;
typedef short bf16x8 __attribute__((ext_vector_type(8)));
typedef float f32x4 __attribute__((ext_vector_type(4)));
typedef unsigned u32x4 __attribute__((ext_vector_type(4)));
constexpr int BM = 256, BK = 64, HALF = 128, HTB = HALF * BK * 2  , STAGE_BYTES = 8 * HTB, NXCD = 8, WGM = 8;

__host__ __device__ __forceinline__ int lds_byte(int r, int c) { const int st = (r >> 4) * 2 + (c >> 5), rr = r & 15, cc = c & 31, ob = rr * 64 + cc * 2; return st * 1024 + (ob ^ (((ob >> 9) & 1) << 5)); }
__host__ __device__ __forceinline__ void stage_rc(int b, int& R, int& C) { const int st = b / 1024, sb = b % 1024, swz = sb ^ (((sb >> 9) & 1) << 5); R = (st >> 1) * 16 + swz / 64; C = (st & 1) * 32 + (swz % 64) / 2; }
__host__ __device__ __forceinline__ int perm32(int rho) { const int n = rho >> 4, i = rho & 15; return 8 * (i >> 2) + 4 * n + (i & 3); }

struct Unit { int pm, pn; };
struct Gemm { const bf16_t* A; const bf16_t* Bt; int M, N, K; };

struct StaticOrder {
    int nM, nN, nwg, G, c;
    __host__ __device__ void init(int M, int N, int G_, int c_) { nM = M / BM; nN = N / BM; nwg = nM * nN; G = G_; c = c_; }
    __host__ __device__ bool next(int i, Unit& u) const {
        const long L = (long)i * G + c; if (L >= nwg) return false;
        int wgid = (int)L; { const int q = nwg / NXCD, r = nwg % NXCD, xcd = wgid % NXCD, off = wgid / NXCD; wgid = (xcd < r ? xcd * (q + 1) : r * (q + 1) + (xcd - r) * q) + off; }
        const int nig = WGM * nN, gid = wgid / nig, fm = gid * WGM, gsz = (nM - fm) < WGM ? (nM - fm) : WGM;
        u.pm = fm + ((wgid % nig) % gsz); u.pn = (wgid % nig) / gsz; return true;
    }
    __device__ __forceinline__ void a_ready(const Unit&) const {}
    __device__ __forceinline__ void done(const Unit&) const {}
};

__device__ __forceinline__ unsigned cvt_pk_bf16(float lo, float hi) { unsigned r; asm volatile("v_cvt_pk_bf16_f32 %0, %1, %2" : "=v"(r) : "v"(lo), "v"(hi)); return r; }
typedef float f32x2 __attribute__((ext_vector_type(2)));
template <class Epi, class Sched, bool ALIGN_EPI = false, bool SP2 = false>
__device__ __forceinline__ void gemm_phase(PG8_LAS unsigned char* lds, const Gemm g, const Sched& S, const Epi& E) {
    const int tid = threadIdx.x, wid = __builtin_amdgcn_readfirstlane(tid >> 6), lane = tid & 63, wr = wid >> 2, wc = wid & 3, fr = lane & 15, fq = lane >> 4;
    const int K = g.K, nt = K / BK;
    unsigned voffA[2], voffB[2];
#pragma unroll
    for (int i = 0; i < 2; ++i) { int R, C; stage_rc(tid * 16 + i * 8192, R, C); const int Rb = Epi::PERM ? ((R & ~31) + perm32(R & 31)) : R;
        voffA[i] = (unsigned)(R * K + C) * 2u; voffB[i] = (unsigned)(Rb * K + C) * 2u; }
    const size_t kstep = (size_t)(BK * 2);
    const size_t hstep = (size_t)HALF * K * 2;
    const size_t tstep = 2 * hstep;
    const unsigned ldsw = (unsigned)wid * 1024u;
    const int aoff = lds_byte(wr * 64 + fr, fq * 8), boff = lds_byte(wc * 32 + fr, fq * 8);
#define PG8_SA(b, h) (((b) * 2 + (h)) * HTB)
#define PG8_SB(b, h) ((4 + (b) * 2 + (h)) * HTB)
#define PG8_STAGE(bufoff, gbase, voff) do { _Pragma("unroll") for (int _i = 0; _i < 2; ++_i) \
        __builtin_amdgcn_global_load_lds((const unsigned*)((const char*)(gbase) + (voff)[_i]), (PG8_LAS unsigned*)(lds + (bufoff) + ldsw + _i * 8192), 16, 0, 0); } while (0)
#define PG8_LDA(dst, b, h) do { _Pragma("unroll") for (int m = 0; m < 4; ++m) _Pragma("unroll") for (int k = 0; k < 2; ++k) dst[m][k] = *(const PG8_LAS bf16x8*)(lds + PG8_SA(b, h) + aoff + m * 2048 + k * 1024); } while (0)
#define PG8_LDB(dst, b, h) do { _Pragma("unroll") for (int n = 0; n < 2; ++n) _Pragma("unroll") for (int k = 0; k < 2; ++k) dst[n][k] = *(const PG8_LAS bf16x8*)(lds + PG8_SB(b, h) + boff + n * 2048 + k * 1024); } while (0)
#define PG8_MMA(ai, bj, At, Bt) do { __builtin_amdgcn_s_setprio(1); _Pragma("unroll") for (int m = 0; m < 4; ++m) _Pragma("unroll") for (int n = 0; n < 2; ++n) _Pragma("unroll") for (int k = 0; k < 2; ++k) \
        acc[ai][bj][m][n] = __builtin_amdgcn_mfma_f32_16x16x32_bf16(Bt[n][k], At[m][k], acc[ai][bj][m][n], 0, 0, 0); __builtin_amdgcn_s_setprio(0); } while (0)
#define PG8_WAIT_V(n) asm volatile("s_waitcnt vmcnt(" #n ")" ::: "memory")
#define PG8_WAIT_L(n) asm volatile("s_waitcnt lgkmcnt(" #n ")" ::: "memory")
#define PG8_BAR __builtin_amdgcn_s_barrier()
#define PG8_SCHED __builtin_amdgcn_sched_barrier(0)
    Unit cur, nxt; int ui = 0;
    if (!S.next(0, cur)) return;
    f32x4 acc[2][2][4][2];
#pragma unroll
    for (int a = 0; a < 2; ++a)
#pragma unroll
        for (int b = 0; b < 2; ++b)
#pragma unroll
            for (int m = 0; m < 4; ++m)
#pragma unroll
                for (int n = 0; n < 2; ++n) acc[a][b][m][n] = (f32x4){0.f, 0.f, 0.f, 0.f};
    bf16x8 At[4][2], B0[2][2], B1[2][2];
    const char* cA = (const char*)g.A + (size_t)cur.pm * tstep; const char* cB = (const char*)g.Bt + (size_t)cur.pn * tstep;
    S.a_ready(cur);
    if constexpr (SP2) {
        PG8_STAGE(PG8_SB(0, 0), cB, voffB); PG8_STAGE(PG8_SB(0, 1), cB + hstep, voffB); PG8_STAGE(PG8_SA(0, 0), cA, voffA); PG8_STAGE(PG8_SA(0, 1), cA + hstep, voffA);
        if (wr == 1) PG8_BAR;
        PG8_WAIT_V(2); PG8_BAR;
        PG8_STAGE(PG8_SB(1, 0), cB + kstep, voffB); PG8_STAGE(PG8_SA(1, 0), cA + kstep, voffA); PG8_STAGE(PG8_SB(1, 1), cB + hstep + kstep, voffB);
        PG8_WAIT_V(6); PG8_BAR;
    } else {
        PG8_STAGE(PG8_SB(0, 0), cB, voffB); PG8_STAGE(PG8_SA(0, 0), cA, voffA); PG8_STAGE(PG8_SB(0, 1), cB + hstep, voffB); PG8_STAGE(PG8_SA(0, 1), cA + hstep, voffA);
        if (wr == 1) PG8_BAR;
        PG8_WAIT_V(4); PG8_BAR;
        PG8_STAGE(PG8_SB(1, 0), cB + kstep, voffB); PG8_STAGE(PG8_SA(1, 0), cA + kstep, voffA); PG8_STAGE(PG8_SB(1, 1), cB + hstep + kstep, voffB);
        PG8_WAIT_V(6); PG8_BAR;
    }
    for (;;) {
        const bool has_next = S.next(ui + 1, nxt);
        const char* nA = has_next ? (const char*)g.A + (size_t)nxt.pm * tstep : cA; const char* nB = has_next ? (const char*)g.Bt + (size_t)nxt.pn * tstep : cB;
        for (int t = 0; t < nt; t += 2) {
            const bool last = (t == nt - 2);
            const char* a1 = cA + (size_t)(t + 1) * kstep;
            const char* a2 = last ? nA : cA + (size_t)(t + 2) * kstep; const char* b2 = last ? nB : cB + (size_t)(t + 2) * kstep;
            const char* a3 = a2 + kstep; const char* b3 = b2 + kstep;
            if (last && has_next) S.a_ready(nxt);
            if constexpr (SP2) {
            PG8_LDB(B0, 0, 0); PG8_LDB(B1, 0, 1); PG8_SCHED; PG8_LDA(At, 0, 0); PG8_STAGE(PG8_SA(1, 1), a1 + hstep, voffA);
            PG8_WAIT_V(8); PG8_WAIT_L(0); PG8_BAR; PG8_MMA(0, 0, At, B0); PG8_MMA(0, 1, At, B1); PG8_BAR; PG8_SCHED;
            PG8_LDA(At, 0, 1); PG8_STAGE(PG8_SB(0, 0), b2, voffB); PG8_STAGE(PG8_SB(0, 1), b2 + hstep, voffB); PG8_STAGE(PG8_SA(0, 0), a2, voffA);
            PG8_WAIT_V(8); PG8_WAIT_L(0); PG8_BAR; PG8_MMA(1, 0, At, B0); PG8_MMA(1, 1, At, B1); PG8_BAR; PG8_SCHED;
            PG8_LDB(B0, 1, 0); PG8_LDB(B1, 1, 1); PG8_SCHED; PG8_LDA(At, 1, 0); PG8_STAGE(PG8_SA(0, 1), a2 + hstep, voffA);
            PG8_WAIT_V(8); PG8_WAIT_L(0); PG8_BAR; PG8_MMA(0, 0, At, B0); PG8_MMA(0, 1, At, B1); PG8_BAR; PG8_SCHED;
            PG8_LDA(At, 1, 1); PG8_STAGE(PG8_SB(1, 0), b3, voffB); PG8_STAGE(PG8_SB(1, 1), b3 + hstep, voffB); PG8_STAGE(PG8_SA(1, 0), a3, voffA);
            PG8_WAIT_V(8); PG8_WAIT_L(0); PG8_BAR; PG8_MMA(1, 0, At, B0); PG8_MMA(1, 1, At, B1); PG8_BAR; PG8_SCHED;
            } else {
            PG8_LDB(B0, 0, 0); PG8_SCHED; PG8_LDA(At, 0, 0); PG8_STAGE(PG8_SA(1, 1), a1 + hstep, voffA);
            PG8_WAIT_L(8); PG8_BAR; PG8_WAIT_L(0); PG8_MMA(0, 0, At, B0); PG8_BAR; PG8_SCHED;
            PG8_LDB(B1, 0, 1); PG8_STAGE(PG8_SB(0, 0), b2, voffB);
            PG8_BAR; PG8_WAIT_L(0); PG8_MMA(0, 1, At, B1); PG8_BAR;
            PG8_LDA(At, 0, 1); PG8_STAGE(PG8_SA(0, 0), a2, voffA);
            PG8_BAR; PG8_WAIT_L(0); PG8_MMA(1, 0, At, B0); PG8_BAR; PG8_SCHED;
            PG8_STAGE(PG8_SB(0, 1), b2 + hstep, voffB);
            PG8_WAIT_V(6); PG8_BAR; PG8_MMA(1, 1, At, B1); PG8_BAR;
            PG8_LDB(B0, 1, 0); PG8_SCHED; PG8_LDA(At, 1, 0); PG8_STAGE(PG8_SA(0, 1), a2 + hstep, voffA);
            PG8_WAIT_L(8); PG8_BAR; PG8_WAIT_L(0); PG8_MMA(0, 0, At, B0); PG8_BAR; PG8_SCHED;
            PG8_LDB(B1, 1, 1); PG8_STAGE(PG8_SB(1, 0), b3, voffB);
            PG8_BAR; PG8_WAIT_L(0); PG8_MMA(0, 1, At, B1); PG8_BAR;
            PG8_LDA(At, 1, 1); PG8_STAGE(PG8_SA(1, 0), a3, voffA);
            PG8_BAR; PG8_WAIT_L(0); PG8_MMA(1, 0, At, B0); PG8_BAR; PG8_SCHED;
            PG8_STAGE(PG8_SB(1, 1), b3 + hstep, voffB);
            PG8_WAIT_V(6); PG8_BAR; PG8_MMA(1, 1, At, B1); PG8_BAR;
            }
        }
        if constexpr (ALIGN_EPI) { if (wr == 0) PG8_BAR; }
        if constexpr (!Epi::AFTER_DRAIN) { E(acc, cur, wr, wc, fr, fq); S.done(cur); }
        if (!has_next) break;
#pragma unroll
        for (int a = 0; a < 2; ++a)
#pragma unroll
            for (int b = 0; b < 2; ++b)
#pragma unroll
                for (int m = 0; m < 4; ++m)
#pragma unroll
                    for (int n = 0; n < 2; ++n) acc[a][b][m][n] = (f32x4){0.f, 0.f, 0.f, 0.f};
        cur = nxt; cA = nA; cB = nB; ++ui;
        if constexpr (ALIGN_EPI) { if (wr == 1) PG8_BAR; }
    }
    PG8_WAIT_V(0);
    if constexpr (!ALIGN_EPI) { if (wr == 0) PG8_BAR; }
    PG8_BAR;
    if constexpr (Epi::AFTER_DRAIN) { E.fused(acc, cur, wr, wc, fr, fq, lds, wid, lane); S.done(cur); }
#undef PG8_SA
#undef PG8_SB
#undef PG8_STAGE
#undef PG8_LDA
#undef PG8_LDB
#undef PG8_MMA
#undef PG8_WAIT_V
#undef PG8_WAIT_L
#undef PG8_BAR
#undef PG8_SCHED
}
}
namespace pg8 {
__device__ __forceinline__ void st16_wt(void* p, u32x4 v) {
#ifdef USE_WT_STORES
    asm volatile("global_store_dwordx4 %0, %1, off sc1\n\ts_nop 1" :: "v"(p), "v"(v) : "memory");
#else
    *(u32x4*)p = v;
#endif
}
__device__ __forceinline__ u32x4 pack8(const f32x4 a, const f32x4 b) { u32x4 w; w.x = cvt_pk_bf16(a[0], a[1]); w.y = cvt_pk_bf16(a[2], a[3]); w.z = cvt_pk_bf16(b[0], b[1]); w.w = cvt_pk_bf16(b[2], b[3]); return w; }

struct EpiInProj {
    static constexpr bool PERM = true, AFTER_DRAIN = false;
    bf16_t* Q; bf16_t* KV; bf16_t* Z; bf16_t* BG; float* G; const float* qn; const float* kn;
    __device__ __forceinline__ void operator()(const f32x4 (&acc)[2][2][4][2], const Unit& u, int wr, int wc, int fr, int fq) const {
        const int pn = u.pn; const int row0 = u.pm * BM + wr * 64 + fr;
        if (pn <= 4) {
            const bool donorm = (pn < 2) || (pn >= 3 && wc < 2);
            const float* nw = (pn < 2) ? qn : kn;
            const float sc = (pn < 2) ? (0.125f * 1.4426950408889634f) : 1.0f;
            f32x4 w4[2][2];
#pragma unroll
            for (int bj = 0; bj < 2; ++bj)
#pragma unroll
                for (int n = 0; n < 2; ++n) { f32x4 t = *(const f32x4*)(nw + 32 * bj + 8 * fq + 4 * n); w4[bj][n] = donorm ? t * sc : (f32x4){1.f, 1.f, 1.f, 1.f}; }
            bf16_t* base; size_t rstride;
            if (pn < 2) { base = Q + (4 * pn + wc) * 64 + 8 * fq; rstride = 512; }
            else { const int ti = (pn - 2) * 2 + (wc >> 1), g = wc & 1; base = KV + (size_t)ti * ((size_t)4 * 2 * 8192 * 64) + 8 * fq; rstride = 64;
                   base += (size_t)g * 8192 * 64; }
#pragma unroll
            for (int ai = 0; ai < 2; ++ai)
#pragma unroll
                for (int m = 0; m < 4; ++m) {
                    const int r = row0 + ai * HALF + m * 16;
                    float rs = 1.f;
                    if (donorm) {
                        float ss = 0.f;
#pragma unroll
                        for (int bj = 0; bj < 2; ++bj)
#pragma unroll
                            for (int n = 0; n < 2; ++n) { const f32x4 x = acc[ai][bj][m][n]; ss += (x[0] * x[0] + x[1] * x[1]) + (x[2] * x[2] + x[3] * x[3]); }
                        ss += __shfl_xor(ss, 16); ss += __shfl_xor(ss, 32);
                        rs = 1.0f / sqrtf(ss * (1.0f / 64.0f) + 1e-6f);
                    }
                    size_t off;
                    if (pn < 2) off = (size_t)r * 512;
                    else { const int b = r >> 13, t = r & 8191; off = ((size_t)(b * 2) * 8192 + t) * 64; }
#pragma unroll
                    for (int bj = 0; bj < 2; ++bj) {
                        const f32x4 v0 = acc[ai][bj][m][0] * rs * w4[bj][0], v1 = acc[ai][bj][m][1] * rs * w4[bj][1];
                        st16_wt(base + off + 32 * bj, pack8(v0, v1));
                    }
                }
        } else if (pn <= 8) {
            bf16_t* base = Z + 128 * (pn - 5) + 32 * wc + 8 * fq;
#pragma unroll
            for (int ai = 0; ai < 2; ++ai)
#pragma unroll
                for (int m = 0; m < 4; ++m) {
                    const int r = row0 + ai * HALF + m * 16;
                    const f32x4 v0 = acc[ai][0][m][0] * acc[ai][1][m][0], v1 = acc[ai][0][m][1] * acc[ai][1][m][1];
                    st16_wt(base + (size_t)r * 512, pack8(v0, v1));
                }
        } else if (pn <= 10) {
            bf16_t* base = BG + 256 * (pn - 9) + 32 * wc + 8 * fq;
#pragma unroll
            for (int ai = 0; ai < 2; ++ai)
#pragma unroll
                for (int m = 0; m < 4; ++m) {
                    const int r = row0 + ai * HALF + m * 16;
#pragma unroll
                    for (int bj = 0; bj < 2; ++bj) st16_wt(base + (size_t)r * 512 + 128 * bj, pack8(acc[ai][bj][m][0], acc[ai][bj][m][1]));
                }
        } else {
            if (wc == 0 && fq < 3) {
#pragma unroll
                for (int ai = 0; ai < 2; ++ai)
#pragma unroll
                    for (int m = 0; m < 4; ++m) {
                        const int r = row0 + ai * HALF + m * 16;
#pragma unroll
                        for (int n = 0; n < 2; ++n) { const f32x4 x = acc[ai][0][m][n]; f32x4 s;
#pragma unroll
                            for (int e = 0; e < 4; ++e) s[e] = 1.0f / (1.0f + __expf(-x[e]));
                            *(f32x4*)(G + (size_t)r * 32 + 8 * fq + 4 * n) = s; }
                    }
            }
        }
    }
};

struct EpiOutProj {
    static constexpr bool PERM = true, AFTER_DRAIN = false;
    const float* x; bf16_t* X1B; bf16_t* A2; float* RSS; const float* mod; const float* n2;
    __device__ __forceinline__ void operator()(const f32x4 (&acc)[2][2][4][2], const Unit& u, int wr, int wc, int fr, int fq) const {
        const int row0 = u.pm * BM + wr * 64 + fr; const int b = (u.pm * BM) >> 13;
        const int col0 = u.pn * BM + wc * 32 + 8 * fq;
        f32x4 g1[2][2], a2[2][2];
#pragma unroll
        for (int bj = 0; bj < 2; ++bj)
#pragma unroll
            for (int n = 0; n < 2; ++n) { const int c = col0 + 128 * bj + 4 * n;
                g1[bj][n] = *(const f32x4*)(mod + (size_t)b * 6144 + 2 * 1024 + c);
                const f32x4 s2 = *(const f32x4*)(mod + (size_t)b * 6144 + 4 * 1024 + c), nn = *(const f32x4*)(n2 + c);
                a2[bj][n] = nn * (s2 + 1.0f); }
#pragma unroll
        for (int ai = 0; ai < 2; ++ai)
#pragma unroll
          for (int mh = 0; mh < 2; ++mh) {
            f32x4 xv[2][2][2];
#pragma unroll
            for (int mm = 0; mm < 2; ++mm)
#pragma unroll
                for (int bj = 0; bj < 2; ++bj) { const size_t off = (size_t)(row0 + ai * HALF + (2 * mh + mm) * 16) * 1024 + col0 + 128 * bj; xv[mm][bj][0] = *(const f32x4*)(x + off); xv[mm][bj][1] = *(const f32x4*)(x + off + 4); }
#pragma unroll
            for (int mm = 0; mm < 2; ++mm)
#pragma unroll
                for (int bj = 0; bj < 2; ++bj) asm volatile("" : "+v"(xv[mm][bj][0]), "+v"(xv[mm][bj][1]));
#pragma unroll
            for (int mm = 0; mm < 2; ++mm) {
                const int m = 2 * mh + mm;
                const int r = row0 + ai * HALF + m * 16; float ss = 0.f;
#pragma unroll
                for (int bj = 0; bj < 2; ++bj) {
                    const size_t off = (size_t)r * 1024 + col0 + 128 * bj;
                    const f32x4 ya = xv[mm][bj][0] + g1[bj][0] * acc[ai][bj][m][0], yb = xv[mm][bj][1] + g1[bj][1] * acc[ai][bj][m][1];
                    st16_wt(X1B + off, pack8(ya, yb));
                    ss += (ya[0] * ya[0] + ya[1] * ya[1]) + (ya[2] * ya[2] + ya[3] * ya[3]) + (yb[0] * yb[0] + yb[1] * yb[1]) + (yb[2] * yb[2] + yb[3] * yb[3]);
                    st16_wt(A2 + off, pack8(ya * a2[bj][0], yb * a2[bj][1]));
                }
                ss += __shfl_xor(ss, 16); ss += __shfl_xor(ss, 32);
                if (fq == 0) RSS[(size_t)r * 16 + u.pn * 4 + wc] = ss;
            }
          }
    }
};

struct EpiFF1 {
    static constexpr bool PERM = true, AFTER_DRAIN = false;
    bf16_t* HID; const float* RSS; const float* bff1;
    __device__ __forceinline__ void operator()(const f32x4 (&acc)[2][2][4][2], const Unit& u, int wr, int wc, int fr, int fq) const {
        const int row0 = u.pm * BM + wr * 64 + fr; const int b = (u.pm * BM) >> 13;
        const int col0 = u.pn * BM + wc * 32 + 8 * fq;
        f32x4 bv[2][2];
#pragma unroll
        for (int bj = 0; bj < 2; ++bj)
#pragma unroll
            for (int n = 0; n < 2; ++n) bv[bj][n] = *(const f32x4*)(bff1 + (size_t)b * 4096 + col0 + 128 * bj + 4 * n);
#pragma unroll
        for (int ai = 0; ai < 2; ++ai) {
            f32x4 sv[4][4];
#pragma unroll
            for (int m = 0; m < 4; ++m)
#pragma unroll
                for (int q = 0; q < 4; ++q) sv[m][q] = *(const f32x4*)(RSS + (size_t)(row0 + ai * HALF + m * 16) * 16 + 4 * q);
#pragma unroll
            for (int m = 0; m < 4; ++m) asm volatile("" : "+v"(sv[m][0]), "+v"(sv[m][1]), "+v"(sv[m][2]), "+v"(sv[m][3]));
#pragma unroll
            for (int m = 0; m < 4; ++m) {
                const int r = row0 + ai * HALF + m * 16;
                const f32x4 st = (sv[m][0] + sv[m][1]) + (sv[m][2] + sv[m][3]);
                const float rs = 1.0f / sqrtf(((st[0] + st[1]) + (st[2] + st[3])) * (1.0f / 1024.0f) + 1e-6f);
#pragma unroll
                for (int bj = 0; bj < 2; ++bj) {
                    f32x4 h0 = acc[ai][bj][m][0] * rs + bv[bj][0], h1 = acc[ai][bj][m][1] * rs + bv[bj][1];
#pragma unroll
                    for (int e = 0; e < 4; ++e) { const float a = fmaxf(h0[e], 0.f), c = fmaxf(h1[e], 0.f); h0[e] = a * a; h1[e] = c * c; }
                    st16_wt(HID + (size_t)r * 4096 + col0 + 128 * bj, pack8(h0, h1));
                }
            }
        }
    }
};

struct EpiFF2 {
    static constexpr bool PERM = true, AFTER_DRAIN = false;
    const bf16_t* X1B; const float* mod; float* dst;
    __device__ __forceinline__ void operator()(const f32x4 (&acc)[2][2][4][2], const Unit& u, int wr, int wc, int fr, int fq) const {
        const int row0 = u.pm * BM + wr * 64 + fr; const int b = (u.pm * BM) >> 13;
        const int col0 = u.pn * BM + wc * 32 + 8 * fq;
        f32x4 g2[2][2];
#pragma unroll
        for (int bj = 0; bj < 2; ++bj)
#pragma unroll
            for (int n = 0; n < 2; ++n) g2[bj][n] = *(const f32x4*)(mod + (size_t)b * 6144 + 5 * 1024 + col0 + 128 * bj + 4 * n);
#pragma unroll
        for (int ai = 0; ai < 2; ++ai) {
            u32x4 xv[4][2];
#pragma unroll
            for (int m = 0; m < 4; ++m)
#pragma unroll
                for (int bj = 0; bj < 2; ++bj) { const size_t off = (size_t)(row0 + ai * HALF + m * 16) * 1024 + col0 + 128 * bj; xv[m][bj] = *(const u32x4*)(X1B + off); }
#pragma unroll
            for (int m = 0; m < 4; ++m)
#pragma unroll
                for (int bj = 0; bj < 2; ++bj) asm volatile("" : "+v"(xv[m][bj]));
#pragma unroll
            for (int m = 0; m < 4; ++m)
#pragma unroll
                for (int bj = 0; bj < 2; ++bj) {
                    const size_t off = (size_t)(row0 + ai * HALF + m * 16) * 1024 + col0 + 128 * bj;
                    const u32x4 w = xv[m][bj];
                    const f32x4 xa = {__builtin_bit_cast(float, w.x << 16), __builtin_bit_cast(float, w.x & 0xffff0000u), __builtin_bit_cast(float, w.y << 16), __builtin_bit_cast(float, w.y & 0xffff0000u)};
                    const f32x4 xb = {__builtin_bit_cast(float, w.z << 16), __builtin_bit_cast(float, w.z & 0xffff0000u), __builtin_bit_cast(float, w.w << 16), __builtin_bit_cast(float, w.w & 0xffff0000u)};
                    *(f32x4*)(dst + off) = xa + g2[bj][0] * acc[ai][bj][m][0]; *(f32x4*)(dst + off + 4) = xb + g2[bj][1] * acc[ai][bj][m][1];
                }
        }
    }
};
}

#ifndef MK_N_LAUNCHES
#define MK_N_LAUNCHES 1
#endif
constexpr int NWAVES = 8;
constexpr int N_PHASES = 8;
constexpr int BATCH = 4, T = 8192, D = 1024, M = BATCH * T, FF = 4096, NIN = 3072, INCOLS = 2840;
constexpr int NCMP = 511;
constexpr float LOG2E = 1.4426950408889634f;
constexpr size_t MiB = 1u << 20;
constexpr size_t WS_CTL = 0, CTL_ZERO_BYTES = 32 * 1024;
constexpr size_t WS_MOD = 1 * MiB;
constexpr size_t WS_BFF1 = 1 * MiB + 128 * 1024;
constexpr size_t WS_PEP = 1 * MiB + 256 * 1024;
constexpr size_t WS_RSS = 2 * MiB;
constexpr size_t WS_G = 4 * MiB;
constexpr size_t WS_WIN = 8 * MiB;
constexpr size_t WS_WOUT = 14 * MiB;
constexpr size_t WS_W1 = 16 * MiB;
constexpr size_t WS_W2 = 24 * MiB;
constexpr size_t WS_CW1K = 32 * MiB, WS_CW1V = 33 * MiB;
constexpr size_t WS_CW2K = 34 * MiB, WS_CW2V = 34 * MiB + 64 * 1024;
constexpr size_t WS_KC = 35 * MiB, WS_VC = 35 * MiB + 512 * 1024;
constexpr size_t WS_A2 = 36 * MiB;
constexpr size_t WS_H = 100 * MiB;
constexpr size_t WS_Q = 164 * MiB;
constexpr size_t WS_KV = 196 * MiB;
constexpr size_t KV_TENS = (size_t)4 * 2 * 8192 * 64;
constexpr size_t WS_Z = 244 * MiB;
constexpr size_t WS_BG = 276 * MiB;
constexpr size_t WS_MIX = 308 * MiB;
constexpr size_t WS_HID = 100 * MiB;
constexpr size_t WS_X1B = 380 * MiB;
constexpr size_t WS_END = 444 * MiB;
constexpr int CW_BAR = 4096;
constexpr int CW_QHEAD = 1024;

constexpr int RING_BYTES = 131072;
constexpr int LDSCTL_OFF = 151 * 1024, MISC_OFF = LDSCTL_OFF + 320;
constexpr int LDS_BYTES = 152 * 1024;

#define GAS __attribute__((address_space(1)))
#define LAS __attribute__((address_space(3)))
typedef unsigned short bf16;
typedef unsigned v4u __attribute__((ext_vector_type(4)));
typedef float f32x4 __attribute__((ext_vector_type(4)));
typedef float f32x16 __attribute__((ext_vector_type(16)));
typedef short bf16x8 __attribute__((ext_vector_type(8)));
typedef short s16x4 __attribute__((ext_vector_type(4)));
typedef GAS unsigned gu32;
#define RLX_AGENT __ATOMIC_RELAXED, __HIP_MEMORY_SCOPE_AGENT
#define LDS_WAIT() asm volatile("s_waitcnt lgkmcnt(0)" ::: "memory")
#define VM_WAIT() asm volatile("s_waitcnt vmcnt(0)" ::: "memory")
__device__ __forceinline__ unsigned f2bf(float f) { unsigned u = __builtin_bit_cast(unsigned, f); return (u + 0x7fffu + ((u >> 16) & 1u)) >> 16; }
__device__ __forceinline__ unsigned pk2(float lo, float hi) { return f2bf(lo) | (f2bf(hi) << 16); }
__device__ __forceinline__ float bf2f(unsigned short h) { return __builtin_bit_cast(float, (unsigned)h << 16); }
#define XB_TMO      128
#define XB_XCNT(j)  (256  + 64 * (j))
#define XB_XSUB(j)  (1280 + 64 * (j))
#define XB_XGEN(j)  (2304 + 64 * (j))
#define XB_TOP      3328
#define XB_TOPGEN   3392
#define XCD_BAR_WORDS 3456
#define XB_SPIN_CAP (1u << 18)

__device__ __forceinline__ unsigned xb_ld(unsigned* p)              { return __hip_atomic_load(p, __ATOMIC_RELAXED, __HIP_MEMORY_SCOPE_AGENT); }
__device__ __forceinline__ unsigned xb_add(unsigned* p, unsigned v) { return __hip_atomic_fetch_add(p, v, __ATOMIC_RELAXED, __HIP_MEMORY_SCOPE_AGENT); }
__device__ __forceinline__ unsigned xb_xcc_id() { return (unsigned)__builtin_amdgcn_s_getreg((3 << 11) | 20) & 0xFu; }
#define XB_SPIN(cond, bar) do { unsigned _sp = 0; while (cond) { __builtin_amdgcn_s_sleep(1); \
    if ((++_sp & 255u) == 0u) { if (xb_ld(&(bar)[XB_TMO])) break; if (_sp > XB_SPIN_CAP) { atomicAdd(&(bar)[XB_TMO], 1u); break; } } } } while (0)

struct XcdBarrier {
    unsigned* bar; unsigned x;
    volatile LAS unsigned* st;
};

__device__ __forceinline__ XcdBarrier xcd_barrier_post(unsigned* bar, volatile LAS unsigned* st) {
    XcdBarrier b; b.bar = bar; b.x = xb_xcc_id(); b.st = st;
    if (threadIdx.x == 0) (void)xb_add(&bar[XB_XCNT(b.x)], 1u);
    return b;
}
__device__ __forceinline__ void xcd_barrier_complete(unsigned* bar, unsigned x, unsigned& nloc, unsigned& nx) {
    const unsigned G = gridDim.x * gridDim.y * gridDim.z;
    unsigned sum, cnt, mine, sp = 0u;
    for (;;) {
        sum = 0u; cnt = 0u; mine = 0u;
#pragma unroll
        for (unsigned j = 0; j < 16; ++j) { const unsigned c = xb_ld(&bar[XB_XCNT(j)]); sum += c; cnt += (c > 0u) ? 1u : 0u; mine = (j == x) ? c : mine; }
        if (sum == G) break;
        __builtin_amdgcn_s_sleep(1);
        if ((++sp & 255u) == 0u) { if (xb_ld(&bar[XB_TMO])) break; if (sp > XB_SPIN_CAP) { atomicAdd(&bar[XB_TMO], 1u); break; } }
    }
    nloc = mine > 0u ? mine : 1u; nx = cnt > 0u ? cnt : 1u;
}

__device__ __forceinline__ void xcd_barrier(const XcdBarrier& b) {
    asm volatile("s_waitcnt vmcnt(0)" ::: "memory");
    __syncthreads();
    if (threadIdx.x == 0) {
        unsigned* bar = b.bar;
        __builtin_amdgcn_s_waitcnt(0);
        unsigned nloc = b.st[0], nx = b.st[1];
        if (nloc == 0u) { xcd_barrier_complete(bar, b.x, nloc, nx); b.st[0] = nloc; b.st[1] = nx; }
        const unsigned old = xb_add(&bar[XB_XSUB(b.x)], 1u);
        const unsigned gen = old / nloc;
        if (old + 1u == (gen + 1u) * nloc) {
            __builtin_amdgcn_fence(__ATOMIC_RELEASE, "agent");
            asm volatile("s_waitcnt vmcnt(0)" ::: "memory");
            const unsigned og = xb_add(&bar[XB_TOP], 1u);
            const unsigned tg = og / nx;
            if (og + 1u == (tg + 1u) * nx) xb_add(&bar[XB_TOPGEN], 1u);
            else XB_SPIN(xb_ld(&bar[XB_TOPGEN]) == tg, bar);
            __builtin_amdgcn_fence(__ATOMIC_ACQUIRE, "agent");
            xb_add(&bar[XB_XGEN(b.x)], 1u);
            asm volatile("s_waitcnt vmcnt(0)" ::: "memory");
        } else {
            XB_SPIN(xb_ld(&bar[XB_XGEN(b.x)]) == gen, bar);
            __builtin_amdgcn_fence(__ATOMIC_ACQUIRE, "agent");
            asm volatile("s_waitcnt vmcnt(0)" ::: "memory");
        }
    }
    __syncthreads();
}

struct Frame {
    LAS unsigned char* lds;
    volatile LAS unsigned* MISC;
    gu32* ctl;
    int tid, lane, wave;
    int vcu, G;
    const float* in[20];
    float* out;
    unsigned char* ws;
    unsigned long long tp_t0, tp_acc;
};
#ifdef ATP_A
#define ATP(F, id) do { if ((id) == ATP_A) (F).tp_t0 = __builtin_amdgcn_s_memrealtime(); if ((id) == ATP_B) (F).tp_acc += __builtin_amdgcn_s_memrealtime() - (F).tp_t0; } while (0)
#else
#define ATP(F, id) do {} while (0)
#endif
__device__ __forceinline__ float wave_sum(float v) {
#pragma unroll
    for (int o = 1; o < 64; o <<= 1) v += __shfl_xor(v, o);
    return v;
}

__device__ __forceinline__ void p0_transpose_item(const float* W, int K, int N, int nsrc0, int nvalid, bf16* WT, int drow0, int kb, LAS float* scr, int lane) {
    const int k0 = 64 * kb; const int nl = lane & 31;
    float tv[32];
#pragma unroll
    for (int i = 0; i < 32; ++i) { const int kk = 2 * i + (lane >> 5); tv[i] = (nl < nvalid) ? W[(size_t)(k0 + kk) * N + nsrc0 + nl] : 0.f; }
#pragma unroll
    for (int i = 0; i < 32; ++i) { const int kk = 2 * i + (lane >> 5); scr[kk * 33 + nl] = tv[i]; }
    LDS_WAIT(); asm volatile("" ::: "memory");
    const int c = lane & 7;
#pragma unroll
    for (int j = 0; j < 4; ++j) { const int n = (lane >> 3) + 8 * j; const LAS float* s = scr + (8 * c) * 33 + n;
        v4u o; o.x = pk2(s[0 * 33], s[1 * 33]); o.y = pk2(s[2 * 33], s[3 * 33]); o.z = pk2(s[4 * 33], s[5 * 33]); o.w = pk2(s[6 * 33], s[7 * 33]);
        *(GAS v4u*)(WT + (size_t)(drow0 + n) * K + k0 + 8 * c) = o; }
    LDS_WAIT(); asm volatile("" ::: "memory");
}
__device__ __forceinline__ void win_src(int rb, int& src0, int& nvalid) {
    const int pn = rb >> 3, q = rb & 7, bj = q >> 2, wc = q & 3; nvalid = 32;
    if (pn < 2) src0 = (4 * pn + wc) * 64 + 32 * bj;
    else if (pn < 5) src0 = 512 + (pn - 2) * 256 + (wc >> 1) * 128 + (wc & 1) * 64 + 32 * bj;
    else if (pn < 9) src0 = (bj == 0 ? 1304 : 2328) + 128 * (pn - 5) + 32 * wc;
    else if (pn < 11) src0 = 1816 + 256 * (pn - 9) + 32 * q;
    else { src0 = 1280; nvalid = (q == 0) ? 24 : 0; }
}
__device__ __forceinline__ void p0_phase(Frame& F) {
    const int bid = blockIdx.x;
    ATP(F, 60);
    for (int it = bid; it < 224; it += F.G) {
      if (it < 192) {
        const int cb = it;
        LAS float* sc = (LAS float*)(F.lds);
        LAS float* red = (LAS float*)(F.lds + 16384);
        const float* c = F.in[1];
        for (int i = F.tid; i < 4096; i += 512) { const float v = c[i]; sc[i] = v / (1.0f + __expf(-v)); }
        __syncthreads();
        const float* wa = F.in[16]; const int col = 32 * cb + (F.lane & 31), kpar = F.lane >> 5;
        float a0 = 0.f, a1 = 0.f, a2 = 0.f, a3 = 0.f;
#pragma unroll 32
        for (int i = 0; i < 64; ++i) { const int k = 128 * F.wave + 2 * i + kpar; const float w = wa[(size_t)k * 6144 + col];
            a0 += sc[k] * w; a1 += sc[1024 + k] * w; a2 += sc[2048 + k] * w; a3 += sc[3072 + k] * w; }
        a0 += __shfl_xor(a0, 32); a1 += __shfl_xor(a1, 32); a2 += __shfl_xor(a2, 32); a3 += __shfl_xor(a3, 32);
        if (F.lane < 32) { red[(F.wave * 4 + 0) * 32 + F.lane] = a0; red[(F.wave * 4 + 1) * 32 + F.lane] = a1; red[(F.wave * 4 + 2) * 32 + F.lane] = a2; red[(F.wave * 4 + 3) * 32 + F.lane] = a3; }
        __syncthreads();
        if (F.tid < 128) { const int b = F.tid >> 5, cc = F.tid & 31; float s = F.in[17][32 * cb + cc];
#pragma unroll
            for (int w = 0; w < 8; ++w) s += red[(w * 4 + b) * 32 + cc];
            ((float*)(F.ws + WS_MOD))[b * 6144 + 32 * cb + cc] = s; }
        __syncthreads();
      } else {
        const int kv = (it - 192) >> 4, kc = (it - 192) & 15; const float* pe = F.in[kv ? 8 : 5]; const float* w1 = F.in[kv ? 9 : 6];
        if (F.tid < 256) { float s = 0.f;
#pragma unroll 32
            for (int k = 128 * kc; k < 128 * kc + 128; ++k) s += pe[k] * w1[(size_t)k * 256 + F.tid];
            ((float*)(F.ws + WS_PEP))[(kv * 16 + kc) * 256 + F.tid] = s; }
      }
    }
    __syncthreads();
    ATP(F, 61);
    LAS float* scr = (LAS float*)(F.lds + F.wave * 16384);
    const int gw = F.vcu * NWAVES + F.wave, NGW = F.G * NWAVES;
    constexpr int I_IN = 96 * 16, I_OUT = 32 * 16, I_1 = 128 * 16, I_2 = 32 * 64, I_C1 = 8 * 32, I_C2 = 2 * 4;
    constexpr int NITEMS = I_IN + I_OUT + I_1 + I_2 + 2 * I_C1 + 2 * I_C2;
    for (int it = gw; it < NITEMS; it += NGW) {
        int r = it;
        if (r < I_IN) { const int rb = r % 96, kb = r / 96; int s0, nv; win_src(rb, s0, nv); p0_transpose_item(F.in[2], D, INCOLS, s0, nv, (bf16*)(F.ws + WS_WIN), 32 * rb, kb, scr, F.lane); continue; } r -= I_IN;
        if (r < I_OUT) { const int rb = r & 31, kb = r >> 5; p0_transpose_item(F.in[13], D, D, 32 * rb, 32, (bf16*)(F.ws + WS_WOUT), 32 * rb, kb, scr, F.lane); continue; } r -= I_OUT;
        if (r < I_1) { const int rb = r & 127, kb = r >> 7; p0_transpose_item(F.in[18], D, FF, 32 * rb, 32, (bf16*)(F.ws + WS_W1), 32 * rb, kb, scr, F.lane); continue; } r -= I_1;
        if (r < I_2) { const int rb = r & 31, kb = r >> 5; p0_transpose_item(F.in[19], FF, D, 32 * rb, 32, (bf16*)(F.ws + WS_W2), 32 * rb, kb, scr, F.lane); continue; } r -= I_2;
        if (r < I_C1) { const int rb = r & 7, kb = r >> 3; p0_transpose_item(F.in[6], 2048, 256, 32 * rb, 32, (bf16*)(F.ws + WS_CW1K), 32 * rb, kb, scr, F.lane); continue; } r -= I_C1;
        if (r < I_C1) { const int rb = r & 7, kb = r >> 3; p0_transpose_item(F.in[9], 2048, 256, 32 * rb, 32, (bf16*)(F.ws + WS_CW1V), 32 * rb, kb, scr, F.lane); continue; } r -= I_C1;
        if (r < I_C2) { const int rb = r & 1, kb = r >> 1; p0_transpose_item(F.in[7], 256, 64, 32 * rb, 32, (bf16*)(F.ws + WS_CW2K), 32 * rb, kb, scr, F.lane); continue; } r -= I_C2;
        { const int rb = r & 1, kb = r >> 1; p0_transpose_item(F.in[10], 256, 64, 32 * rb, 32, (bf16*)(F.ws + WS_CW2V), 32 * rb, kb, scr, F.lane); }
    }
    __syncthreads();
}

__device__ __forceinline__ void p1_phase(Frame& F) {
    const int gw = F.vcu * NWAVES + F.wave, NGW = F.G * NWAVES;
    const float* mod = (const float*)(F.ws + WS_MOD);
    const float* x = F.in[0]; const float* n1 = F.in[14];
    bf16* H = (bf16*)(F.ws + WS_H);
    ATP(F, 10);
    for (int chunk = gw; chunk < M / 16; chunk += NGW) {
        const int r0 = chunk * 16, b = r0 >> 13;
        f32x4 ca[4], cb[4];
#pragma unroll
        for (int j = 0; j < 4; ++j) { const int c = 4 * (F.lane + 64 * j);
            const f32x4 nn = *(const f32x4*)(n1 + c), s1 = *(const f32x4*)(mod + (size_t)b * 6144 + 1024 + c);
            ca[j] = nn * (s1 + 1.0f); cb[j] = *(const f32x4*)(mod + (size_t)b * 6144 + c); }
        for (int rr = 0; rr < 16; rr += 4) {
            f32x4 v[4][4]; float s[4];
#pragma unroll
            for (int q = 0; q < 4; ++q) { const GAS f32x4* xr = (const GAS f32x4*)(x + (size_t)(r0 + rr + q) * D) + F.lane;
#pragma unroll
                for (int j = 0; j < 4; ++j) v[q][j] = xr[64 * j]; }
#pragma unroll
            for (int q = 0; q < 4; ++q) { s[q] = 0.f;
#pragma unroll
                for (int j = 0; j < 4; ++j) s[q] += (v[q][j].x * v[q][j].x + v[q][j].y * v[q][j].y) + (v[q][j].z * v[q][j].z + v[q][j].w * v[q][j].w); }
#pragma unroll
            for (int o = 1; o < 64; o <<= 1) {
#pragma unroll
                for (int q = 0; q < 4; ++q) s[q] += __shfl_xor(s[q], o); }
#pragma unroll
            for (int q = 0; q < 4; ++q) {
                const float rs = 1.0f / sqrtf(s[q] * (1.0f / D) + 1e-6f);
                GAS unsigned long long* o8 = (GAS unsigned long long*)(H + (size_t)(r0 + rr + q) * D) + F.lane;
#pragma unroll
                for (int j = 0; j < 4; ++j) { const f32x4 h = v[q][j] * rs * ca[j] + cb[j];
                    o8[64 * j] = (unsigned long long)pk2(h.x, h.y) | ((unsigned long long)pk2(h.z, h.w) << 32); }
            }
        }
    }
    ATP(F, 11);
    const bf16* W1t = (const bf16*)(F.ws + WS_W1);
    float* bff1 = (float*)(F.ws + WS_BFF1);
    for (int n = gw; n < FF; n += NGW) {
        float a[4] = {0.f, 0.f, 0.f, 0.f};
#pragma unroll
        for (int j = 0; j < 2; ++j) { const int k0 = 8 * F.lane + 512 * j;
            const v4u wv = *(const GAS v4u*)(W1t + (size_t)n * D + k0);
            float w[8]; w[0] = bf2f(wv.x & 0xffff); w[1] = bf2f(wv.x >> 16); w[2] = bf2f(wv.y & 0xffff); w[3] = bf2f(wv.y >> 16); w[4] = bf2f(wv.z & 0xffff); w[5] = bf2f(wv.z >> 16); w[6] = bf2f(wv.w & 0xffff); w[7] = bf2f(wv.w >> 16);
#pragma unroll
            for (int b = 0; b < 4; ++b) { const f32x4 s0 = *(const f32x4*)(mod + (size_t)b * 6144 + 3 * 1024 + k0), s1 = *(const f32x4*)(mod + (size_t)b * 6144 + 3 * 1024 + k0 + 4);
                a[b] += (w[0] * s0[0] + w[1] * s0[1]) + (w[2] * s0[2] + w[3] * s0[3]) + (w[4] * s1[0] + w[5] * s1[1]) + (w[6] * s1[2] + w[7] * s1[3]); } }
#pragma unroll
        for (int b = 0; b < 4; ++b) { const float s = wave_sum(a[b]); if (F.lane == 0) bff1[b * 4096 + n] = s; }
    }
    ATP(F, 12);
}

__device__ __forceinline__ float gelu_tanh(float x) {
    const float u = 0.7978845608028654f * (x + 0.044715f * x * x * x);
    const float e = __expf(2.0f * u);
    const float th = 1.0f - 2.0f / (1.0f + e);
    return 0.5f * x * (1.0f + th);
}
__device__ __forceinline__ void p3_phase(Frame& F) {
    constexpr int AIMG = 0, GSTR = 2064, HIDO = 68224, HSTR = 528, OUTO = 85120, OSTR = 65;
    const int lane = F.lane, w = F.wave, r32 = lane & 31, hi = lane >> 5;
    for (int item = blockIdx.x; item < 256; item += F.G) {
        const int prob = item >> 4, mt = item & 15, kv = prob >> 3, b = (prob >> 1) & 3, g = prob & 1, n0 = 32 * mt;
        const bf16* raw = (const bf16*)(F.ws + WS_KV) + (size_t)kv * KV_TENS + (size_t)(b * 2 + g) * 8192 * 64;
        ATP(F, 30);
        { v4u av[9];
#pragma unroll
          for (int q = 0; q < 9; ++q) { const int idx = F.tid + 512 * q, gl = idx >> 7, ch = idx & 127, gi = n0 + gl;
              av[q] = (v4u){0u, 0u, 0u, 0u}; if (idx < 33 * 128 && gi < 512) av[q] = *(const GAS v4u*)(raw + (size_t)gi * 1024 + ch * 8); }
#pragma unroll
          for (int q = 0; q < 9; ++q) { const int idx = F.tid + 512 * q, gl = idx >> 7, ch = idx & 127;
              if (idx < 33 * 128) *(LAS v4u*)(F.lds + AIMG + gl * GSTR + ch * 16) = av[q]; } }
        __syncthreads();
        ATP(F, 31);
        const bf16* W1t = (const bf16*)(F.ws + (kv ? WS_CW1V : WS_CW1K));
        const bf16* bp = W1t + (size_t)(32 * w + r32) * 2048 + 8 * hi;
        const LAS unsigned char* ap = F.lds + AIMG + r32 * GSTR + hi * 16;
        f32x16 acc = {};
#pragma unroll 1
        for (int s0 = 0; s0 < 128; s0 += 32) {
            bf16x8 bfr[32];
#pragma unroll
            for (int j = 0; j < 32; ++j) bfr[j] = *(const GAS bf16x8*)(bp + 16 * (s0 + j));
#pragma unroll
            for (int j = 0; j < 32; ++j) asm volatile("" : "+v"(bfr[j]));
            const LAS unsigned char* aq = ap + (s0 >= 64 ? GSTR + (s0 - 64) * 32 : s0 * 32);
#pragma unroll
            for (int j = 0; j < 32; ++j) { const bf16x8 af = *(const LAS bf16x8*)(aq + j * 32); acc = __builtin_amdgcn_mfma_f32_32x32x16_bf16(af, bfr[j], acc, 0, 0, 0); }
        }
        ATP(F, 32);
        { const float* pp = (const float*)(F.ws + WS_PEP) + kv * 16 * 256 + 32 * w + r32; float pb = 0.f;
#pragma unroll
          for (int kc = 0; kc < 16; ++kc) pb += pp[kc * 256];
#pragma unroll
          for (int i = 0; i < 16; ++i) { const int row = (i & 3) + 8 * (i >> 2) + 4 * hi; const float h = gelu_tanh(acc[i] + pb);
              *(LAS unsigned short*)(F.lds + HIDO + row * HSTR + (32 * w + r32) * 2) = (unsigned short)f2bf(h); } }
        __syncthreads();
        if (w < 2) {
            const bf16* W2t = (const bf16*)(F.ws + (kv ? WS_CW2V : WS_CW2K));
            const bf16* bp2 = W2t + (size_t)(32 * w + r32) * 256 + 8 * hi;
            const LAS unsigned char* ap2 = F.lds + HIDO + r32 * HSTR + hi * 16;
            f32x16 a2 = {};
#pragma unroll
            for (int s = 0; s < 16; ++s) { const bf16x8 bf_ = *(const GAS bf16x8*)(bp2 + 16 * s); const bf16x8 af = *(const LAS bf16x8*)(ap2 + s * 32); a2 = __builtin_amdgcn_mfma_f32_32x32x16_bf16(af, bf_, a2, 0, 0, 0); }
#pragma unroll
            for (int i = 0; i < 16; ++i) { const int row = (i & 3) + 8 * (i >> 2) + 4 * hi; *(LAS float*)(F.lds + OUTO + (row * OSTR + 32 * w + r32) * 4) = a2[i]; }
        }
        __syncthreads();
        { const int row = F.tid >> 4, c4 = (F.tid & 15) * 4; const LAS float* op = (const LAS float*)(F.lds + OUTO) + row * OSTR + c4;
          float v0 = op[0], v1 = op[1], v2 = op[2], v3 = op[3];
          if (kv == 0) { float ss = (v0 * v0 + v1 * v1) + (v2 * v2 + v3 * v3); ss += __shfl_xor(ss, 1); ss += __shfl_xor(ss, 2); ss += __shfl_xor(ss, 4); ss += __shfl_xor(ss, 8);
              const float rs = 1.0f / sqrtf(ss * (1.0f / 64.0f) + 1e-6f); const f32x4 kn = *(const f32x4*)(F.in[4] + c4); v0 *= rs * kn[0]; v1 *= rs * kn[1]; v2 *= rs * kn[2]; v3 *= rs * kn[3]; }
          const int n = n0 + row; if (n >= NCMP) { v0 = v1 = v2 = v3 = 0.f; }
          bf16* dst = (bf16*)(F.ws + (kv ? WS_VC : WS_KC)) + ((size_t)(b * 2 + g) * 512 + n) * 64 + c4;
          *(GAS unsigned long long*)dst = (unsigned long long)pk2(v0, v1) | ((unsigned long long)pk2(v2, v3) << 32); }
        __syncthreads();
        ATP(F, 33);
    }
}

namespace att {
constexpr int SLOT = 16384;
constexpr int L_RING = 0;
constexpr int L_IMP = 65536, IMP_STR = 132;
constexpr int L_OACC = 65536;
constexpr int L_BTAB = L_OACC + 65536;
constexpr int NBT = 960, BT0 = 895;
constexpr int L_WSF = L_BTAB + 4 * NBT * 4;
constexpr int L_SELM = L_WSF + 2048;
constexpr int L_UNI = L_SELM + 1024;
constexpr int L_END = L_UNI + 256;
static_assert(L_END <= LDSCTL_OFF, "attention LDS map");
constexpr float NEG_INF = -INFINITY;
constexpr float THR = 8.0f;

__device__ __forceinline__ int t5_bucket(int n) {
    if (n < 16) return n;
    int b = 16;
    b += (n >= 21); b += (n >= 27); b += (n >= 35); b += (n >= 46); b += (n >= 59); b += (n >= 77); b += (n >= 99); b += (n >= 128);
    b += (n >= 166); b += (n >= 216); b += (n >= 280); b += (n >= 363); b += (n >= 470); b += (n >= 609); b += (n >= 790);
    return b;
}
__device__ __forceinline__ s16x4 vtr(const LAS unsigned char* p) { typedef short v4i16_t __attribute__((ext_vector_type(4))); return __builtin_bit_cast(s16x4, __builtin_amdgcn_ds_read_tr16_b64_v4i16((LAS v4i16_t*)p)); }
__device__ __forceinline__ unsigned cvtpk(float lo, float hi) { typedef float f2 __attribute__((ext_vector_type(2))); typedef __bf16 b2 __attribute__((ext_vector_type(2))); f2 v = {lo, hi}; b2 b = __builtin_convertvector(v, b2); return __builtin_bit_cast(unsigned, b); }
__device__ __forceinline__ float xhalf_max(float a) { auto rr = __builtin_amdgcn_permlane32_swap(__float_as_uint(a), __float_as_uint(a), false, false); return fmaxf(__uint_as_float(rr[0]), __uint_as_float(rr[1])); }
__device__ __forceinline__ float xhalf_sum(float a) { auto rr = __builtin_amdgcn_permlane32_swap(__float_as_uint(a), __float_as_uint(a), false, false); return __uint_as_float(rr[0]) + __uint_as_float(rr[1]); }
__device__ __forceinline__ float quad_sum(float a) {
    a += __int_as_float(__builtin_amdgcn_update_dpp(0, __float_as_int(a), 0xB1, 0xf, 0xf, true));
    a += __int_as_float(__builtin_amdgcn_update_dpp(0, __float_as_int(a), 0x4E, 0xf, 0xf, true));
    return a;
}
__device__ __forceinline__ void glds16(const void* gsrc, unsigned lds_dst) { unsigned keep;
    asm volatile("s_mov_b32 %0, m0\n\ts_mov_b32 m0, %2\n\ts_nop 0\n\tglobal_load_lds_dwordx4 %1, off\n\ts_mov_b32 m0, %0" : "=&s"(keep) : "v"(gsrc), "s"(lds_dst) : "memory"); }
#define ATT_WAIT_BAR(N) asm volatile("s_waitcnt vmcnt(" #N ") lgkmcnt(0)\n\ts_barrier" ::: "memory")
__device__ __forceinline__ void tile_dma(const bf16* Kt, const bf16* Vt, bool hasV, unsigned slot_addr, int w, int lane) {
    glds16(Kt + lane * 64 + w * 8, (unsigned)__builtin_amdgcn_readfirstlane(slot_addr + w * 1024));
    if (hasV) glds16(Vt + (16 * (w & 3) + (lane >> 2)) * 64 + (w >> 2) * 32 + (lane & 3) * 8, (unsigned)__builtin_amdgcn_readfirstlane(slot_addr + 8192 + w * 1024));
}
__device__ __forceinline__ void qk_tile(const LAS unsigned char* buf, const bf16x8 (&qf)[4], float cv, f32x16& p0, f32x16& p1, int r32, int hi) {
    const LAS unsigned char* kp = buf + hi * 1024 + r32 * 16;
    f32x16 c;
#pragma unroll
    for (int i = 0; i < 16; ++i) c[i] = cv;
    bf16x8 k0[4], k1[4];
#pragma unroll
    for (int s = 0; s < 4; ++s) { k0[s] = *(const LAS bf16x8*)(kp + s * 2048); k1[s] = *(const LAS bf16x8*)(kp + s * 2048 + 512); }
#ifndef NO_K_PIN
    __builtin_amdgcn_sched_barrier(0);
#endif
#ifdef ATT_PRIO
    __builtin_amdgcn_s_setprio(1);
#endif
#ifdef QK_SEQ
    p0 = __builtin_amdgcn_mfma_f32_32x32x16_bf16(k0[0], qf[0], c, 0, 0, 0);
#pragma unroll
    for (int s = 1; s < 4; ++s) p0 = __builtin_amdgcn_mfma_f32_32x32x16_bf16(k0[s], qf[s], p0, 0, 0, 0);
    p1 = __builtin_amdgcn_mfma_f32_32x32x16_bf16(k1[0], qf[0], c, 0, 0, 0);
#pragma unroll
    for (int s = 1; s < 4; ++s) p1 = __builtin_amdgcn_mfma_f32_32x32x16_bf16(k1[s], qf[s], p1, 0, 0, 0);
#else
    p0 = __builtin_amdgcn_mfma_f32_32x32x16_bf16(k0[0], qf[0], c, 0, 0, 0);
    p1 = __builtin_amdgcn_mfma_f32_32x32x16_bf16(k1[0], qf[0], c, 0, 0, 0);
#pragma unroll
    for (int s = 1; s < 4; ++s) {
        p0 = __builtin_amdgcn_mfma_f32_32x32x16_bf16(k0[s], qf[s], p0, 0, 0, 0);
        p1 = __builtin_amdgcn_mfma_f32_32x32x16_bf16(k1[s], qf[s], p1, 0, 0, 0);
    }
#endif
#ifdef ATT_PRIO
    __builtin_amdgcn_s_setprio(0);
#endif
}
template <int KSTEP>
__device__ __forceinline__ void bias_mask(f32x16& p0, f32x16& p1, const LAS float* bt, int dbase, int hi) {
#pragma unroll
    for (int i = 0; i < 16; ++i) {
        const int kl = (i & 3) + 8 * (i >> 2) + 4 * hi;
        const int d0 = dbase - KSTEP * kl, d1 = d0 - KSTEP * 32;
        const int i0 = BT0 - min(max(d0, 0), BT0), i1 = BT0 - min(max(d1, 0), BT0);
        const float b0 = bt[i0], b1 = bt[i1];
        p0[i] = (d0 >= 0) ? p0[i] + b0 : NEG_INF;
        p1[i] = (d1 >= 0) ? p1[i] + b1 : NEG_INF;
        if ((i & 3) == 3) asm volatile("" ::: "memory");
    }
}
template <int MODE>
__device__ __forceinline__ void bias_near(f32x16& p0, f32x16& p1, const LAS float* tb, int dbase, int hi) {
#pragma unroll
    for (int i = 0; i < 16; ++i) {
        const int ko = (i & 3) + 8 * (i >> 2);
        const float b0 = tb[ko], b1 = tb[ko + 32];
        const int d0 = dbase - ko - 4 * hi, d1 = d0 - 32;
        if (MODE == 0) { p0[i] += b0; p1[i] += b1; }
        else if (MODE == 1) { p0[i] = d0 >= 0 ? p0[i] + b0 : NEG_INF; p1[i] = d1 >= 0 ? p1[i] + b1 : NEG_INF; }
        else { p0[i] = d0 < 512 ? p0[i] + b0 : NEG_INF; p1[i] = d1 < 512 ? p1[i] + b1 : NEG_INF; }
        if ((i & 7) == 7) asm volatile("" ::: "memory");
    }
}
__device__ __forceinline__ void bias_near_mode(f32x16& p0, f32x16& p1, const LAS float* tb, int dbase, int hi, int mode) {
    if (mode == 0) bias_near<0>(p0, p1, tb, dbase, hi); else if (mode == 1) bias_near<1>(p0, p1, tb, dbase, hi); else bias_near<2>(p0, p1, tb, dbase, hi);
}
__device__ __forceinline__ float rowmax32(const f32x16& p0, const f32x16& p1) {
    float a = fmaxf(fmaxf(p0[0], p1[0]), p0[1]), b = fmaxf(fmaxf(p1[1], p0[2]), p1[2]);
#pragma unroll
    for (int i = 3; i < 15; i += 2) { a = fmaxf(fmaxf(a, p0[i]), p1[i]); b = fmaxf(fmaxf(b, p0[i + 1]), p1[i + 1]); }
    a = fmaxf(fmaxf(a, p0[15]), p1[15]);
    return xhalf_max(fmaxf(a, b));
}
__device__ __forceinline__ void pv_tile(const LAS unsigned char* buf, const f32x16& p0, const f32x16& p1, f32x16 (&o)[2], int lane, int hi) {
    const LAS unsigned char* vp = buf + 8192 + ((lane >> 4) & 1) * 32 + (lane & 3) * 8 + (4 * hi + ((lane & 15) >> 2)) * 64;
    bf16x8 pa[4];
#pragma unroll
    for (int s = 0; s < 2; ++s) {
        v4u a, c;
        a.x = cvtpk(p0[8 * s + 0], p0[8 * s + 1]); a.y = cvtpk(p0[8 * s + 2], p0[8 * s + 3]); a.z = cvtpk(p0[8 * s + 4], p0[8 * s + 5]); a.w = cvtpk(p0[8 * s + 6], p0[8 * s + 7]);
        c.x = cvtpk(p1[8 * s + 0], p1[8 * s + 1]); c.y = cvtpk(p1[8 * s + 2], p1[8 * s + 3]); c.z = cvtpk(p1[8 * s + 4], p1[8 * s + 5]); c.w = cvtpk(p1[8 * s + 6], p1[8 * s + 7]);
        pa[s] = __builtin_bit_cast(bf16x8, a); pa[2 + s] = __builtin_bit_cast(bf16x8, c);
    }
#pragma unroll
    for (int ks = 0; ks < 4; ++ks)
#pragma unroll
        for (int d0 = 0; d0 < 2; ++d0) {
            const s16x4 lo = vtr(vp + d0 * 4096 + ks * 1024), hh = vtr(vp + d0 * 4096 + ks * 1024 + 512);
            const bf16x8 vf = (bf16x8){lo[0], lo[1], lo[2], lo[3], hh[0], hh[1], hh[2], hh[3]};
            o[d0] = __builtin_amdgcn_mfma_f32_32x32x16_bf16(pa[ks], vf, o[d0], 0, 0, 0);
        }
}
struct VFrags { s16x4 lo[4][2], hh[4][2]; };
__device__ __forceinline__ void v_read(VFrags& vf, const LAS unsigned char* buf, int lane, int hi) {
    const LAS unsigned char* vp = buf + 8192 + ((lane >> 4) & 1) * 32 + (lane & 3) * 8 + (4 * hi + ((lane & 15) >> 2)) * 64;
#pragma unroll
    for (int ks = 0; ks < 4; ++ks)
#pragma unroll
        for (int d0 = 0; d0 < 2; ++d0) { vf.lo[ks][d0] = vtr(vp + d0 * 4096 + ks * 1024); vf.hh[ks][d0] = vtr(vp + d0 * 4096 + ks * 1024 + 512); }
}
__device__ __forceinline__ void pv_tile_pre(const VFrags& vf, const f32x16& p0, const f32x16& p1, f32x16 (&o)[2]) {
    bf16x8 pa[4];
#pragma unroll
    for (int s = 0; s < 2; ++s) {
        v4u a, c;
        a.x = cvtpk(p0[8 * s + 0], p0[8 * s + 1]); a.y = cvtpk(p0[8 * s + 2], p0[8 * s + 3]); a.z = cvtpk(p0[8 * s + 4], p0[8 * s + 5]); a.w = cvtpk(p0[8 * s + 6], p0[8 * s + 7]);
        c.x = cvtpk(p1[8 * s + 0], p1[8 * s + 1]); c.y = cvtpk(p1[8 * s + 2], p1[8 * s + 3]); c.z = cvtpk(p1[8 * s + 4], p1[8 * s + 5]); c.w = cvtpk(p1[8 * s + 6], p1[8 * s + 7]);
        pa[s] = __builtin_bit_cast(bf16x8, a); pa[2 + s] = __builtin_bit_cast(bf16x8, c);
    }
#pragma unroll
    for (int ks = 0; ks < 4; ++ks)
#pragma unroll
        for (int d0 = 0; d0 < 2; ++d0) {
            const bf16x8 v = (bf16x8){vf.lo[ks][d0][0], vf.lo[ks][d0][1], vf.lo[ks][d0][2], vf.lo[ks][d0][3], vf.hh[ks][d0][0], vf.hh[ks][d0][1], vf.hh[ks][d0][2], vf.hh[ks][d0][3]};
            o[d0] = __builtin_amdgcn_mfma_f32_32x32x16_bf16(pa[ks], v, o[d0], 0, 0, 0);
        }
}
__device__ __forceinline__ float exp_pv(const VFrags& vf, f32x16& p0, f32x16& p1, f32x16 (&o)[2]) {
    float s0 = 0.f, s1 = 0.f;
#pragma unroll
    for (int i = 0; i < 16; ++i) { p0[i] = __builtin_amdgcn_exp2f(p0[i]); s0 += p0[i]; }
    bf16x8 pa[2];
#pragma unroll
    for (int s = 0; s < 2; ++s) { v4u a; a.x = cvtpk(p0[8 * s + 0], p0[8 * s + 1]); a.y = cvtpk(p0[8 * s + 2], p0[8 * s + 3]); a.z = cvtpk(p0[8 * s + 4], p0[8 * s + 5]); a.w = cvtpk(p0[8 * s + 6], p0[8 * s + 7]); pa[s] = __builtin_bit_cast(bf16x8, a); }
#pragma unroll
    for (int ks = 0; ks < 2; ++ks)
#pragma unroll
        for (int d0 = 0; d0 < 2; ++d0) {
            const bf16x8 v = (bf16x8){vf.lo[ks][d0][0], vf.lo[ks][d0][1], vf.lo[ks][d0][2], vf.lo[ks][d0][3], vf.hh[ks][d0][0], vf.hh[ks][d0][1], vf.hh[ks][d0][2], vf.hh[ks][d0][3]};
            o[d0] = __builtin_amdgcn_mfma_f32_32x32x16_bf16(pa[ks], v, o[d0], 0, 0, 0);
        }
#pragma unroll
    for (int i = 0; i < 16; ++i) { p1[i] = __builtin_amdgcn_exp2f(p1[i]); s1 += p1[i]; }
#pragma unroll
    for (int s = 0; s < 2; ++s) { v4u a; a.x = cvtpk(p1[8 * s + 0], p1[8 * s + 1]); a.y = cvtpk(p1[8 * s + 2], p1[8 * s + 3]); a.z = cvtpk(p1[8 * s + 4], p1[8 * s + 5]); a.w = cvtpk(p1[8 * s + 6], p1[8 * s + 7]); pa[s] = __builtin_bit_cast(bf16x8, a); }
#pragma unroll
    for (int ks = 2; ks < 4; ++ks)
#pragma unroll
        for (int d0 = 0; d0 < 2; ++d0) {
            const bf16x8 v = (bf16x8){vf.lo[ks][d0][0], vf.lo[ks][d0][1], vf.lo[ks][d0][2], vf.lo[ks][d0][3], vf.hh[ks][d0][0], vf.hh[ks][d0][1], vf.hh[ks][d0][2], vf.hh[ks][d0][3]};
            o[d0] = __builtin_amdgcn_mfma_f32_32x32x16_bf16(pa[ks - 2], v, o[d0], 0, 0, 0);
        }
    return s0 + s1;
}
__device__ __forceinline__ void row_to_regs(LAS float* wsf, float v, float (&f)[16], int r32, int hi) {
    if (hi == 0) wsf[r32] = v;
#pragma unroll
    for (int u = 0; u < 4; ++u) { const f32x4 t = *(const LAS f32x4*)(wsf + 8 * u + 4 * hi); f[4 * u] = t[0]; f[4 * u + 1] = t[1]; f[4 * u + 2] = t[2]; f[4 * u + 3] = t[3]; }
}
struct SmState { float m, l; bool have; };
__device__ __forceinline__ void sm_init(SmState& st) { st.m = 0.f; st.l = 0.f; st.have = false; }
template <bool HASO>
__device__ __forceinline__ void sm_rebase(SmState& st, f32x16& p0, f32x16& p1, f32x16 (&o)[2], LAS float* wsf, int r32, int hi) {
    const float mx = rowmax32(p0, p1);
    const bool fin = mx > NEG_INF;
    const bool trig = st.have ? (mx > THR) : fin;
    if (__any(trig)) {
        const float dl = st.have ? fmaxf(mx, 0.f) : (fin ? mx : 0.f);
        const float alpha = st.have ? __builtin_amdgcn_exp2f(-dl) : 1.0f;
        st.m += dl; st.l *= alpha; st.have = st.have || fin;
#pragma unroll
        for (int i = 0; i < 16; ++i) { p0[i] -= dl; p1[i] -= dl; }
        if (HASO) { float f[16]; row_to_regs(wsf, alpha, f, r32, hi);
#pragma unroll
            for (int i = 0; i < 16; ++i) { o[0][i] *= f[i]; o[1][i] *= f[i]; } }
    }
}
__device__ __forceinline__ float exp_sum(f32x16& p0, f32x16& p1) {
    float s0 = 0.f, s1 = 0.f;
#pragma unroll
    for (int i = 0; i < 16; ++i) { p0[i] = __builtin_amdgcn_exp2f(p0[i]); p1[i] = __builtin_amdgcn_exp2f(p1[i]); s0 += p0[i]; s1 += p1[i]; }
    return s0 + s1;
}

__device__ __forceinline__ void build_btab(Frame& F, int g) {
    LAS float* btab = (LAS float*)(F.lds + L_BTAB); const float* rb = F.in[11];
    __syncthreads();
    for (int i = F.tid; i < 4 * NBT; i += 512) { const int rr = i / NBT, d = BT0 - (i - rr * NBT); btab[i] = rb[t5_bucket(d > 0 ? d : 0) * 8 + 4 * g + rr] * LOG2E; }
    __syncthreads();
}
__device__ __forceinline__ void attn_item(Frame& F, int b, int g, int qb) {
    const int tid = F.tid, lane = F.lane, w = F.wave, r32 = lane & 31, hi = lane >> 5, qi = r32 >> 2, r = r32 & 3;
    const int t0 = qb * 64, tl = 8 * w + qi, tpos = t0 + tl;
    ATP(F, 0);
    LAS unsigned char* lds = F.lds;
    const unsigned lds0 = (unsigned)(uintptr_t)lds;
    LAS float* imp = (LAS float*)(lds + L_IMP);
    LAS float* btab = (LAS float*)(lds + L_BTAB);
    LAS float* wsf = (LAS float*)(lds + L_WSF) + w * 64;
    LAS unsigned* selm = (LAS unsigned*)(lds + L_SELM);
    LAS unsigned* uni = (LAS unsigned*)(lds + L_UNI);
    const bf16* KVb = (const bf16*)(F.ws + WS_KV);
    const size_t bgoff = (size_t)(b * 2 + g) * 8192 * 64;
    const bf16* ksb = KVb + 2 * KV_TENS + bgoff; const bf16* vsb = KVb + 3 * KV_TENS + bgoff;
    const bf16* kwb = KVb + 4 * KV_TENS + bgoff; const bf16* vwb = KVb + 5 * KV_TENS + bgoff;
    const bf16* kcb = (const bf16*)(F.ws + WS_KC) + (size_t)(b * 2 + g) * 512 * 64;
    const bf16* vcb = (const bf16*)(F.ws + WS_VC) + (size_t)(b * 2 + g) * 512 * 64;
    for (int i = lane; i < 8 * IMP_STR; i += 64) imp[8 * w * IMP_STR + i] = 0.f;
    if (tid < 64) uni[tid] = 0u;
    bf16x8 qf[4];
    { const bf16* Qp = (const bf16*)(F.ws + WS_Q) + ((size_t)(b * 8192 + tpos) * 512 + (4 * g + r) * 64 + 8 * hi);
#pragma unroll
      for (int s = 0; s < 4; ++s) qf[s] = *(const GAS bf16x8*)(Qp + 16 * s); }
    float gate[3];
    { const float* gp = (const float*)(F.ws + WS_G) + (size_t)(b * 8192 + tpos) * 32 + (4 * g + r) * 3; gate[0] = gp[0]; gate[1] = gp[1]; gate[2] = gp[2]; }
    const float bfar = F.in[11][31 * 8 + 4 * g + r] * LOG2E;
    const LAS float* bt = btab + r * NBT;
    LAS float* oaccp = (LAS float*)(lds + L_OACC) + w * 2048 + lane;
    asm volatile("s_waitcnt vmcnt(0)" ::: "memory");
    __syncthreads();

    ATP(F, 1);
    const int nct = (4 * qb + 3 + 63) >> 6;
    const int dcb = tpos - 31;
    const int ncfar = (t0 - 1829) >= 0 ? min(nct, (t0 - 1829) / 1024 + 1) : 0;
    SmState sc; sm_init(sc);
    f32x16 oc[2]; oc[0] = f32x16{}; oc[1] = f32x16{};
    tile_dma(kcb, vcb, false, lds0 + L_RING, w, lane);
    if (nct > 1) { tile_dma(kcb + 4096, vcb, false, lds0 + L_RING + SLOT, w, lane); ATT_WAIT_BAR(1); } else { ATT_WAIT_BAR(0); }
    for (int c = 0, sl = 0; c < nct; ++c) {
        const int sl2 = sl >= SLOT ? sl - SLOT : sl + 2 * SLOT;
        if (c + 2 < nct) tile_dma(kcb + (size_t)(c + 2) * 4096, vcb, false, lds0 + L_RING + sl2, w, lane);
        f32x16 p0, p1; qk_tile(lds + L_RING + sl, qf, c < ncfar ? bfar - sc.m : -sc.m, p0, p1, r32, hi);
        if (c >= ncfar) bias_mask<16>(p0, p1, bt, dcb - 1024 * c, hi);
        sm_rebase<false>(sc, p0, p1, oc, wsf, r32, hi);
        sc.l += exp_sum(p0, p1);
        if (c + 2 < nct) { ATT_WAIT_BAR(1); } else { ATT_WAIT_BAR(0); }
        sl = sl == 2 * SLOT ? 0 : sl + SLOT;
    }
    ATP(F, 2);
    const float lc = xhalf_sum(sc.l);
    const float ilc = lc > 0.f ? 1.0f / lc : 0.f;
    {
        tile_dma(kcb, vcb, true, lds0 + L_RING, w, lane);
        if (nct > 1) { tile_dma(kcb + 4096, vcb + 4096, true, lds0 + L_RING + SLOT, w, lane); ATT_WAIT_BAR(2); } else { ATT_WAIT_BAR(0); }
        for (int c = 0, sl = 0; c < nct; ++c) {
            const int sl2 = sl >= SLOT ? sl - SLOT : sl + 2 * SLOT;
            if (c + 2 < nct) tile_dma(kcb + (size_t)(c + 2) * 4096, vcb + (size_t)(c + 2) * 4096, true, lds0 + L_RING + sl2, w, lane);
            VFrags vf; v_read(vf, lds + L_RING + sl, lane, hi);
            f32x16 p0, p1; qk_tile(lds + L_RING + sl, qf, c < ncfar ? bfar - sc.m : -sc.m, p0, p1, r32, hi);
            if (c >= ncfar) bias_mask<16>(p0, p1, bt, dcb - 1024 * c, hi);
#pragma unroll
            for (int i = 0; i < 16; ++i) { p0[i] = __builtin_amdgcn_exp2f(p0[i]) * ilc; p1[i] = __builtin_amdgcn_exp2f(p1[i]) * ilc; }
#pragma unroll
            for (int a = 0; a < 2; ++a)
#pragma unroll
                for (int u = 0; u < 4; ++u) {
                    const float x0 = a ? p1[4 * u] : p0[4 * u], x1 = a ? p1[4 * u + 1] : p0[4 * u + 1], x2 = a ? p1[4 * u + 2] : p0[4 * u + 2], x3 = a ? p1[4 * u + 3] : p0[4 * u + 3];
                    const float mainv = quad_sum((x0 + x1) + (x2 + 0.5f * x3)), spill = quad_sum(0.5f * x3);
                    const int j = 16 * c + 8 * a + 2 * u + hi;
                    if (r == 0) { (void)__hip_atomic_fetch_add(&imp[(8 * w + qi) * IMP_STR + j], mainv, __ATOMIC_RELAXED, __HIP_MEMORY_SCOPE_WORKGROUP); if (j + 1 < 128) (void)__hip_atomic_fetch_add(&imp[(8 * w + qi) * IMP_STR + j + 1], spill, __ATOMIC_RELAXED, __HIP_MEMORY_SCOPE_WORKGROUP); }
                }
            pv_tile_pre(vf, p0, p1, oc);
            if (c + 2 < nct) { ATT_WAIT_BAR(2); } else { ATT_WAIT_BAR(0); }
            sl = sl == 2 * SLOT ? 0 : sl + SLOT;
        }
    }
    ATP(F, 3);
    for (int pass = 0; pass < 2; ++pass) {
        const int q = 8 * w + 4 * pass + (lane >> 4), t = lane & 15;
        const f32x4 va = *(const LAS f32x4*)(imp + q * IMP_STR + 8 * t), vb = *(const LAS f32x4*)(imp + q * IMP_STR + 8 * t + 4);
        unsigned key[8];
#pragma unroll
        for (int e = 0; e < 8; ++e) { const int j = 8 * t + e; const float v = e < 4 ? va[e] : vb[e - 4];
            const bool val = j <= qb, fo = (j == 0) || (j == qb) || (j == qb - 1);
            key[e] = !val ? 0u : (fo ? 0x7f000000u : __float_as_uint(v) + 1u); }
        unsigned Tt = 0u; bool fin = false;
        for (int bit = 30; bit >= 0; --bit) {
            const unsigned cand = Tt | (1u << bit); int cnt = 0;
#pragma unroll
            for (int e = 0; e < 8; ++e) cnt += (key[e] >= cand) ? 1 : 0;
            cnt += __builtin_amdgcn_update_dpp(0, cnt, 0x128, 0xf, 0xf, true);
            cnt += __builtin_amdgcn_update_dpp(0, cnt, 0x124, 0xf, 0xf, true);
            cnt += __builtin_amdgcn_update_dpp(0, cnt, 0x122, 0xf, 0xf, true);
            cnt += __builtin_amdgcn_update_dpp(0, cnt, 0x121, 0xf, 0xf, true);
            if (!fin && cnt >= 16) { Tt = cand; fin = (cnt == 16); }
            if (__all(fin)) break;
        }
        int ngt = 0, neq = 0;
#pragma unroll
        for (int e = 0; e < 8; ++e) { ngt += (key[e] > Tt) ? 1 : 0; neq += (key[e] == Tt) ? 1 : 0; }
        ngt += __builtin_amdgcn_update_dpp(0, ngt, 0x128, 0xf, 0xf, true); ngt += __builtin_amdgcn_update_dpp(0, ngt, 0x124, 0xf, 0xf, true);
        ngt += __builtin_amdgcn_update_dpp(0, ngt, 0x122, 0xf, 0xf, true); ngt += __builtin_amdgcn_update_dpp(0, ngt, 0x121, 0xf, 0xf, true);
        const int need = 16 - ngt;
        int inc = neq;
        inc += __builtin_amdgcn_update_dpp(0, inc, 0x111, 0xf, 0xf, true);
        inc += __builtin_amdgcn_update_dpp(0, inc, 0x112, 0xf, 0xf, true);
        inc += __builtin_amdgcn_update_dpp(0, inc, 0x114, 0xf, 0xf, true);
        inc += __builtin_amdgcn_update_dpp(0, inc, 0x118, 0xf, 0xf, true);
        int pre = inc - neq; unsigned bits = 0u;
#pragma unroll
        for (int e = 0; e < 8; ++e) { const bool eq = key[e] == Tt; const bool sel = (key[e] != 0u) && ((key[e] > Tt) || (eq && pre < need)); pre += eq ? 1 : 0; bits |= sel ? (1u << e) : 0u; }
        unsigned word = bits << ((t & 3) * 8);
        word |= (unsigned)__builtin_amdgcn_update_dpp(0, (int)word, 0xB1, 0xf, 0xf, true);
        word |= (unsigned)__builtin_amdgcn_update_dpp(0, (int)word, 0x4E, 0xf, 0xf, true);
        if ((t & 3) == 0) { selm[q * 4 + (t >> 2)] = word; (void)__hip_atomic_fetch_or(&uni[w * 4 + (t >> 2)], word, __ATOMIC_RELAXED, __HIP_MEMORY_SCOPE_WORKGROUP); (void)__hip_atomic_fetch_or(&uni[32 + (t >> 2)], word, __ATOMIC_RELAXED, __HIP_MEMORY_SCOPE_WORKGROUP); }
    }
    __syncthreads();
    { float f[16]; row_to_regs(wsf, gate[0], f, r32, hi);
#pragma unroll
      for (int i = 0; i < 16; ++i) { oaccp[i * 64] = oc[0][i] * f[i]; oaccp[(16 + i) * 64] = oc[1][i] * f[i]; } }
    unsigned mym[4], bu[4], wuv[4];
#pragma unroll
    for (int k = 0; k < 4; ++k) { mym[k] = selm[(8 * w + qi) * 4 + k]; bu[k] = __builtin_amdgcn_readfirstlane(uni[32 + k]); wuv[k] = __builtin_amdgcn_readfirstlane(uni[w * 4 + k]); }
    ATP(F, 4);
#ifndef REP_SEL
#define REP_SEL 1
#endif
#ifndef REP_WIN
#define REP_WIN 1
#endif
#ifndef REP_CMP
#define REP_CMP 1
#endif
    for (int rep_ = 0; rep_ < REP_SEL; ++rep_) {
        f32x16 o[2]; o[0] = f32x16{}; o[1] = f32x16{}; SmState ss; sm_init(ss);
#define NEXT_SEL(from, dst) do { const int f_ = (from); int r_ = -1; for (int j_ = f_; j_ <= qb; ++j_) if ((bu[j_ >> 5] >> (j_ & 31)) & 1u) { r_ = j_; break; } dst = r_; } while (0)
#define SEL_DMA(j, slot) tile_dma(ksb + (size_t)(j) * 4096, vsb + (size_t)(j) * 4096, true, lds0 + L_RING + (slot) * SLOT, w, lane)
#define SEL_DO(j, slot) do { if ((j) >= 0 && (((wuv[(j) >> 5] >> ((j) & 31)) & 1u) != 0u)) { \
            const bool mine = (mym[(j) >> 5] >> ((j) & 31)) & 1u; const bool nearj = qb - (j) < 14; const LAS unsigned char* tb_ = lds + L_RING + (slot) * SLOT; \
            VFrags vf; v_read(vf, tb_, lane, hi); \
            f32x16 p0, p1; qk_tile(tb_, qf, mine ? (nearj ? -ss.m - bfar : -ss.m) : NEG_INF, p0, p1, r32, hi); \
            if (nearj) bias_near_mode(p0, p1, bt + (BT0 - (tpos - 64 * (j))) + 4 * hi, tpos - 64 * (j), hi, (j) == qb ? 1 : 0); \
            sm_rebase<true>(ss, p0, p1, o, wsf, r32, hi); \
            ss.l += exp_sum(p0, p1); \
            pv_tile_pre(vf, p0, p1, o); } } while (0)
        int a0, a1 = -1, nx = -1;
        NEXT_SEL(0, a0); if (a0 >= 0) NEXT_SEL(a0 + 1, a1); if (a1 >= 0) NEXT_SEL(a1 + 1, nx);
        if (a0 >= 0) SEL_DMA(a0, 0); if (a1 >= 0) SEL_DMA(a1, 1);
        ATT_WAIT_BAR(0);
        int pb = 0;
        while (a0 >= 0) {
            int b0 = nx, b1 = -1; if (b0 >= 0) NEXT_SEL(b0 + 1, b1); nx = -1; if (b1 >= 0) NEXT_SEL(b1 + 1, nx);
            const int cs = pb ? 2 : 0, ns = pb ? 0 : 2;
            if (b0 >= 0) SEL_DMA(b0, ns); if (b1 >= 0) SEL_DMA(b1, ns + 1);
            SEL_DO(a0, cs); SEL_DO(a1, cs + 1);
            ATT_WAIT_BAR(0);
            a0 = b0; a1 = b1; pb ^= 1;
        }
#undef SEL_DMA
#undef SEL_DO
#undef NEXT_SEL
        const float ls = xhalf_sum(ss.l);
        float f[16]; row_to_regs(wsf, ls > 0.f ? gate[1] / (ls * REP_SEL) : 0.f, f, r32, hi);
#pragma unroll
        for (int i = 0; i < 16; ++i) { oaccp[i * 64] += o[0][i] * f[i]; oaccp[(16 + i) * 64] += o[1][i] * f[i]; }
    }
    ATP(F, 5);
    {
        f32x16 o[2]; o[0] = f32x16{}; o[1] = f32x16{}; SmState sw; sm_init(sw);
        const int jf = qb >= 8 ? qb - 8 : 0;
#define WIN_DMA(j, slot) tile_dma(kwb + (size_t)(j) * 4096, vwb + (size_t)(j) * 4096, true, lds0 + L_RING + (slot) * SLOT, w, lane)
#define WIN_DO(j, slot) do { if ((j) <= qb) { const LAS unsigned char* tb_ = lds + L_RING + (slot) * SLOT; \
            VFrags vf; v_read(vf, tb_, lane, hi); \
            f32x16 p0, p1; qk_tile(tb_, qf, -sw.m, p0, p1, r32, hi); \
            bias_near_mode(p0, p1, bt + (BT0 - (tpos - 64 * (j))) + 4 * hi, tpos - 64 * (j), hi, (j) == qb ? 1 : ((j) == qb - 8 ? 2 : 0)); \
            sm_rebase<true>(sw, p0, p1, o, wsf, r32, hi); \
            sw.l += exp_sum(p0, p1); \
            pv_tile_pre(vf, p0, p1, o); } } while (0)
        WIN_DMA(jf, 0); if (jf + 1 <= qb) WIN_DMA(jf + 1, 1);
        ATT_WAIT_BAR(0);
        for (int j = jf, pb = 0; j <= qb; j += 2, pb ^= 1) {
            const int cs = pb ? 2 : 0, ns = pb ? 0 : 2;
            if (j + 2 <= qb) WIN_DMA(j + 2, ns); if (j + 3 <= qb) WIN_DMA(j + 3, ns + 1);
            WIN_DO(j, cs); WIN_DO(j + 1, cs + 1);
            ATT_WAIT_BAR(0);
        }
#undef WIN_DMA
#undef WIN_DO
        const float lw = xhalf_sum(sw.l);
        float f[16]; row_to_regs(wsf, lw > 0.f ? gate[2] / lw : 0.f, f, r32, hi);
#pragma unroll
        for (int i = 0; i < 16; ++i) { o[0][i] = oaccp[i * 64] + o[0][i] * f[i]; o[1][i] = oaccp[(16 + i) * 64] + o[1][i] * f[i]; }
        asm volatile("" ::: "memory");
        LAS unsigned short* stg = (LAS unsigned short*)(lds + L_OACC + w * 8192);
#pragma unroll
        for (int i = 0; i < 16; ++i) { const int orow = (i & 3) + 8 * (i >> 2) + 4 * hi;
            stg[orow * 64 + r32] = (unsigned short)f2bf(o[0][i]); stg[orow * 64 + 32 + r32] = (unsigned short)f2bf(o[1][i]); }
        LDS_WAIT();
        bf16* MIX = (bf16*)(F.ws + WS_MIX);
#pragma unroll
        for (int i = 0; i < 4; ++i) { const int row = i * 8 + (lane >> 3), ch = lane & 7; const v4u v = *(const LAS v4u*)(stg + row * 64 + ch * 8);
            *(GAS v4u*)(MIX + (size_t)(b * 8192 + t0 + 8 * w + (row >> 2)) * 1024 + (4 * g + (row & 3)) * 64 + ch * 8) = v; }
    }
    __syncthreads();
    ATP(F, 6);
}
}

__device__ __forceinline__ void p4_phase(Frame& F) {
    ATP(F, 20);
    {
        const bf16* Z = (const bf16*)(F.ws + WS_Z); const bf16* BG = (const bf16*)(F.ws + WS_BG); bf16* MIX = (bf16*)(F.ws + WS_MIX);
        const float* cw = F.in[12];
        const int ch = F.tid & 63, rsub = F.tid >> 6;
        f32x4 w0a = *(const f32x4*)(cw + 8 * ch), w0b = *(const f32x4*)(cw + 8 * ch + 4), w1a = *(const f32x4*)(cw + 512 + 8 * ch), w1b = *(const f32x4*)(cw + 512 + 8 * ch + 4), w2a = *(const f32x4*)(cw + 1024 + 8 * ch), w2b = *(const f32x4*)(cw + 1024 + 8 * ch + 4);
        for (int rb = blockIdx.x; rb < M / 8; rb += F.G) {
            const int row = 8 * rb + rsub, t = row & 8191;
            const v4u z2 = *(const GAS v4u*)(Z + (size_t)row * 512 + 8 * ch);
            v4u z1 = (v4u){0u, 0u, 0u, 0u}, z0 = (v4u){0u, 0u, 0u, 0u};
            if (t >= 1) z1 = *(const GAS v4u*)(Z + (size_t)(row - 1) * 512 + 8 * ch);
            if (t >= 2) z0 = *(const GAS v4u*)(Z + (size_t)(row - 2) * 512 + 8 * ch);
            const v4u bg = *(const GAS v4u*)(BG + (size_t)row * 512 + 8 * ch);
            float o[8];
#define CV(k, comp, sh, wa, wi) o[k] = bf2f((unsigned short)((bg.comp >> sh) & 0xffff)) * (w0##wa[wi] * bf2f((unsigned short)((z0.comp >> sh) & 0xffff)) + w1##wa[wi] * bf2f((unsigned short)((z1.comp >> sh) & 0xffff)) + w2##wa[wi] * bf2f((unsigned short)((z2.comp >> sh) & 0xffff)))
            CV(0, x, 0, a, 0); CV(1, x, 16, a, 1); CV(2, y, 0, a, 2); CV(3, y, 16, a, 3); CV(4, z, 0, b, 0); CV(5, z, 16, b, 1); CV(6, w, 0, b, 2); CV(7, w, 16, b, 3);
#undef CV
            v4u ov; ov.x = pk2(o[0], o[1]); ov.y = pk2(o[2], o[3]); ov.z = pk2(o[4], o[5]); ov.w = pk2(o[6], o[7]);
            *(GAS v4u*)(MIX + (size_t)row * 1024 + 512 + 8 * ch) = ov;
        }
    }
    asm volatile("s_waitcnt vmcnt(0)" ::: "memory");
    ATP(F, 21);
    if (F.G == 256) {
        att::build_btab(F, (int)(blockIdx.x & 1));
        static constexpr unsigned char QBTAB[128] = {118,92,63,0,113,98,58,1,114,91,60,2,125,81,57,4,112,84,64,3,126,69,61,6,127,70,62,5,122,74,56,7,115,67,55,14,124,66,54,12,121,73,53,9,123,68,51,13,120,76,52,8,119,75,50,11,108,79,44,18,116,78,43,16,107,71,48,21,110,77,46,17,111,72,47,19,109,82,45,15,117,65,49,20,103,101,42,10,97,87,41,22,104,83,37,24,102,80,36,28,106,59,40,38,100,86,35,26,105,96,27,25,99,85,39,23,93,90,34,29,94,89,33,30,95,88,32,31};
        const int bg = blockIdx.x & 7, s_ = blockIdx.x >> 3;
#pragma unroll 1
        for (int i = 0; i < 4; ++i) att::attn_item(F, bg >> 1, bg & 1, (int)QBTAB[4 * s_ + i]);
    } else {
        for (int rd = 0; rd * F.G < 1024; ++rd) {
            const int pos = (rd & 1) ? (F.G - 1 - (int)blockIdx.x) : (int)blockIdx.x;
            const int k = rd * F.G + pos; if (k >= 1024) continue;
            att::build_btab(F, k & 1);
            att::attn_item(F, (k & 7) >> 1, k & 1, 127 - (k >> 3));
        }
    }
}

struct Args { const float* in[20]; float* out; unsigned char* ws; int ph_lo, ph_hi; };
__global__ void __launch_bounds__(NWAVES * 64, 2) mk_fwd(Args args) {
    extern __shared__ __attribute__((aligned(16))) unsigned char lds[];
    Frame F;
    F.lds = (LAS unsigned char*)lds;
    F.MISC = (volatile LAS unsigned*)(F.lds + MISC_OFF);
    F.tid = threadIdx.x; F.lane = F.tid & 63; F.wave = __builtin_amdgcn_readfirstlane(F.tid >> 6);
    F.G = gridDim.x; { const int bx = blockIdx.x; F.vcu = (F.G % 8 == 0) ? (bx % 8) * (F.G / 8) + bx / 8 : bx; }
    F.tp_t0 = 0; F.tp_acc = 0; F.ws = args.ws; F.out = args.out; F.ctl = (gu32*)(args.ws + WS_CTL);
#pragma unroll
    for (int i = 0; i < 20; ++i) F.in[i] = args.in[i];
    for (int u = F.tid; u < (LDS_BYTES - LDSCTL_OFF) / 4; u += NWAVES * 64) ((LAS unsigned*)(F.lds + LDSCTL_OFF))[u] = 0u;
    __syncthreads();
    const int lo = args.ph_lo, hi = args.ph_hi;
    const bool one = (hi - lo) > 1;
    XcdBarrier bar; bar.bar = (unsigned*)(F.ctl + CW_BAR); bar.x = 0; bar.st = nullptr;
    if (one) bar = xcd_barrier_post((unsigned*)(F.ctl + CW_BAR), F.MISC + 8);
#ifdef ONLY_PHASE
#define IN(k) ((k) == ONLY_PHASE && lo <= (k) && (k) < hi)
#else
#define IN(k) (lo <= (k) && (k) < hi)
#endif
#ifndef REP_MASK
#define REP_MASK 0
#endif
#define REPS(k) for (int rep_ = 0; rep_ < 1 + ((REP_MASK >> (k)) & 1); ++rep_)
#define SEAM(k) do { if (IN(k) && IN((k) + 1)) xcd_barrier(bar); } while (0)
    unsigned char* ws = args.ws;
#ifdef PROBE_PHASE
    unsigned long long tp0_ = 0, tp1_ = 0;
#define TPS(k) do { if ((k) == PROBE_PHASE) tp0_ = __builtin_amdgcn_s_memrealtime(); if ((k) == PROBE_END) tp1_ = __builtin_amdgcn_s_memrealtime(); } while (0)
#else
#define TPS(k) do {} while (0)
#endif
#ifdef UBENCH
    if (blockIdx.x == 0 && IN(0)) {
        __syncthreads();
        const unsigned long long t0 = __builtin_amdgcn_s_memrealtime();
        f32x16 a0 = {}, a1 = {}; bf16x8 x = (bf16x8){1, 2, 3, 4, 5, 6, 7, 8}; asm volatile("" : "+v"(x));
        float v0 = (float)F.tid, v1 = v0 + 1.f, v2 = v0 + 2.f, v3 = v0 + 3.f, v4 = v0 * 0.5f, v5 = v0 * 0.25f, v6 = 1.f, v7 = 2.f;
        if (UBENCH == 4) { if (F.wave < 4) { for (int i = 0; i < 2048; ++i) { a0 = __builtin_amdgcn_mfma_f32_32x32x16_bf16(x, x, a0, 0, 0, 0);
                v0 = v0 * 1.0001f + 0.5f; v1 = v1 * 1.0001f + 0.5f; v2 = v2 * 1.0001f + 0.5f; v3 = v3 * 1.0001f + 0.5f; v4 = v4 * 1.0001f + 0.5f; v5 = v5 * 1.0001f + 0.5f; v6 = v6 * 1.0001f + 0.5f; v7 = v7 * 1.0001f + 0.5f;
                __builtin_amdgcn_sched_barrier(0);
                a1 = __builtin_amdgcn_mfma_f32_32x32x16_bf16(x, x, a1, 0, 0, 0);
                v0 = v0 * 1.0001f + 0.5f; v1 = v1 * 1.0001f + 0.5f; v2 = v2 * 1.0001f + 0.5f; v3 = v3 * 1.0001f + 0.5f; v4 = v4 * 1.0001f + 0.5f; v5 = v5 * 1.0001f + 0.5f; v6 = v6 * 1.0001f + 0.5f; v7 = v7 * 1.0001f + 0.5f;
                __builtin_amdgcn_sched_barrier(0); } } }
        else if (F.wave < 4) { if (UBENCH & 1) { for (int i = 0; i < 2048; ++i) { a0 = __builtin_amdgcn_mfma_f32_32x32x16_bf16(x, x, a0, 0, 0, 0); a1 = __builtin_amdgcn_mfma_f32_32x32x16_bf16(x, x, a1, 0, 0, 0); } } }
        else { if (UBENCH & 2) { for (int i = 0; i < 4096; ++i) { v0 = v0 * 1.0001f + 0.5f; v1 = v1 * 1.0001f + 0.5f; v2 = v2 * 1.0001f + 0.5f; v3 = v3 * 1.0001f + 0.5f; v4 = v4 * 1.0001f + 0.5f; v5 = v5 * 1.0001f + 0.5f; v6 = v6 * 1.0001f + 0.5f; v7 = v7 * 1.0001f + 0.5f; } } }
        asm volatile("" :: "v"(a0), "v"(a1), "v"(v0), "v"(v1), "v"(v2), "v"(v3), "v"(v4), "v"(v5), "v"(v6), "v"(v7));
        __syncthreads();
        const unsigned long long t1 = __builtin_amdgcn_s_memrealtime();
        F.tp_acc = t1 - t0;
    }
#endif
    TPS(0);
    if (IN(0)) { REPS(0) p0_phase(F); ATP(F, 62); SEAM(0); ATP(F, 63); }
    TPS(1);
    if (IN(1)) { REPS(1) p1_phase(F); SEAM(1); }
#ifdef XTRA_BAR
    for (int xb_ = 0; xb_ < XTRA_BAR; ++xb_) xcd_barrier(bar);
#endif
    TPS(2);
    if (IN(2)) {
        pg8::Gemm g{(const pg8::bf16_t*)(ws + WS_H), (const pg8::bf16_t*)(ws + WS_WIN), M, NIN, D}; pg8::StaticOrder S; S.init(M, NIN, F.G, (int)blockIdx.x);
        pg8::EpiInProj E{(pg8::bf16_t*)(ws + WS_Q), (pg8::bf16_t*)(ws + WS_KV), (pg8::bf16_t*)(ws + WS_Z), (pg8::bf16_t*)(ws + WS_BG), (float*)(ws + WS_G), F.in[3], F.in[4]};
        pg8::gemm_phase<pg8::EpiInProj, pg8::StaticOrder, true, true>(F.lds, g, S, E);
#ifdef DUP_P2
        pg8::gemm_phase<pg8::EpiInProj, pg8::StaticOrder, true, true>(F.lds, g, S, E);
#endif
        SEAM(2);
    }
    TPS(3);
    if (IN(3)) { REPS(3) p3_phase(F); SEAM(3); }
    TPS(4);
    if (IN(4)) { REPS(4) p4_phase(F); ATP(F, 50); SEAM(4); ATP(F, 51); }
    TPS(5);
    if (IN(5)) {
        pg8::Gemm g{(const pg8::bf16_t*)(ws + WS_MIX), (const pg8::bf16_t*)(ws + WS_WOUT), M, D, D}; pg8::StaticOrder S; S.init(M, D, F.G, (int)blockIdx.x);
        pg8::EpiOutProj E{F.in[0], (pg8::bf16_t*)(ws + WS_X1B), (pg8::bf16_t*)(ws + WS_A2), (float*)(ws + WS_RSS), (const float*)(ws + WS_MOD), F.in[15]};
        REPS(5) pg8::gemm_phase<pg8::EpiOutProj, pg8::StaticOrder, true, true>(F.lds, g, S, E);
        SEAM(5);
    }
    TPS(6);
    if (IN(6)) {
        pg8::Gemm g{(const pg8::bf16_t*)(ws + WS_A2), (const pg8::bf16_t*)(ws + WS_W1), M, FF, D}; pg8::StaticOrder S; S.init(M, FF, F.G, (int)blockIdx.x);
        pg8::EpiFF1 E{(pg8::bf16_t*)(ws + WS_HID), (const float*)(ws + WS_RSS), (const float*)(ws + WS_BFF1)};
        REPS(6) pg8::gemm_phase<pg8::EpiFF1, pg8::StaticOrder, true, true>(F.lds, g, S, E);
        SEAM(6);
    }
    TPS(7);
    if (IN(7)) {
        pg8::Gemm g{(const pg8::bf16_t*)(ws + WS_HID), (const pg8::bf16_t*)(ws + WS_W2), M, D, FF}; pg8::StaticOrder S; S.init(M, D, F.G, (int)blockIdx.x);
#ifdef DUP_P7
        { pg8::EpiFF2 E0{(const pg8::bf16_t*)(ws + WS_X1B), (const float*)(ws + WS_MOD), (float*)(ws + (size_t)100 * MiB)};
          pg8::gemm_phase<pg8::EpiFF2, pg8::StaticOrder, true, true>(F.lds, g, S, E0); }
#endif
        pg8::EpiFF2 E{(const pg8::bf16_t*)(ws + WS_X1B), (const float*)(ws + WS_MOD), F.out};
        pg8::gemm_phase<pg8::EpiFF2, pg8::StaticOrder, true, true>(F.lds, g, S, E);
    }
    TPS(8);
#ifndef PROBE_BLK
#define PROBE_BLK 0
#endif
#if defined(ATP_A) || defined(UBENCH)
#ifndef ATP_MULT
#define ATP_MULT 8
#endif
    if (blockIdx.x == PROBE_BLK && F.tid == 0) { const unsigned long long until = __builtin_amdgcn_s_memrealtime() + (unsigned long long)ATP_MULT * F.tp_acc;
        while (__builtin_amdgcn_s_memrealtime() < until) __builtin_amdgcn_s_sleep(8); }
#endif
#ifdef PROBE_PHASE
    if (blockIdx.x == 0 && F.tid == 0) { const unsigned long long until = __builtin_amdgcn_s_memrealtime() + (unsigned long long)PROBE_MULT * (tp1_ - tp0_);
        while (__builtin_amdgcn_s_memrealtime() < until) __builtin_amdgcn_s_sleep(8); }
#endif
#undef IN
#undef SEAM
}

extern "C" void kernel_launch(void* const* d_in, const int* in_sizes, int n_in, void* d_out, int out_size, void* d_ws, size_t ws_size, hipStream_t stream) {
    static int grid = 0;
    if (grid == 0) {
        if (n_in != 20 || in_sizes[0] != M * D || out_size != M * D || ws_size < WS_END) { fprintf(stderr, "kernel_launch: unexpected problem shape (n_in %d, in0 %d, out %d, ws %zu)\n", n_in, n_in > 0 ? in_sizes[0] : -1, out_size, ws_size); grid = -1; return; }
        int dev = 0, cus = 0, per_cu = 0;
        if (hipGetDevice(&dev) != hipSuccess || hipDeviceGetAttribute(&cus, hipDeviceAttributeMultiprocessorCount, dev) != hipSuccess) { grid = -1; return; }
        if (hipFuncSetAttribute((const void*)mk_fwd, hipFuncAttributeMaxDynamicSharedMemorySize, LDS_BYTES) != hipSuccess) { fprintf(stderr, "kernel_launch: hipFuncSetAttribute failed\n"); grid = -1; return; }
        if (hipOccupancyMaxActiveBlocksPerMultiprocessor(&per_cu, (const void*)mk_fwd, NWAVES * 64, LDS_BYTES) != hipSuccess || per_cu < 1) { fprintf(stderr, "kernel_launch: occupancy query says %d blocks per CU\n", per_cu); (void)hipGetLastError(); per_cu = 1; }
        grid = cus * 1;
        if (per_cu < 1) grid = -1;
    }
    if (grid < 0) return;
    (void)hipMemsetAsync((char*)d_ws + WS_CTL, 0, CTL_ZERO_BYTES, stream);
    Args a{};
    for (int i = 0; i < 20; ++i) a.in[i] = (const float*)d_in[i];
    a.out = (float*)d_out; a.ws = (unsigned char*)d_ws;
    if (MK_N_LAUNCHES == 1) {
        a.ph_lo = 0; a.ph_hi = N_PHASES;
        void* kargs[] = {&a};
        hipError_t e = hipLaunchCooperativeKernel((const void*)mk_fwd, dim3(grid), dim3(NWAVES * 64), kargs, LDS_BYTES, stream);
        if (e != hipSuccess) fprintf(stderr, "kernel_launch: cooperative launch failed: %s (grid %d)\n", hipGetErrorString(e), grid);
    } else {
        for (int p = 0; p < N_PHASES; ++p) { a.ph_lo = p; a.ph_hi = p + 1; hipLaunchKernelGGL(mk_fwd, dim3(grid), dim3(NWAVES * 64), LDS_BYTES, stream, a); }
    }
}
```

```cpp
#include <hip/hip_runtime.h>
#include <hip/hip_bf16.h>
#include <cstdio>
#include <cstdint>
#include <cmath>
namespace pg8 {
#define PG8_LAS __attribute__((address_space(3)))
typedef unsigned short bf16_t;
typedef short bf16x8 __attribute__((ext_vector_type(8)));
typedef float f32x4 __attribute__((ext_vector_type(4)));
typedef unsigned u32x4 __attribute__((ext_vector_type(4)));
constexpr int BM = 256, BK = 64, HALF = 128, HTB = HALF * BK * 2  , STAGE_BYTES = 8 * HTB, NXCD = 8, WGM = 8;

__host__ __device__ __forceinline__ int lds_byte(int r, int c) { const int st = (r >> 4) * 2 + (c >> 5), rr = r & 15, cc = c & 31, ob = rr * 64 + cc * 2; return st * 1024 + (ob ^ (((ob >> 9) & 1) << 5)); }
__host__ __device__ __forceinline__ void stage_rc(int b, int& R, int& C) { const int st = b / 1024, sb = b % 1024, swz = sb ^ (((sb >> 9) & 1) << 5); R = (st >> 1) * 16 + swz / 64; C = (st & 1) * 32 + (swz % 64) / 2; }
__host__ __device__ __forceinline__ int perm32(int rho) { const int n = rho >> 4, i = rho & 15; return 8 * (i >> 2) + 4 * n + (i & 3); }

struct Unit { int pm, pn; };
struct Gemm { const bf16_t* A; const bf16_t* Bt; int M, N, K; };

struct StaticOrder {
    int nM, nN, nwg, G, c;
    __host__ __device__ void init(int M, int N, int G_, int c_) { nM = M / BM; nN = N / BM; nwg = nM * nN; G = G_; c = c_; }
    __host__ __device__ bool next(int i, Unit& u) const {
        const long L = (long)i * G + c; if (L >= nwg) return false;
        int wgid = (int)L; { const int q = nwg / NXCD, r = nwg % NXCD, xcd = wgid % NXCD, off = wgid / NXCD; wgid = (xcd < r ? xcd * (q + 1) : r * (q + 1) + (xcd - r) * q) + off; }
        const int nig = WGM * nN, gid = wgid / nig, fm = gid * WGM, gsz = (nM - fm) < WGM ? (nM - fm) : WGM;
        u.pm = fm + ((wgid % nig) % gsz); u.pn = (wgid % nig) / gsz; return true;
    }
    __device__ __forceinline__ void a_ready(const Unit&) const {}
    __device__ __forceinline__ void done(const Unit&) const {}
};

__device__ __forceinline__ unsigned cvt_pk_bf16(float lo, float hi) { unsigned r; asm volatile("v_cvt_pk_bf16_f32 %0, %1, %2" : "=v"(r) : "v"(lo), "v"(hi)); return r; }
typedef float f32x2 __attribute__((ext_vector_type(2)));
template <class Epi, class Sched, bool ALIGN_EPI = false, bool SP2 = false>
__device__ __forceinline__ void gemm_phase(PG8_LAS unsigned char* lds, const Gemm g, const Sched& S, const Epi& E) {
    const int tid = threadIdx.x, wid = __builtin_amdgcn_readfirstlane(tid >> 6), lane = tid & 63, wr = wid >> 2, wc = wid & 3, fr = lane & 15, fq = lane >> 4;
    const int K = g.K, nt = K / BK;
    unsigned voffA[2], voffB[2];
#pragma unroll
    for (int i = 0; i < 2; ++i) { int R, C; stage_rc(tid * 16 + i * 8192, R, C); const int Rb = Epi::PERM ? ((R & ~31) + perm32(R & 31)) : R;
        voffA[i] = (unsigned)(R * K + C) * 2u; voffB[i] = (unsigned)(Rb * K + C) * 2u; }
    const size_t kstep = (size_t)(BK * 2);
    const size_t hstep = (size_t)HALF * K * 2;
    const size_t tstep = 2 * hstep;
    const unsigned ldsw = (unsigned)wid * 1024u;
    const int aoff = lds_byte(wr * 64 + fr, fq * 8), boff = lds_byte(wc * 32 + fr, fq * 8);
#define PG8_SA(b, h) (((b) * 2 + (h)) * HTB)
#define PG8_SB(b, h) ((4 + (b) * 2 + (h)) * HTB)
#define PG8_STAGE(bufoff, gbase, voff) do { _Pragma("unroll") for (int _i = 0; _i < 2; ++_i) \
        __builtin_amdgcn_global_load_lds((const unsigned*)((const char*)(gbase) + (voff)[_i]), (PG8_LAS unsigned*)(lds + (bufoff) + ldsw + _i * 8192), 16, 0, 0); } while (0)
#define PG8_LDA(dst, b, h) do { _Pragma("unroll") for (int m = 0; m < 4; ++m) _Pragma("unroll") for (int k = 0; k < 2; ++k) dst[m][k] = *(const PG8_LAS bf16x8*)(lds + PG8_SA(b, h) + aoff + m * 2048 + k * 1024); } while (0)
#define PG8_LDB(dst, b, h) do { _Pragma("unroll") for (int n = 0; n < 2; ++n) _Pragma("unroll") for (int k = 0; k < 2; ++k) dst[n][k] = *(const PG8_LAS bf16x8*)(lds + PG8_SB(b, h) + boff + n * 2048 + k * 1024); } while (0)
#define PG8_MMA(ai, bj, At, Bt) do { __builtin_amdgcn_s_setprio(1); _Pragma("unroll") for (int m = 0; m < 4; ++m) _Pragma("unroll") for (int n = 0; n < 2; ++n) _Pragma("unroll") for (int k = 0; k < 2; ++k) \
        acc[ai][bj][m][n] = __builtin_amdgcn_mfma_f32_16x16x32_bf16(Bt[n][k], At[m][k], acc[ai][bj][m][n], 0, 0, 0); __builtin_amdgcn_s_setprio(0); } while (0)
#define PG8_WAIT_V(n) asm volatile("s_waitcnt vmcnt(" #n ")" ::: "memory")
#define PG8_WAIT_L(n) asm volatile("s_waitcnt lgkmcnt(" #n ")" ::: "memory")
#define PG8_BAR __builtin_amdgcn_s_barrier()
#define PG8_SCHED __builtin_amdgcn_sched_barrier(0)
    Unit cur, nxt; int ui = 0;
    if (!S.next(0, cur)) return;
    f32x4 acc[2][2][4][2];
#pragma unroll
    for (int a = 0; a < 2; ++a)
#pragma unroll
        for (int b = 0; b < 2; ++b)
#pragma unroll
            for (int m = 0; m < 4; ++m)
#pragma unroll
                for (int n = 0; n < 2; ++n) acc[a][b][m][n] = (f32x4){0.f, 0.f, 0.f, 0.f};
    bf16x8 At[4][2], B0[2][2], B1[2][2];
    const char* cA = (const char*)g.A + (size_t)cur.pm * tstep; const char* cB = (const char*)g.Bt + (size_t)cur.pn * tstep;
    S.a_ready(cur);
    if constexpr (SP2) {
        PG8_STAGE(PG8_SB(0, 0), cB, voffB); PG8_STAGE(PG8_SB(0, 1), cB + hstep, voffB); PG8_STAGE(PG8_SA(0, 0), cA, voffA); PG8_STAGE(PG8_SA(0, 1), cA + hstep, voffA);
        if (wr == 1) PG8_BAR;
        PG8_WAIT_V(2); PG8_BAR;
        PG8_STAGE(PG8_SB(1, 0), cB + kstep, voffB); PG8_STAGE(PG8_SA(1, 0), cA + kstep, voffA); PG8_STAGE(PG8_SB(1, 1), cB + hstep + kstep, voffB);
        PG8_WAIT_V(6); PG8_BAR;
    } else {
        PG8_STAGE(PG8_SB(0, 0), cB, voffB); PG8_STAGE(PG8_SA(0, 0), cA, voffA); PG8_STAGE(PG8_SB(0, 1), cB + hstep, voffB); PG8_STAGE(PG8_SA(0, 1), cA + hstep, voffA);
        if (wr == 1) PG8_BAR;
        PG8_WAIT_V(4); PG8_BAR;
        PG8_STAGE(PG8_SB(1, 0), cB + kstep, voffB); PG8_STAGE(PG8_SA(1, 0), cA + kstep, voffA); PG8_STAGE(PG8_SB(1, 1), cB + hstep + kstep, voffB);
        PG8_WAIT_V(6); PG8_BAR;
    }
    for (;;) {
        const bool has_next = S.next(ui + 1, nxt);
        const char* nA = has_next ? (const char*)g.A + (size_t)nxt.pm * tstep : cA; const char* nB = has_next ? (const char*)g.Bt + (size_t)nxt.pn * tstep : cB;
        for (int t = 0; t < nt; t += 2) {
            const bool last = (t == nt - 2);
            const char* a1 = cA + (size_t)(t + 1) * kstep;
            const char* a2 = last ? nA : cA + (size_t)(t + 2) * kstep; const char* b2 = last ? nB : cB + (size_t)(t + 2) * kstep;
            const char* a3 = a2 + kstep; const char* b3 = b2 + kstep;
            if (last && has_next) S.a_ready(nxt);
            if constexpr (SP2) {
            PG8_LDB(B0, 0, 0); PG8_LDB(B1, 0, 1); PG8_SCHED; PG8_LDA(At, 0, 0); PG8_STAGE(PG8_SA(1, 1), a1 + hstep, voffA);
            PG8_WAIT_V(8); PG8_WAIT_L(0); PG8_BAR; PG8_MMA(0, 0, At, B0); PG8_MMA(0, 1, At, B1); PG8_BAR; PG8_SCHED;
            PG8_LDA(At, 0, 1); PG8_STAGE(PG8_SB(0, 0), b2, voffB); PG8_STAGE(PG8_SB(0, 1), b2 + hstep, voffB); PG8_STAGE(PG8_SA(0, 0), a2, voffA);
            PG8_WAIT_V(8); PG8_WAIT_L(0); PG8_BAR; PG8_MMA(1, 0, At, B0); PG8_MMA(1, 1, At, B1); PG8_BAR; PG8_SCHED;
            PG8_LDB(B0, 1, 0); PG8_LDB(B1, 1, 1); PG8_SCHED; PG8_LDA(At, 1, 0); PG8_STAGE(PG8_SA(0, 1), a2 + hstep, voffA);
            PG8_WAIT_V(8); PG8_WAIT_L(0); PG8_BAR; PG8_MMA(0, 0, At, B0); PG8_MMA(0, 1, At, B1); PG8_BAR; PG8_SCHED;
            PG8_LDA(At, 1, 1); PG8_STAGE(PG8_SB(1, 0), b3, voffB); PG8_STAGE(PG8_SB(1, 1), b3 + hstep, voffB); PG8_STAGE(PG8_SA(1, 0), a3, voffA);
            PG8_WAIT_V(8); PG8_WAIT_L(0); PG8_BAR; PG8_MMA(1, 0, At, B0); PG8_MMA(1, 1, At, B1); PG8_BAR; PG8_SCHED;
            } else {
            PG8_LDB(B0, 0, 0); PG8_SCHED; PG8_LDA(At, 0, 0); PG8_STAGE(PG8_SA(1, 1), a1 + hstep, voffA);
            PG8_WAIT_L(8); PG8_BAR; PG8_WAIT_L(0); PG8_MMA(0, 0, At, B0); PG8_BAR; PG8_SCHED;
            PG8_LDB(B1, 0, 1); PG8_STAGE(PG8_SB(0, 0), b2, voffB);
            PG8_BAR; PG8_WAIT_L(0); PG8_MMA(0, 1, At, B1); PG8_BAR;
            PG8_LDA(At, 0, 1); PG8_STAGE(PG8_SA(0, 0), a2, voffA);
            PG8_BAR; PG8_WAIT_L(0); PG8_MMA(1, 0, At, B0); PG8_BAR; PG8_SCHED;
            PG8_STAGE(PG8_SB(0, 1), b2 + hstep, voffB);
            PG8_WAIT_V(6); PG8_BAR; PG8_MMA(1, 1, At, B1); PG8_BAR;
            PG8_LDB(B0, 1, 0); PG8_SCHED; PG8_LDA(At, 1, 0); PG8_STAGE(PG8_SA(0, 1), a2 + hstep, voffA);
            PG8_WAIT_L(8); PG8_BAR; PG8_WAIT_L(0); PG8_MMA(0, 0, At, B0); PG8_BAR; PG8_SCHED;
            PG8_LDB(B1, 1, 1); PG8_STAGE(PG8_SB(1, 0), b3, voffB);
            PG8_BAR; PG8_WAIT_L(0); PG8_MMA(0, 1, At, B1); PG8_BAR;
            PG8_LDA(At, 1, 1); PG8_STAGE(PG8_SA(1, 0), a3, voffA);
            PG8_BAR; PG8_WAIT_L(0); PG8_MMA(1, 0, At, B0); PG8_BAR; PG8_SCHED;
            PG8_STAGE(PG8_SB(1, 1), b3 + hstep, voffB);
            PG8_WAIT_V(6); PG8_BAR; PG8_MMA(1, 1, At, B1); PG8_BAR;
            }
        }
        if constexpr (ALIGN_EPI) { if (wr == 0) PG8_BAR; }
        if constexpr (!Epi::AFTER_DRAIN) { E(acc, cur, wr, wc, fr, fq); S.done(cur); }
        if (!has_next) break;
#pragma unroll
        for (int a = 0; a < 2; ++a)
#pragma unroll
            for (int b = 0; b < 2; ++b)
#pragma unroll
                for (int m = 0; m < 4; ++m)
#pragma unroll
                    for (int n = 0; n < 2; ++n) acc[a][b][m][n] = (f32x4){0.f, 0.f, 0.f, 0.f};
        cur = nxt; cA = nA; cB = nB; ++ui;
        if constexpr (ALIGN_EPI) { if (wr == 1) PG8_BAR; }
    }
    PG8_WAIT_V(0);
    if constexpr (!ALIGN_EPI) { if (wr == 0) PG8_BAR; }
    PG8_BAR;
    if constexpr (Epi::AFTER_DRAIN) { E.fused(acc, cur, wr, wc, fr, fq, lds, wid, lane); S.done(cur); }
#undef PG8_SA
#undef PG8_SB
#undef PG8_STAGE
#undef PG8_LDA
#undef PG8_LDB
#undef PG8_MMA
#undef PG8_WAIT_V
#undef PG8_WAIT_L
#undef PG8_BAR
#undef PG8_SCHED
}
}
namespace pg8 {
__device__ __forceinline__ void st16_wt(void* p, u32x4 v) {
#ifdef USE_WT_STORES
    asm volatile("global_store_dwordx4 %0, %1, off sc1\n\ts_nop 1" :: "v"(p), "v"(v) : "memory");
#else
    *(u32x4*)p = v;
#endif
}
__device__ __forceinline__ u32x4 pack8(const f32x4 a, const f32x4 b) { u32x4 w; w.x = cvt_pk_bf16(a[0], a[1]); w.y = cvt_pk_bf16(a[2], a[3]); w.z = cvt_pk_bf16(b[0], b[1]); w.w = cvt_pk_bf16(b[2], b[3]); return w; }

struct EpiInProj {
    static constexpr bool PERM = true, AFTER_DRAIN = false;
    bf16_t* Q; bf16_t* KV; bf16_t* Z; bf16_t* BG; float* G; const float* qn; const float* kn;
    __device__ __forceinline__ void operator()(const f32x4 (&acc)[2][2][4][2], const Unit& u, int wr, int wc, int fr, int fq) const {
        const int pn = u.pn; const int row0 = u.pm * BM + wr * 64 + fr;
        if (pn <= 4) {
            const bool donorm = (pn < 2) || (pn >= 3 && wc < 2);
            const float* nw = (pn < 2) ? qn : kn;
            const float sc = (pn < 2) ? (0.125f * 1.4426950408889634f) : 1.0f;
            f32x4 w4[2][2];
#pragma unroll
            for (int bj = 0; bj < 2; ++bj)
#pragma unroll
                for (int n = 0; n < 2; ++n) { f32x4 t = *(const f32x4*)(nw + 32 * bj + 8 * fq + 4 * n); w4[bj][n] = donorm ? t * sc : (f32x4){1.f, 1.f, 1.f, 1.f}; }
            bf16_t* base; size_t rstride;
            if (pn < 2) { base = Q + (4 * pn + wc) * 64 + 8 * fq; rstride = 512; }
            else { const int ti = (pn - 2) * 2 + (wc >> 1), g = wc & 1; base = KV + (size_t)ti * ((size_t)4 * 2 * 8192 * 64) + 8 * fq; rstride = 64;
                   base += (size_t)g * 8192 * 64; }
#pragma unroll
            for (int ai = 0; ai < 2; ++ai)
#pragma unroll
                for (int m = 0; m < 4; ++m) {
                    const int r = row0 + ai * HALF + m * 16;
                    float rs = 1.f;
                    if (donorm) {
                        float ss = 0.f;
#pragma unroll
                        for (int bj = 0; bj < 2; ++bj)
#pragma unroll
                            for (int n = 0; n < 2; ++n) { const f32x4 x = acc[ai][bj][m][n]; ss += (x[0] * x[0] + x[1] * x[1]) + (x[2] * x[2] + x[3] * x[3]); }
                        ss += __shfl_xor(ss, 16); ss += __shfl_xor(ss, 32);
                        rs = 1.0f / sqrtf(ss * (1.0f / 64.0f) + 1e-6f);
                    }
                    size_t off;
                    if (pn < 2) off = (size_t)r * 512;
                    else { const int b = r >> 13, t = r & 8191; off = ((size_t)(b * 2) * 8192 + t) * 64; }
#pragma unroll
                    for (int bj = 0; bj < 2; ++bj) {
                        const f32x4 v0 = acc[ai][bj][m][0] * rs * w4[bj][0], v1 = acc[ai][bj][m][1] * rs * w4[bj][1];
                        st16_wt(base + off + 32 * bj, pack8(v0, v1));
                    }
                }
        } else if (pn <= 8) {
            bf16_t* base = Z + 128 * (pn - 5) + 32 * wc + 8 * fq;
#pragma unroll
            for (int ai = 0; ai < 2; ++ai)
#pragma unroll
                for (int m = 0; m < 4; ++m) {
                    const int r = row0 + ai * HALF + m * 16;
                    const f32x4 v0 = acc[ai][0][m][0] * acc[ai][1][m][0], v1 = acc[ai][0][m][1] * acc[ai][1][m][1];
                    st16_wt(base + (size_t)r * 512, pack8(v0, v1));
                }
        } else if (pn <= 10) {
            bf16_t* base = BG + 256 * (pn - 9) + 32 * wc + 8 * fq;
#pragma unroll
            for (int ai = 0; ai < 2; ++ai)
#pragma unroll
                for (int m = 0; m < 4; ++m) {
                    const int r = row0 + ai * HALF + m * 16;
#pragma unroll
                    for (int bj = 0; bj < 2; ++bj) st16_wt(base + (size_t)r * 512 + 128 * bj, pack8(acc[ai][bj][m][0], acc[ai][bj][m][1]));
                }
        } else {
            if (wc == 0 && fq < 3) {
#pragma unroll
                for (int ai = 0; ai < 2; ++ai)
#pragma unroll
                    for (int m = 0; m < 4; ++m) {
                        const int r = row0 + ai * HALF + m * 16;
#pragma unroll
                        for (int n = 0; n < 2; ++n) { const f32x4 x = acc[ai][0][m][n]; f32x4 s;
#pragma unroll
                            for (int e = 0; e < 4; ++e) s[e] = 1.0f / (1.0f + __expf(-x[e]));
                            *(f32x4*)(G + (size_t)r * 32 + 8 * fq + 4 * n) = s; }
                    }
            }
        }
    }
};

struct EpiOutProj {
    static constexpr bool PERM = true, AFTER_DRAIN = false;
    const float* x; bf16_t* X1B; bf16_t* A2; float* RSS; const float* mod; const float* n2;
    __device__ __forceinline__ void operator()(const f32x4 (&acc)[2][2][4][2], const Unit& u, int wr, int wc, int fr, int fq) const {
        const int row0 = u.pm * BM + wr * 64 + fr; const int b = (u.pm * BM) >> 13;
        const int col0 = u.pn * BM + wc * 32 + 8 * fq;
        f32x4 g1[2][2], a2[2][2];
#pragma unroll
        for (int bj = 0; bj < 2; ++bj)
#pragma unroll
            for (int n = 0; n < 2; ++n) { const int c = col0 + 128 * bj + 4 * n;
                g1[bj][n] = *(const f32x4*)(mod + (size_t)b * 6144 + 2 * 1024 + c);
                const f32x4 s2 = *(const f32x4*)(mod + (size_t)b * 6144 + 4 * 1024 + c), nn = *(const f32x4*)(n2 + c);
                a2[bj][n] = nn * (s2 + 1.0f); }
#pragma unroll
        for (int ai = 0; ai < 2; ++ai)
#pragma unroll
          for (int mh = 0; mh < 2; ++mh) {
            f32x4 xv[2][2][2];
#pragma unroll
            for (int mm = 0; mm < 2; ++mm)
#pragma unroll
                for (int bj = 0; bj < 2; ++bj) { const size_t off = (size_t)(row0 + ai * HALF + (2 * mh + mm) * 16) * 1024 + col0 + 128 * bj; xv[mm][bj][0] = *(const f32x4*)(x + off); xv[mm][bj][1] = *(const f32x4*)(x + off + 4); }
#pragma unroll
            for (int mm = 0; mm < 2; ++mm)
#pragma unroll
                for (int bj = 0; bj < 2; ++bj) asm volatile("" : "+v"(xv[mm][bj][0]), "+v"(xv[mm][bj][1]));
#pragma unroll
            for (int mm = 0; mm < 2; ++mm) {
                const int m = 2 * mh + mm;
                const int r = row0 + ai * HALF + m * 16; float ss = 0.f;
#pragma unroll
                for (int bj = 0; bj < 2; ++bj) {
                    const size_t off = (size_t)r * 1024 + col0 + 128 * bj;
                    const f32x4 ya = xv[mm][bj][0] + g1[bj][0] * acc[ai][bj][m][0], yb = xv[mm][bj][1] + g1[bj][1] * acc[ai][bj][m][1];
                    st16_wt(X1B + off, pack8(ya, yb));
                    ss += (ya[0] * ya[0] + ya[1] * ya[1]) + (ya[2] * ya[2] + ya[3] * ya[3]) + (yb[0] * yb[0] + yb[1] * yb[1]) + (yb[2] * yb[2] + yb[3] * yb[3]);
                    st16_wt(A2 + off, pack8(ya * a2[bj][0], yb * a2[bj][1]));
                }
                ss += __shfl_xor(ss, 16); ss += __shfl_xor(ss, 32);
                if (fq == 0) RSS[(size_t)r * 16 + u.pn * 4 + wc] = ss;
            }
          }
    }
};

struct EpiFF1 {
    static constexpr bool PERM = true, AFTER_DRAIN = false;
    bf16_t* HID; const float* RSS; const float* bff1;
    __device__ __forceinline__ void operator()(const f32x4 (&acc)[2][2][4][2], const Unit& u, int wr, int wc, int fr, int fq) const {
        const int row0 = u.pm * BM + wr * 64 + fr; const int b = (u.pm * BM) >> 13;
        const int col0 = u.pn * BM + wc * 32 + 8 * fq;
        f32x4 bv[2][2];
#pragma unroll
        for (int bj = 0; bj < 2; ++bj)
#pragma unroll
            for (int n = 0; n < 2; ++n) bv[bj][n] = *(const f32x4*)(bff1 + (size_t)b * 4096 + col0 + 128 * bj + 4 * n);
#pragma unroll
        for (int ai = 0; ai < 2; ++ai) {
            f32x4 sv[4][4];
#pragma unroll
            for (int m = 0; m < 4; ++m)
#pragma unroll
                for (int q = 0; q < 4; ++q) sv[m][q] = *(const f32x4*)(RSS + (size_t)(row0 + ai * HALF + m * 16) * 16 + 4 * q);
#pragma unroll
            for (int m = 0; m < 4; ++m) asm volatile("" : "+v"(sv[m][0]), "+v"(sv[m][1]), "+v"(sv[m][2]), "+v"(sv[m][3]));
#pragma unroll
            for (int m = 0; m < 4; ++m) {
                const int r = row0 + ai * HALF + m * 16;
                const f32x4 st = (sv[m][0] + sv[m][1]) + (sv[m][2] + sv[m][3]);
                const float rs = 1.0f / sqrtf(((st[0] + st[1]) + (st[2] + st[3])) * (1.0f / 1024.0f) + 1e-6f);
#pragma unroll
                for (int bj = 0; bj < 2; ++bj) {
                    f32x4 h0 = acc[ai][bj][m][0] * rs + bv[bj][0], h1 = acc[ai][bj][m][1] * rs + bv[bj][1];
#pragma unroll
                    for (int e = 0; e < 4; ++e) { const float a = fmaxf(h0[e], 0.f), c = fmaxf(h1[e], 0.f); h0[e] = a * a; h1[e] = c * c; }
                    st16_wt(HID + (size_t)r * 4096 + col0 + 128 * bj, pack8(h0, h1));
                }
            }
        }
    }
};

struct EpiFF2 {
    static constexpr bool PERM = true, AFTER_DRAIN = false;
    const bf16_t* X1B; const float* mod; float* dst;
    __device__ __forceinline__ void operator()(const f32x4 (&acc)[2][2][4][2], const Unit& u, int wr, int wc, int fr, int fq) const {
        const int row0 = u.pm * BM + wr * 64 + fr; const int b = (u.pm * BM) >> 13;
        const int col0 = u.pn * BM + wc * 32 + 8 * fq;
        f32x4 g2[2][2];
#pragma unroll
        for (int bj = 0; bj < 2; ++bj)
#pragma unroll
            for (int n = 0; n < 2; ++n) g2[bj][n] = *(const f32x4*)(mod + (size_t)b * 6144 + 5 * 1024 + col0 + 128 * bj + 4 * n);
#pragma unroll
        for (int ai = 0; ai < 2; ++ai) {
            u32x4 xv[4][2];
#pragma unroll
            for (int m = 0; m < 4; ++m)
#pragma unroll
                for (int bj = 0; bj < 2; ++bj) { const size_t off = (size_t)(row0 + ai * HALF + m * 16) * 1024 + col0 + 128 * bj; xv[m][bj] = *(const u32x4*)(X1B + off); }
#pragma unroll
            for (int m = 0; m < 4; ++m)
#pragma unroll
                for (int bj = 0; bj < 2; ++bj) asm volatile("" : "+v"(xv[m][bj]));
#pragma unroll
            for (int m = 0; m < 4; ++m)
#pragma unroll
                for (int bj = 0; bj < 2; ++bj) {
                    const size_t off = (size_t)(row0 + ai * HALF + m * 16) * 1024 + col0 + 128 * bj;
                    const u32x4 w = xv[m][bj];
                    const f32x4 xa = {__builtin_bit_cast(float, w.x << 16), __builtin_bit_cast(float, w.x & 0xffff0000u), __builtin_bit_cast(float, w.y << 16), __builtin_bit_cast(float, w.y & 0xffff0000u)};
                    const f32x4 xb = {__builtin_bit_cast(float, w.z << 16), __builtin_bit_cast(float, w.z & 0xffff0000u), __builtin_bit_cast(float, w.w << 16), __builtin_bit_cast(float, w.w & 0xffff0000u)};
                    *(f32x4*)(dst + off) = xa + g2[bj][0] * acc[ai][bj][m][0]; *(f32x4*)(dst + off + 4) = xb + g2[bj][1] * acc[ai][bj][m][1];
                }
        }
    }
};
}

#ifndef MK_N_LAUNCHES
#define MK_N_LAUNCHES 1
#endif
constexpr int NWAVES = 8;
constexpr int N_PHASES = 8;
constexpr int BATCH = 4, T = 8192, D = 1024, M = BATCH * T, FF = 4096, NIN = 3072, INCOLS = 2840;
constexpr int NCMP = 511;
constexpr float LOG2E = 1.4426950408889634f;
constexpr size_t MiB = 1u << 20;
constexpr size_t WS_CTL = 0, CTL_ZERO_BYTES = 32 * 1024;
constexpr size_t WS_MOD = 1 * MiB;
constexpr size_t WS_BFF1 = 1 * MiB + 128 * 1024;
constexpr size_t WS_PEP = 1 * MiB + 256 * 1024;
constexpr size_t WS_RSS = 2 * MiB;
constexpr size_t WS_G = 4 * MiB;
constexpr size_t WS_WIN = 8 * MiB;
constexpr size_t WS_WOUT = 14 * MiB;
constexpr size_t WS_W1 = 16 * MiB;
constexpr size_t WS_W2 = 24 * MiB;
constexpr size_t WS_CW1K = 32 * MiB, WS_CW1V = 33 * MiB;
constexpr size_t WS_CW2K = 34 * MiB, WS_CW2V = 34 * MiB + 64 * 1024;
constexpr size_t WS_KC = 35 * MiB, WS_VC = 35 * MiB + 512 * 1024;
constexpr size_t WS_A2 = 36 * MiB;
constexpr size_t WS_H = 100 * MiB;
constexpr size_t WS_Q = 164 * MiB;
constexpr size_t WS_KV = 196 * MiB;
constexpr size_t KV_TENS = (size_t)4 * 2 * 8192 * 64;
constexpr size_t WS_Z = 244 * MiB;
constexpr size_t WS_BG = 276 * MiB;
constexpr size_t WS_MIX = 308 * MiB;
constexpr size_t WS_HID = 100 * MiB;
constexpr size_t WS_X1B = 380 * MiB;
constexpr size_t WS_END = 444 * MiB;
constexpr int CW_BAR = 4096;
constexpr int CW_QHEAD = 1024;

constexpr int RING_BYTES = 131072;
constexpr int LDSCTL_OFF = 151 * 1024, MISC_OFF = LDSCTL_OFF + 320;
constexpr int LDS_BYTES = 152 * 1024;

#define GAS __attribute__((address_space(1)))
#define LAS __attribute__((address_space(3)))
typedef unsigned short bf16;
typedef unsigned v4u __attribute__((ext_vector_type(4)));
typedef float f32x4 __attribute__((ext_vector_type(4)));
typedef float f32x16 __attribute__((ext_vector_type(16)));
typedef short bf16x8 __attribute__((ext_vector_type(8)));
typedef short s16x4 __attribute__((ext_vector_type(4)));
typedef GAS unsigned gu32;
#define RLX_AGENT __ATOMIC_RELAXED, __HIP_MEMORY_SCOPE_AGENT
#define LDS_WAIT() asm volatile("s_waitcnt lgkmcnt(0)" ::: "memory")
#define VM_WAIT() asm volatile("s_waitcnt vmcnt(0)" ::: "memory")
__device__ __forceinline__ unsigned f2bf(float f) { unsigned u = __builtin_bit_cast(unsigned, f); return (u + 0x7fffu + ((u >> 16) & 1u)) >> 16; }
__device__ __forceinline__ unsigned pk2(float lo, float hi) { return f2bf(lo) | (f2bf(hi) << 16); }
__device__ __forceinline__ float bf2f(unsigned short h) { return __builtin_bit_cast(float, (unsigned)h << 16); }
#define XB_TMO      128
#define XB_XCNT(j)  (256  + 64 * (j))
#define XB_XSUB(j)  (1280 + 64 * (j))
#define XB_XGEN(j)  (2304 + 64 * (j))
#define XB_TOP      3328
#define XB_TOPGEN   3392
#define XCD_BAR_WORDS 3456
#define XB_SPIN_CAP (1u << 18)

__device__ __forceinline__ unsigned xb_ld(unsigned* p)              { return __hip_atomic_load(p, __ATOMIC_RELAXED, __HIP_MEMORY_SCOPE_AGENT); }
__device__ __forceinline__ unsigned xb_add(unsigned* p, unsigned v) { return __hip_atomic_fetch_add(p, v, __ATOMIC_RELAXED, __HIP_MEMORY_SCOPE_AGENT); }
__device__ __forceinline__ unsigned xb_xcc_id() { return (unsigned)__builtin_amdgcn_s_getreg((3 << 11) | 20) & 0xFu; }
#define XB_SPIN(cond, bar) do { unsigned _sp = 0; while (cond) { __builtin_amdgcn_s_sleep(1); \
    if ((++_sp & 255u) == 0u) { if (xb_ld(&(bar)[XB_TMO])) break; if (_sp > XB_SPIN_CAP) { atomicAdd(&(bar)[XB_TMO], 1u); break; } } } } while (0)

struct XcdBarrier {
    unsigned* bar; unsigned x;
    volatile LAS unsigned* st;
};

__device__ __forceinline__ XcdBarrier xcd_barrier_post(unsigned* bar, volatile LAS unsigned* st) {
    XcdBarrier b; b.bar = bar; b.x = xb_xcc_id(); b.st = st;
    if (threadIdx.x == 0) (void)xb_add(&bar[XB_XCNT(b.x)], 1u);
    return b;
}
__device__ __forceinline__ void xcd_barrier_complete(unsigned* bar, unsigned x, unsigned& nloc, unsigned& nx) {
    const unsigned G = gridDim.x * gridDim.y * gridDim.z;
    unsigned sum, cnt, mine, sp = 0u;
    for (;;) {
        sum = 0u; cnt = 0u; mine = 0u;
#pragma unroll
        for (unsigned j = 0; j < 16; ++j) { const unsigned c = xb_ld(&bar[XB_XCNT(j)]); sum += c; cnt += (c > 0u) ? 1u : 0u; mine = (j == x) ? c : mine; }
        if (sum == G) break;
        __builtin_amdgcn_s_sleep(1);
        if ((++sp & 255u) == 0u) { if (xb_ld(&bar[XB_TMO])) break; if (sp > XB_SPIN_CAP) { atomicAdd(&bar[XB_TMO], 1u); break; } }
    }
    nloc = mine > 0u ? mine : 1u; nx = cnt > 0u ? cnt : 1u;
}

__device__ __forceinline__ void xcd_barrier(const XcdBarrier& b) {
    asm volatile("s_waitcnt vmcnt(0)" ::: "memory");
    __syncthreads();
    if (threadIdx.x == 0) {
        unsigned* bar = b.bar;
        __builtin_amdgcn_s_waitcnt(0);
        unsigned nloc = b.st[0], nx = b.st[1];
        if (nloc == 0u) { xcd_barrier_complete(bar, b.x, nloc, nx); b.st[0] = nloc; b.st[1] = nx; }
        const unsigned old = xb_add(&bar[XB_XSUB(b.x)], 1u);
        const unsigned gen = old / nloc;
        if (old + 1u == (gen + 1u) * nloc) {
            __builtin_amdgcn_fence(__ATOMIC_RELEASE, "agent");
            asm volatile("s_waitcnt vmcnt(0)" ::: "memory");
            const unsigned og = xb_add(&bar[XB_TOP], 1u);
            const unsigned tg = og / nx;
            if (og + 1u == (tg + 1u) * nx) xb_add(&bar[XB_TOPGEN], 1u);
            else XB_SPIN(xb_ld(&bar[XB_TOPGEN]) == tg, bar);
            __builtin_amdgcn_fence(__ATOMIC_ACQUIRE, "agent");
            xb_add(&bar[XB_XGEN(b.x)], 1u);
            asm volatile("s_waitcnt vmcnt(0)" ::: "memory");
        } else {
            XB_SPIN(xb_ld(&bar[XB_XGEN(b.x)]) == gen, bar);
            __builtin_amdgcn_fence(__ATOMIC_ACQUIRE, "agent");
            asm volatile("s_waitcnt vmcnt(0)" ::: "memory");
        }
    }
    __syncthreads();
}

struct Frame {
    LAS unsigned char* lds;
    volatile LAS unsigned* MISC;
    gu32* ctl;
    int tid, lane, wave;
    int vcu, G;
    const float* in[20];
    float* out;
    unsigned char* ws;
    unsigned long long tp_t0, tp_acc;
};
#ifdef ATP_A
#define ATP(F, id) do { if ((id) == ATP_A) (F).tp_t0 = __builtin_amdgcn_s_memrealtime(); if ((id) == ATP_B) (F).tp_acc += __builtin_amdgcn_s_memrealtime() - (F).tp_t0; } while (0)
#else
#define ATP(F, id) do {} while (0)
#endif
__device__ __forceinline__ float wave_sum(float v) {
#pragma unroll
    for (int o = 1; o < 64; o <<= 1) v += __shfl_xor(v, o);
    return v;
}

__device__ __forceinline__ void p0_transpose_item(const float* W, int K, int N, int nsrc0, int nvalid, bf16* WT, int drow0, int kb, LAS float* scr, int lane) {
    const int k0 = 64 * kb; const int nl = lane & 31;
    float tv[32];
#pragma unroll
    for (int i = 0; i < 32; ++i) { const int kk = 2 * i + (lane >> 5); tv[i] = (nl < nvalid) ? W[(size_t)(k0 + kk) * N + nsrc0 + nl] : 0.f; }
#pragma unroll
    for (int i = 0; i < 32; ++i) { const int kk = 2 * i + (lane >> 5); scr[kk * 33 + nl] = tv[i]; }
    LDS_WAIT(); asm volatile("" ::: "memory");
    const int c = lane & 7;
#pragma unroll
    for (int j = 0; j < 4; ++j) { const int n = (lane >> 3) + 8 * j; const LAS float* s = scr + (8 * c) * 33 + n;
        v4u o; o.x = pk2(s[0 * 33], s[1 * 33]); o.y = pk2(s[2 * 33], s[3 * 33]); o.z = pk2(s[4 * 33], s[5 * 33]); o.w = pk2(s[6 * 33], s[7 * 33]);
        *(GAS v4u*)(WT + (size_t)(drow0 + n) * K + k0 + 8 * c) = o; }
    LDS_WAIT(); asm volatile("" ::: "memory");
}
__device__ __forceinline__ void win_src(int rb, int& src0, int& nvalid) {
    const int pn = rb >> 3, q = rb & 7, bj = q >> 2, wc = q & 3; nvalid = 32;
    if (pn < 2) src0 = (4 * pn + wc) * 64 + 32 * bj;
    else if (pn < 5) src0 = 512 + (pn - 2) * 256 + (wc >> 1) * 128 + (wc & 1) * 64 + 32 * bj;
    else if (pn < 9) src0 = (bj == 0 ? 1304 : 2328) + 128 * (pn - 5) + 32 * wc;
    else if (pn < 11) src0 = 1816 + 256 * (pn - 9) + 32 * q;
    else { src0 = 1280; nvalid = (q == 0) ? 24 : 0; }
}
__device__ __forceinline__ void p0_phase(Frame& F) {
    const int bid = blockIdx.x;
    ATP(F, 60);
    for (int it = bid; it < 224; it += F.G) {
      if (it < 192) {
        const int cb = it;
        LAS float* sc = (LAS float*)(F.lds);
        LAS float* red = (LAS float*)(F.lds + 16384);
        const float* c = F.in[1];
        for (int i = F.tid; i < 4096; i += 512) { const float v = c[i]; sc[i] = v / (1.0f + __expf(-v)); }
        __syncthreads();
        const float* wa = F.in[16]; const int col = 32 * cb + (F.lane & 31), kpar = F.lane >> 5;
        float a0 = 0.f, a1 = 0.f, a2 = 0.f, a3 = 0.f;
#pragma unroll 32
        for (int i = 0; i < 64; ++i) { const int k = 128 * F.wave + 2 * i + kpar; const float w = wa[(size_t)k * 6144 + col];
            a0 += sc[k] * w; a1 += sc[1024 + k] * w; a2 += sc[2048 + k] * w; a3 += sc[3072 + k] * w; }
        a0 += __shfl_xor(a0, 32); a1 += __shfl_xor(a1, 32); a2 += __shfl_xor(a2, 32); a3 += __shfl_xor(a3, 32);
        if (F.lane < 32) { red[(F.wave * 4 + 0) * 32 + F.lane] = a0; red[(F.wave * 4 + 1) * 32 + F.lane] = a1; red[(F.wave * 4 + 2) * 32 + F.lane] = a2; red[(F.wave * 4 + 3) * 32 + F.lane] = a3; }
        __syncthreads();
        if (F.tid < 128) { const int b = F.tid >> 5, cc = F.tid & 31; float s = F.in[17][32 * cb + cc];
#pragma unroll
            for (int w = 0; w < 8; ++w) s += red[(w * 4 + b) * 32 + cc];
            ((float*)(F.ws + WS_MOD))[b * 6144 + 32 * cb + cc] = s; }
        __syncthreads();
      } else {
        const int kv = (it - 192) >> 4, kc = (it - 192) & 15; const float* pe = F.in[kv ? 8 : 5]; const float* w1 = F.in[kv ? 9 : 6];
        if (F.tid < 256) { float s = 0.f;
#pragma unroll 32
            for (int k = 128 * kc; k < 128 * kc + 128; ++k) s += pe[k] * w1[(size_t)k * 256 + F.tid];
            ((float*)(F.ws + WS_PEP))[(kv * 16 + kc) * 256 + F.tid] = s; }
      }
    }
    __syncthreads();
    ATP(F, 61);
    LAS float* scr = (LAS float*)(F.lds + F.wave * 16384);
    const int gw = F.vcu * NWAVES + F.wave, NGW = F.G * NWAVES;
    constexpr int I_IN = 96 * 16, I_OUT = 32 * 16, I_1 = 128 * 16, I_2 = 32 * 64, I_C1 = 8 * 32, I_C2 = 2 * 4;
    constexpr int NITEMS = I_IN + I_OUT + I_1 + I_2 + 2 * I_C1 + 2 * I_C2;
    for (int it = gw; it < NITEMS; it += NGW) {
        int r = it;
        if (r < I_IN) { const int rb = r % 96, kb = r / 96; int s0, nv; win_src(rb, s0, nv); p0_transpose_item(F.in[2], D, INCOLS, s0, nv, (bf16*)(F.ws + WS_WIN), 32 * rb, kb, scr, F.lane); continue; } r -= I_IN;
        if (r < I_OUT) { const int rb = r & 31, kb = r >> 5; p0_transpose_item(F.in[13], D, D, 32 * rb, 32, (bf16*)(F.ws + WS_WOUT), 32 * rb, kb, scr, F.lane); continue; } r -= I_OUT;
        if (r < I_1) { const int rb = r & 127, kb = r >> 7; p0_transpose_item(F.in[18], D, FF, 32 * rb, 32, (bf16*)(F.ws + WS_W1), 32 * rb, kb, scr, F.lane); continue; } r -= I_1;
        if (r < I_2) { const int rb = r & 31, kb = r >> 5; p0_transpose_item(F.in[19], FF, D, 32 * rb, 32, (bf16*)(F.ws + WS_W2), 32 * rb, kb, scr, F.lane); continue; } r -= I_2;
        if (r < I_C1) { const int rb = r & 7, kb = r >> 3; p0_transpose_item(F.in[6], 2048, 256, 32 * rb, 32, (bf16*)(F.ws + WS_CW1K), 32 * rb, kb, scr, F.lane); continue; } r -= I_C1;
        if (r < I_C1) { const int rb = r & 7, kb = r >> 3; p0_transpose_item(F.in[9], 2048, 256, 32 * rb, 32, (bf16*)(F.ws + WS_CW1V), 32 * rb, kb, scr, F.lane); continue; } r -= I_C1;
        if (r < I_C2) { const int rb = r & 1, kb = r >> 1; p0_transpose_item(F.in[7], 256, 64, 32 * rb, 32, (bf16*)(F.ws + WS_CW2K), 32 * rb, kb, scr, F.lane); continue; } r -= I_C2;
        { const int rb = r & 1, kb = r >> 1; p0_transpose_item(F.in[10], 256, 64, 32 * rb, 32, (bf16*)(F.ws + WS_CW2V), 32 * rb, kb, scr, F.lane); }
    }
    __syncthreads();
}

__device__ __forceinline__ void p1_phase(Frame& F) {
    const int gw = F.vcu * NWAVES + F.wave, NGW = F.G * NWAVES;
    const float* mod = (const float*)(F.ws + WS_MOD);
    const float* x = F.in[0]; const float* n1 = F.in[14];
    bf16* H = (bf16*)(F.ws + WS_H);
    ATP(F, 10);
    for (int chunk = gw; chunk < M / 16; chunk += NGW) {
        const int r0 = chunk * 16, b = r0 >> 13;
        f32x4 ca[4], cb[4];
#pragma unroll
        for (int j = 0; j < 4; ++j) { const int c = 4 * (F.lane + 64 * j);
            const f32x4 nn = *(const f32x4*)(n1 + c), s1 = *(const f32x4*)(mod + (size_t)b * 6144 + 1024 + c);
            ca[j] = nn * (s1 + 1.0f); cb[j] = *(const f32x4*)(mod + (size_t)b * 6144 + c); }
        for (int rr = 0; rr < 16; rr += 4) {
            f32x4 v[4][4]; float s[4];
#pragma unroll
            for (int q = 0; q < 4; ++q) { const GAS f32x4* xr = (const GAS f32x4*)(x + (size_t)(r0 + rr + q) * D) + F.lane;
#pragma unroll
                for (int j = 0; j < 4; ++j) v[q][j] = xr[64 * j]; }
#pragma unroll
            for (int q = 0; q < 4; ++q) { s[q] = 0.f;
#pragma unroll
                for (int j = 0; j < 4; ++j) s[q] += (v[q][j].x * v[q][j].x + v[q][j].y * v[q][j].y) + (v[q][j].z * v[q][j].z + v[q][j].w * v[q][j].w); }
#pragma unroll
            for (int o = 1; o < 64; o <<= 1) {
#pragma unroll
                for (int q = 0; q < 4; ++q) s[q] += __shfl_xor(s[q], o); }
#pragma unroll
            for (int q = 0; q < 4; ++q) {
                const float rs = 1.0f / sqrtf(s[q] * (1.0f / D) + 1e-6f);
                GAS unsigned long long* o8 = (GAS unsigned long long*)(H + (size_t)(r0 + rr + q) * D) + F.lane;
#pragma unroll
                for (int j = 0; j < 4; ++j) { const f32x4 h = v[q][j] * rs * ca[j] + cb[j];
                    o8[64 * j] = (unsigned long long)pk2(h.x, h.y) | ((unsigned long long)pk2(h.z, h.w) << 32); }
            }
        }
    }
    ATP(F, 11);
    const bf16* W1t = (const bf16*)(F.ws + WS_W1);
    float* bff1 = (float*)(F.ws + WS_BFF1);
    for (int n = gw; n < FF; n += NGW) {
        float a[4] = {0.f, 0.f, 0.f, 0.f};
#pragma unroll
        for (int j = 0; j < 2; ++j) { const int k0 = 8 * F.lane + 512 * j;
            const v4u wv = *(const GAS v4u*)(W1t + (size_t)n * D + k0);
            float w[8]; w[0] = bf2f(wv.x & 0xffff); w[1] = bf2f(wv.x >> 16); w[2] = bf2f(wv.y & 0xffff); w[3] = bf2f(wv.y >> 16); w[4] = bf2f(wv.z & 0xffff); w[5] = bf2f(wv.z >> 16); w[6] = bf2f(wv.w & 0xffff); w[7] = bf2f(wv.w >> 16);
#pragma unroll
            for (int b = 0; b < 4; ++b) { const f32x4 s0 = *(const f32x4*)(mod + (size_t)b * 6144 + 3 * 1024 + k0), s1 = *(const f32x4*)(mod + (size_t)b * 6144 + 3 * 1024 + k0 + 4);
                a[b] += (w[0] * s0[0] + w[1] * s0[1]) + (w[2] * s0[2] + w[3] * s0[3]) + (w[4] * s1[0] + w[5] * s1[1]) + (w[6] * s1[2] + w[7] * s1[3]); } }
#pragma unroll
        for (int b = 0; b < 4; ++b) { const float s = wave_sum(a[b]); if (F.lane == 0) bff1[b * 4096 + n] = s; }
    }
    ATP(F, 12);
}

__device__ __forceinline__ float gelu_tanh(float x) {
    const float u = 0.7978845608028654f * (x + 0.044715f * x * x * x);
    const float e = __expf(2.0f * u);
    const float th = 1.0f - 2.0f / (1.0f + e);
    return 0.5f * x * (1.0f + th);
}
__device__ __forceinline__ void p3_phase(Frame& F) {
    constexpr int AIMG = 0, GSTR = 2064, HIDO = 68224, HSTR = 528, OUTO = 85120, OSTR = 65;
    const int lane = F.lane, w = F.wave, r32 = lane & 31, hi = lane >> 5;
    for (int item = blockIdx.x; item < 256; item += F.G) {
        const int prob = item >> 4, mt = item & 15, kv = prob >> 3, b = (prob >> 1) & 3, g = prob & 1, n0 = 32 * mt;
        const bf16* raw = (const bf16*)(F.ws + WS_KV) + (size_t)kv * KV_TENS + (size_t)(b * 2 + g) * 8192 * 64;
        ATP(F, 30);
        { v4u av[9];
#pragma unroll
          for (int q = 0; q < 9; ++q) { const int idx = F.tid + 512 * q, gl = idx >> 7, ch = idx & 127, gi = n0 + gl;
              av[q] = (v4u){0u, 0u, 0u, 0u}; if (idx < 33 * 128 && gi < 512) av[q] = *(const GAS v4u*)(raw + (size_t)gi * 1024 + ch * 8); }
#pragma unroll
          for (int q = 0; q < 9; ++q) { const int idx = F.tid + 512 * q, gl = idx >> 7, ch = idx & 127;
              if (idx < 33 * 128) *(LAS v4u*)(F.lds + AIMG + gl * GSTR + ch * 16) = av[q]; } }
        __syncthreads();
        ATP(F, 31);
        const bf16* W1t = (const bf16*)(F.ws + (kv ? WS_CW1V : WS_CW1K));
        const bf16* bp = W1t + (size_t)(32 * w + r32) * 2048 + 8 * hi;
        const LAS unsigned char* ap = F.lds + AIMG + r32 * GSTR + hi * 16;
        f32x16 acc = {};
#pragma unroll 1
        for (int s0 = 0; s0 < 128; s0 += 32) {
            bf16x8 bfr[32];
#pragma unroll
            for (int j = 0; j < 32; ++j) bfr[j] = *(const GAS bf16x8*)(bp + 16 * (s0 + j));
#pragma unroll
            for (int j = 0; j < 32; ++j) asm volatile("" : "+v"(bfr[j]));
            const LAS unsigned char* aq = ap + (s0 >= 64 ? GSTR + (s0 - 64) * 32 : s0 * 32);
#pragma unroll
            for (int j = 0; j < 32; ++j) { const bf16x8 af = *(const LAS bf16x8*)(aq + j * 32); acc = __builtin_amdgcn_mfma_f32_32x32x16_bf16(af, bfr[j], acc, 0, 0, 0); }
        }
        ATP(F, 32);
        { const float* pp = (const float*)(F.ws + WS_PEP) + kv * 16 * 256 + 32 * w + r32; float pb = 0.f;
#pragma unroll
          for (int kc = 0; kc < 16; ++kc) pb += pp[kc * 256];
#pragma unroll
          for (int i = 0; i < 16; ++i) { const int row = (i & 3) + 8 * (i >> 2) + 4 * hi; const float h = gelu_tanh(acc[i] + pb);
              *(LAS unsigned short*)(F.lds + HIDO + row * HSTR + (32 * w + r32) * 2) = (unsigned short)f2bf(h); } }
        __syncthreads();
        if (w < 2) {
            const bf16* W2t = (const bf16*)(F.ws + (kv ? WS_CW2V : WS_CW2K));
            const bf16* bp2 = W2t + (size_t)(32 * w + r32) * 256 + 8 * hi;
            const LAS unsigned char* ap2 = F.lds + HIDO + r32 * HSTR + hi * 16;
            f32x16 a2 = {};
#pragma unroll
            for (int s = 0; s < 16; ++s) { const bf16x8 bf_ = *(const GAS bf16x8*)(bp2 + 16 * s); const bf16x8 af = *(const LAS bf16x8*)(ap2 + s * 32); a2 = __builtin_amdgcn_mfma_f32_32x32x16_bf16(af, bf_, a2, 0, 0, 0); }
#pragma unroll
            for (int i = 0; i < 16; ++i) { const int row = (i & 3) + 8 * (i >> 2) + 4 * hi; *(LAS float*)(F.lds + OUTO + (row * OSTR + 32 * w + r32) * 4) = a2[i]; }
        }
        __syncthreads();
        { const int row = F.tid >> 4, c4 = (F.tid & 15) * 4; const LAS float* op = (const LAS float*)(F.lds + OUTO) + row * OSTR + c4;
          float v0 = op[0], v1 = op[1], v2 = op[2], v3 = op[3];
          if (kv == 0) { float ss = (v0 * v0 + v1 * v1) + (v2 * v2 + v3 * v3); ss += __shfl_xor(ss, 1); ss += __shfl_xor(ss, 2); ss += __shfl_xor(ss, 4); ss += __shfl_xor(ss, 8);
              const float rs = 1.0f / sqrtf(ss * (1.0f / 64.0f) + 1e-6f); const f32x4 kn = *(const f32x4*)(F.in[4] + c4); v0 *= rs * kn[0]; v1 *= rs * kn[1]; v2 *= rs * kn[2]; v3 *= rs * kn[3]; }
          const int n = n0 + row; if (n >= NCMP) { v0 = v1 = v2 = v3 = 0.f; }
          bf16* dst = (bf16*)(F.ws + (kv ? WS_VC : WS_KC)) + ((size_t)(b * 2 + g) * 512 + n) * 64 + c4;
          *(GAS unsigned long long*)dst = (unsigned long long)pk2(v0, v1) | ((unsigned long long)pk2(v2, v3) << 32); }
        __syncthreads();
        ATP(F, 33);
    }
}

namespace att {
constexpr int SLOT = 16384;
constexpr int L_RING = 0;
constexpr int L_IMP = 65536, IMP_STR = 132;
constexpr int L_OACC = 65536;
constexpr int L_BTAB = L_OACC + 65536;
constexpr int NBT = 960, BT0 = 895;
constexpr int L_WSF = L_BTAB + 4 * NBT * 4;
constexpr int L_SELM = L_WSF + 2048;
constexpr int L_UNI = L_SELM + 1024;
constexpr int L_END = L_UNI + 256;
static_assert(L_END <= LDSCTL_OFF, "attention LDS map");
constexpr float NEG_INF = -INFINITY;
constexpr float THR = 8.0f;

__device__ __forceinline__ int t5_bucket(int n) {
    if (n < 16) return n;
    int b = 16;
    b += (n >= 21); b += (n >= 27); b += (n >= 35); b += (n >= 46); b += (n >= 59); b += (n >= 77); b += (n >= 99); b += (n >= 128);
    b += (n >= 166); b += (n >= 216); b += (n >= 280); b += (n >= 363); b += (n >= 470); b += (n >= 609); b += (n >= 790);
    return b;
}
__device__ __forceinline__ s16x4 vtr(const LAS unsigned char* p) { typedef short v4i16_t __attribute__((ext_vector_type(4))); return __builtin_bit_cast(s16x4, __builtin_amdgcn_ds_read_tr16_b64_v4i16((LAS v4i16_t*)p)); }
__device__ __forceinline__ unsigned cvtpk(float lo, float hi) { typedef float f2 __attribute__((ext_vector_type(2))); typedef __bf16 b2 __attribute__((ext_vector_type(2))); f2 v = {lo, hi}; b2 b = __builtin_convertvector(v, b2); return __builtin_bit_cast(unsigned, b); }
__device__ __forceinline__ float xhalf_max(float a) { auto rr = __builtin_amdgcn_permlane32_swap(__float_as_uint(a), __float_as_uint(a), false, false); return fmaxf(__uint_as_float(rr[0]), __uint_as_float(rr[1])); }
__device__ __forceinline__ float xhalf_sum(float a) { auto rr = __builtin_amdgcn_permlane32_swap(__float_as_uint(a), __float_as_uint(a), false, false); return __uint_as_float(rr[0]) + __uint_as_float(rr[1]); }
__device__ __forceinline__ float fadd_s(float a, float b) { float r; asm("v_add_f32_e32 %0, %1, %2" : "=v"(r) : "v"(a), "v"(b)); return r; }
__device__ __forceinline__ float fsub_s(float a, float b) { float r; asm("v_sub_f32_e32 %0, %1, %2" : "=v"(r) : "v"(a), "v"(b)); return r; }
__device__ __forceinline__ float fmul_s(float a, float b) { float r; asm("v_mul_f32_e32 %0, %1, %2" : "=v"(r) : "v"(a), "v"(b)); return r; }
__device__ __forceinline__ float quad_sum(float a) {
    a += __int_as_float(__builtin_amdgcn_update_dpp(0, __float_as_int(a), 0xB1, 0xf, 0xf, true));
    a += __int_as_float(__builtin_amdgcn_update_dpp(0, __float_as_int(a), 0x4E, 0xf, 0xf, true));
    return a;
}
__device__ __forceinline__ void glds16(const void* gsrc, unsigned lds_dst) { unsigned keep;
    asm volatile("s_mov_b32 %0, m0\n\ts_mov_b32 m0, %2\n\ts_nop 0\n\tglobal_load_lds_dwordx4 %1, off\n\ts_mov_b32 m0, %0" : "=&s"(keep) : "v"(gsrc), "s"(lds_dst) : "memory"); }
#define ATT_WAIT_BAR(N) asm volatile("s_waitcnt vmcnt(" #N ") lgkmcnt(0)\n\ts_barrier" ::: "memory")
__device__ __forceinline__ void tile_dma(const bf16* Kt, const bf16* Vt, bool hasV, unsigned slot_addr, int w, int lane) {
    glds16(Kt + lane * 64 + w * 8, (unsigned)__builtin_amdgcn_readfirstlane(slot_addr + w * 1024));
    if (hasV) glds16(Vt + (16 * (w & 3) + (lane >> 2)) * 64 + (w >> 2) * 32 + (lane & 3) * 8, (unsigned)__builtin_amdgcn_readfirstlane(slot_addr + 8192 + w * 1024));
}
__device__ __forceinline__ void qk_tile(const LAS unsigned char* buf, const bf16x8 (&qf)[4], float cv, f32x16& p0, f32x16& p1, int r32, int hi) {
    const LAS unsigned char* kp = buf + hi * 1024 + r32 * 16;
    f32x16 c;
#pragma unroll
    for (int i = 0; i < 16; ++i) c[i] = cv;
    bf16x8 k0[4], k1[4];
#pragma unroll
    for (int s = 0; s < 4; ++s) { k0[s] = *(const LAS bf16x8*)(kp + s * 2048); k1[s] = *(const LAS bf16x8*)(kp + s * 2048 + 512); }
#ifndef NO_K_PIN
    __builtin_amdgcn_sched_barrier(0);
#endif
#ifdef ATT_PRIO
    __builtin_amdgcn_s_setprio(1);
#endif
#ifdef QK_SEQ
    p0 = __builtin_amdgcn_mfma_f32_32x32x16_bf16(k0[0], qf[0], c, 0, 0, 0);
#pragma unroll
    for (int s = 1; s < 4; ++s) p0 = __builtin_amdgcn_mfma_f32_32x32x16_bf16(k0[s], qf[s], p0, 0, 0, 0);
    p1 = __builtin_amdgcn_mfma_f32_32x32x16_bf16(k1[0], qf[0], c, 0, 0, 0);
#pragma unroll
    for (int s = 1; s < 4; ++s) p1 = __builtin_amdgcn_mfma_f32_32x32x16_bf16(k1[s], qf[s], p1, 0, 0, 0);
#else
    p0 = __builtin_amdgcn_mfma_f32_32x32x16_bf16(k0[0], qf[0], c, 0, 0, 0);
    p1 = __builtin_amdgcn_mfma_f32_32x32x16_bf16(k1[0], qf[0], c, 0, 0, 0);
#pragma unroll
    for (int s = 1; s < 4; ++s) {
        p0 = __builtin_amdgcn_mfma_f32_32x32x16_bf16(k0[s], qf[s], p0, 0, 0, 0);
        p1 = __builtin_amdgcn_mfma_f32_32x32x16_bf16(k1[s], qf[s], p1, 0, 0, 0);
    }
#endif
#ifdef ATT_PRIO
    __builtin_amdgcn_s_setprio(0);
#endif
}
template <int KSTEP>
__device__ __forceinline__ void bias_mask(f32x16& p0, f32x16& p1, const LAS float* bt, int dbase, int hi) {
#pragma unroll
    for (int i = 0; i < 16; ++i) {
        const int kl = (i & 3) + 8 * (i >> 2) + 4 * hi;
        const int d0 = dbase - KSTEP * kl, d1 = d0 - KSTEP * 32;
        const int i0 = BT0 - min(max(d0, 0), BT0), i1 = BT0 - min(max(d1, 0), BT0);
        const float b0 = bt[i0], b1 = bt[i1];
        p0[i] = (d0 >= 0) ? fadd_s(p0[i], b0) : NEG_INF;
        p1[i] = (d1 >= 0) ? fadd_s(p1[i], b1) : NEG_INF;
        if ((i & 3) == 3) asm volatile("" ::: "memory");
    }
}
template <int MODE>
__device__ __forceinline__ void bias_near(f32x16& p0, f32x16& p1, const LAS float* tb, int dbase, int hi) {
#pragma unroll
    for (int i = 0; i < 16; ++i) {
        const int ko = (i & 3) + 8 * (i >> 2);
        const float b0 = tb[ko], b1 = tb[ko + 32];
        const int d0 = dbase - ko - 4 * hi, d1 = d0 - 32;
        if (MODE == 0) { p0[i] = fadd_s(p0[i], b0); p1[i] = fadd_s(p1[i], b1); }
        else if (MODE == 1) { p0[i] = d0 >= 0 ? fadd_s(p0[i], b0) : NEG_INF; p1[i] = d1 >= 0 ? fadd_s(p1[i], b1) : NEG_INF; }
        else { p0[i] = d0 < 512 ? fadd_s(p0[i], b0) : NEG_INF; p1[i] = d1 < 512 ? fadd_s(p1[i], b1) : NEG_INF; }
        if ((i & 7) == 7) asm volatile("" ::: "memory");
    }
}
__device__ __forceinline__ void bias_near_mode(f32x16& p0, f32x16& p1, const LAS float* tb, int dbase, int hi, int mode) {
    if (mode == 0) bias_near<0>(p0, p1, tb, dbase, hi); else if (mode == 1) bias_near<1>(p0, p1, tb, dbase, hi); else bias_near<2>(p0, p1, tb, dbase, hi);
}
__device__ __forceinline__ float rowmax32(const f32x16& p0, const f32x16& p1) {
    float a = fmaxf(fmaxf(p0[0], p1[0]), p0[1]), b = fmaxf(fmaxf(p1[1], p0[2]), p1[2]);
#pragma unroll
    for (int i = 3; i < 15; i += 2) { a = fmaxf(fmaxf(a, p0[i]), p1[i]); b = fmaxf(fmaxf(b, p0[i + 1]), p1[i + 1]); }
    a = fmaxf(fmaxf(a, p0[15]), p1[15]);
    return xhalf_max(fmaxf(a, b));
}
__device__ __forceinline__ void pv_tile(const LAS unsigned char* buf, const f32x16& p0, const f32x16& p1, f32x16 (&o)[2], int lane, int hi) {
    const LAS unsigned char* vp = buf + 8192 + ((lane >> 4) & 1) * 32 + (lane & 3) * 8 + (4 * hi + ((lane & 15) >> 2)) * 64;
    bf16x8 pa[4];
#pragma unroll
    for (int s = 0; s < 2; ++s) {
        v4u a, c;
        a.x = cvtpk(p0[8 * s + 0], p0[8 * s + 1]); a.y = cvtpk(p0[8 * s + 2], p0[8 * s + 3]); a.z = cvtpk(p0[8 * s + 4], p0[8 * s + 5]); a.w = cvtpk(p0[8 * s + 6], p0[8 * s + 7]);
        c.x = cvtpk(p1[8 * s + 0], p1[8 * s + 1]); c.y = cvtpk(p1[8 * s + 2], p1[8 * s + 3]); c.z = cvtpk(p1[8 * s + 4], p1[8 * s + 5]); c.w = cvtpk(p1[8 * s + 6], p1[8 * s + 7]);
        pa[s] = __builtin_bit_cast(bf16x8, a); pa[2 + s] = __builtin_bit_cast(bf16x8, c);
    }
#pragma unroll
    for (int ks = 0; ks < 4; ++ks)
#pragma unroll
        for (int d0 = 0; d0 < 2; ++d0) {
            const s16x4 lo = vtr(vp + d0 * 4096 + ks * 1024), hh = vtr(vp + d0 * 4096 + ks * 1024 + 512);
            const bf16x8 vf = (bf16x8){lo[0], lo[1], lo[2], lo[3], hh[0], hh[1], hh[2], hh[3]};
            o[d0] = __builtin_amdgcn_mfma_f32_32x32x16_bf16(pa[ks], vf, o[d0], 0, 0, 0);
        }
}
struct VFrags { s16x4 lo[4][2], hh[4][2]; };
__device__ __forceinline__ void v_read(VFrags& vf, const LAS unsigned char* buf, int lane, int hi) {
    const LAS unsigned char* vp = buf + 8192 + ((lane >> 4) & 1) * 32 + (lane & 3) * 8 + (4 * hi + ((lane & 15) >> 2)) * 64;
#pragma unroll
    for (int ks = 0; ks < 4; ++ks)
#pragma unroll
        for (int d0 = 0; d0 < 2; ++d0) { vf.lo[ks][d0] = vtr(vp + d0 * 4096 + ks * 1024); vf.hh[ks][d0] = vtr(vp + d0 * 4096 + ks * 1024 + 512); }
}
__device__ __forceinline__ void pv_tile_pre(const VFrags& vf, const f32x16& p0, const f32x16& p1, f32x16 (&o)[2]) {
    bf16x8 pa[4];
#pragma unroll
    for (int s = 0; s < 2; ++s) {
        v4u a, c;
        a.x = cvtpk(p0[8 * s + 0], p0[8 * s + 1]); a.y = cvtpk(p0[8 * s + 2], p0[8 * s + 3]); a.z = cvtpk(p0[8 * s + 4], p0[8 * s + 5]); a.w = cvtpk(p0[8 * s + 6], p0[8 * s + 7]);
        c.x = cvtpk(p1[8 * s + 0], p1[8 * s + 1]); c.y = cvtpk(p1[8 * s + 2], p1[8 * s + 3]); c.z = cvtpk(p1[8 * s + 4], p1[8 * s + 5]); c.w = cvtpk(p1[8 * s + 6], p1[8 * s + 7]);
        pa[s] = __builtin_bit_cast(bf16x8, a); pa[2 + s] = __builtin_bit_cast(bf16x8, c);
    }
#pragma unroll
    for (int ks = 0; ks < 4; ++ks)
#pragma unroll
        for (int d0 = 0; d0 < 2; ++d0) {
            const bf16x8 v = (bf16x8){vf.lo[ks][d0][0], vf.lo[ks][d0][1], vf.lo[ks][d0][2], vf.lo[ks][d0][3], vf.hh[ks][d0][0], vf.hh[ks][d0][1], vf.hh[ks][d0][2], vf.hh[ks][d0][3]};
            o[d0] = __builtin_amdgcn_mfma_f32_32x32x16_bf16(pa[ks], v, o[d0], 0, 0, 0);
        }
}
__device__ __forceinline__ float exp_pv(const VFrags& vf, f32x16& p0, f32x16& p1, f32x16 (&o)[2]) {
    float s0 = 0.f, s1 = 0.f;
#pragma unroll
    for (int i = 0; i < 16; ++i) { p0[i] = __builtin_amdgcn_exp2f(p0[i]); s0 += p0[i]; }
    bf16x8 pa[2];
#pragma unroll
    for (int s = 0; s < 2; ++s) { v4u a; a.x = cvtpk(p0[8 * s + 0], p0[8 * s + 1]); a.y = cvtpk(p0[8 * s + 2], p0[8 * s + 3]); a.z = cvtpk(p0[8 * s + 4], p0[8 * s + 5]); a.w = cvtpk(p0[8 * s + 6], p0[8 * s + 7]); pa[s] = __builtin_bit_cast(bf16x8, a); }
#pragma unroll
    for (int ks = 0; ks < 2; ++ks)
#pragma unroll
        for (int d0 = 0; d0 < 2; ++d0) {
            const bf16x8 v = (bf16x8){vf.lo[ks][d0][0], vf.lo[ks][d0][1], vf.lo[ks][d0][2], vf.lo[ks][d0][3], vf.hh[ks][d0][0], vf.hh[ks][d0][1], vf.hh[ks][d0][2], vf.hh[ks][d0][3]};
            o[d0] = __builtin_amdgcn_mfma_f32_32x32x16_bf16(pa[ks], v, o[d0], 0, 0, 0);
        }
#pragma unroll
    for (int i = 0; i < 16; ++i) { p1[i] = __builtin_amdgcn_exp2f(p1[i]); s1 += p1[i]; }
#pragma unroll
    for (int s = 0; s < 2; ++s) { v4u a; a.x = cvtpk(p1[8 * s + 0], p1[8 * s + 1]); a.y = cvtpk(p1[8 * s + 2], p1[8 * s + 3]); a.z = cvtpk(p1[8 * s + 4], p1[8 * s + 5]); a.w = cvtpk(p1[8 * s + 6], p1[8 * s + 7]); pa[s] = __builtin_bit_cast(bf16x8, a); }
#pragma unroll
    for (int ks = 2; ks < 4; ++ks)
#pragma unroll
        for (int d0 = 0; d0 < 2; ++d0) {
            const bf16x8 v = (bf16x8){vf.lo[ks][d0][0], vf.lo[ks][d0][1], vf.lo[ks][d0][2], vf.lo[ks][d0][3], vf.hh[ks][d0][0], vf.hh[ks][d0][1], vf.hh[ks][d0][2], vf.hh[ks][d0][3]};
            o[d0] = __builtin_amdgcn_mfma_f32_32x32x16_bf16(pa[ks - 2], v, o[d0], 0, 0, 0);
        }
    return s0 + s1;
}
__device__ __forceinline__ void row_to_regs(LAS float* wsf, float v, float (&f)[16], int r32, int hi) {
    if (hi == 0) wsf[r32] = v;
#pragma unroll
    for (int u = 0; u < 4; ++u) { const f32x4 t = *(const LAS f32x4*)(wsf + 8 * u + 4 * hi); f[4 * u] = t[0]; f[4 * u + 1] = t[1]; f[4 * u + 2] = t[2]; f[4 * u + 3] = t[3]; }
}
struct SmState { float m, l; bool have; };
__device__ __forceinline__ void sm_init(SmState& st) { st.m = 0.f; st.l = 0.f; st.have = false; }
template <bool HASO>
__device__ __forceinline__ void sm_rebase(SmState& st, f32x16& p0, f32x16& p1, f32x16 (&o)[2], LAS float* wsf, int r32, int hi) {
    const float mx = rowmax32(p0, p1);
    const bool fin = mx > NEG_INF;
    const bool trig = st.have ? (mx > THR) : fin;
    if (__any(trig)) {
        const float dl = st.have ? fmaxf(mx, 0.f) : (fin ? mx : 0.f);
        const float alpha = st.have ? __builtin_amdgcn_exp2f(-dl) : 1.0f;
        st.m += dl; st.l *= alpha; st.have = st.have || fin;
#pragma unroll
        for (int i = 0; i < 16; ++i) { p0[i] = fsub_s(p0[i], dl); p1[i] = fsub_s(p1[i], dl); }
        if (HASO) { float f[16]; row_to_regs(wsf, alpha, f, r32, hi);
#pragma unroll
            for (int i = 0; i < 16; ++i) { o[0][i] = fmul_s(o[0][i], f[i]); o[1][i] = fmul_s(o[1][i], f[i]); } }
    }
}
__device__ __forceinline__ float exp_sum(f32x16& p0, f32x16& p1) {
#ifdef PK_SUM
    float s0 = 0.f, s1 = 0.f;
#pragma unroll
    for (int i = 0; i < 16; ++i) { p0[i] = __builtin_amdgcn_exp2f(p0[i]); p1[i] = __builtin_amdgcn_exp2f(p1[i]); s0 += p0[i]; s1 += p1[i]; }
    return s0 + s1;
#else
    float s0, s1, s2, s3;
#pragma unroll
    for (int i = 0; i < 16; ++i) { p0[i] = __builtin_amdgcn_exp2f(p0[i]); p1[i] = __builtin_amdgcn_exp2f(p1[i]); }
    s0 = fadd_s(p0[0], p0[1]); s1 = fadd_s(p0[2], p0[3]); s2 = fadd_s(p1[0], p1[1]); s3 = fadd_s(p1[2], p1[3]);
#pragma unroll
    for (int i = 4; i < 16; i += 2) { if (i & 2) { s1 = fadd_s(s1, fadd_s(p0[i], p0[i + 1])); s3 = fadd_s(s3, fadd_s(p1[i], p1[i + 1])); } else { s0 = fadd_s(s0, fadd_s(p0[i], p0[i + 1])); s2 = fadd_s(s2, fadd_s(p1[i], p1[i + 1])); } }
    return fadd_s(fadd_s(s0, s1), fadd_s(s2, s3));
#endif
}

__device__ __forceinline__ void build_btab(Frame& F, int g) {
    LAS float* btab = (LAS float*)(F.lds + L_BTAB); const float* rb = F.in[11];
    __syncthreads();
    for (int i = F.tid; i < 4 * NBT; i += 512) { const int rr = i / NBT, d = BT0 - (i - rr * NBT); btab[i] = rb[t5_bucket(d > 0 ? d : 0) * 8 + 4 * g + rr] * LOG2E; }
    __syncthreads();
}
__device__ __forceinline__ void attn_item(Frame& F, int b, int g, int qb) {
    const int tid = F.tid, lane = F.lane, w = F.wave, r32 = lane & 31, hi = lane >> 5, qi = r32 >> 2, r = r32 & 3;
    const int t0 = qb * 64, tl = 8 * w + qi, tpos = t0 + tl;
    ATP(F, 0);
    LAS unsigned char* lds = F.lds;
    const unsigned lds0 = (unsigned)(uintptr_t)lds;
    LAS float* imp = (LAS float*)(lds + L_IMP);
    LAS float* btab = (LAS float*)(lds + L_BTAB);
    LAS float* wsf = (LAS float*)(lds + L_WSF) + w * 64;
    LAS unsigned* selm = (LAS unsigned*)(lds + L_SELM);
    LAS unsigned* uni = (LAS unsigned*)(lds + L_UNI);
    const bf16* KVb = (const bf16*)(F.ws + WS_KV);
    const size_t bgoff = (size_t)(b * 2 + g) * 8192 * 64;
    const bf16* ksb = KVb + 2 * KV_TENS + bgoff; const bf16* vsb = KVb + 3 * KV_TENS + bgoff;
    const bf16* kwb = KVb + 4 * KV_TENS + bgoff; const bf16* vwb = KVb + 5 * KV_TENS + bgoff;
    const bf16* kcb = (const bf16*)(F.ws + WS_KC) + (size_t)(b * 2 + g) * 512 * 64;
    const bf16* vcb = (const bf16*)(F.ws + WS_VC) + (size_t)(b * 2 + g) * 512 * 64;
    for (int i = lane; i < 8 * IMP_STR; i += 64) imp[8 * w * IMP_STR + i] = 0.f;
    if (tid < 64) uni[tid] = 0u;
    bf16x8 qf[4];
    { const bf16* Qp = (const bf16*)(F.ws + WS_Q) + ((size_t)(b * 8192 + tpos) * 512 + (4 * g + r) * 64 + 8 * hi);
#pragma unroll
      for (int s = 0; s < 4; ++s) qf[s] = *(const GAS bf16x8*)(Qp + 16 * s); }
    float gate[3];
    { const float* gp = (const float*)(F.ws + WS_G) + (size_t)(b * 8192 + tpos) * 32 + (4 * g + r) * 3; gate[0] = gp[0]; gate[1] = gp[1]; gate[2] = gp[2]; }
    const float bfar = F.in[11][31 * 8 + 4 * g + r] * LOG2E;
    const LAS float* bt = btab + r * NBT;
    LAS float* oaccp = (LAS float*)(lds + L_OACC) + w * 2048 + lane;
    asm volatile("s_waitcnt vmcnt(0)" ::: "memory");
    __syncthreads();

    ATP(F, 1);
    const int nct = (4 * qb + 3 + 63) >> 6;
    const int dcb = tpos - 31;
    const int ncfar = (t0 - 1829) >= 0 ? min(nct, (t0 - 1829) / 1024 + 1) : 0;
    SmState sc; sm_init(sc);
    f32x16 oc[2]; oc[0] = f32x16{}; oc[1] = f32x16{};
#define CMP_DMA(c, slot, hasv) tile_dma(kcb + (size_t)(c) * 4096, vcb + (size_t)(c) * 4096, hasv, lds0 + L_RING + (slot) * SLOT, w, lane)
#define CMP_A(c, slot) do { if ((c) < nct) { const LAS unsigned char* tb_ = lds + L_RING + (slot) * SLOT; \
        f32x16 p0, p1; qk_tile(tb_, qf, (c) < ncfar ? bfar - sc.m : -sc.m, p0, p1, r32, hi); \
        if ((c) >= ncfar) bias_mask<16>(p0, p1, bt, dcb - 1024 * (c), hi); \
        sm_rebase<false>(sc, p0, p1, oc, wsf, r32, hi); \
        sc.l += exp_sum(p0, p1); } } while (0)
    CMP_DMA(0, 0, false); if (nct > 1) CMP_DMA(1, 1, false);
    ATT_WAIT_BAR(0);
    for (int c = 0, pb = 0; c < nct; c += 2, pb ^= 1) {
        const int cs = pb ? 2 : 0, ns = pb ? 0 : 2;
        if (c + 2 < nct) CMP_DMA(c + 2, ns, false); if (c + 3 < nct) CMP_DMA(c + 3, ns + 1, false);
        CMP_A(c, cs); CMP_A(c + 1, cs + 1);
        ATT_WAIT_BAR(0);
    }
#undef CMP_A
    ATP(F, 2);
    const float lc = xhalf_sum(sc.l);
    const float lgl = lc > 0.f ? __builtin_amdgcn_logf(lc) : 0.f;
#define CMP_B(c, slot) do { if ((c) < nct) { const LAS unsigned char* tb_ = lds + L_RING + (slot) * SLOT; \
        VFrags vf; v_read(vf, tb_, lane, hi); \
        f32x16 p0, p1; qk_tile(tb_, qf, ((c) < ncfar ? bfar - sc.m : -sc.m) - lgl, p0, p1, r32, hi); \
        if ((c) >= ncfar) bias_mask<16>(p0, p1, bt, dcb - 1024 * (c), hi); \
        _Pragma("unroll") for (int i = 0; i < 16; ++i) { p0[i] = __builtin_amdgcn_exp2f(p0[i]); p1[i] = __builtin_amdgcn_exp2f(p1[i]); } \
          \
        _Pragma("unroll") for (int a = 0; a < 2; ++a) _Pragma("unroll") for (int u = 0; u < 4; ++u) { \
            const float x0 = a ? p1[4 * u] : p0[4 * u], x1 = a ? p1[4 * u + 1] : p0[4 * u + 1], x2 = a ? p1[4 * u + 2] : p0[4 * u + 2], x3 = a ? p1[4 * u + 3] : p0[4 * u + 3]; \
            const float h3 = fmul_s(0.5f, x3); const float mainv = quad_sum(fadd_s(fadd_s(x0, x1), fadd_s(x2, h3))), spill = quad_sum(h3); \
            const int j = 16 * (c) + 8 * a + 2 * u + hi; \
            if (r == 0) { (void)__hip_atomic_fetch_add(&imp[(8 * w + qi) * IMP_STR + j], mainv, __ATOMIC_RELAXED, __HIP_MEMORY_SCOPE_WORKGROUP); if (j + 1 < 128) (void)__hip_atomic_fetch_add(&imp[(8 * w + qi) * IMP_STR + j + 1], spill, __ATOMIC_RELAXED, __HIP_MEMORY_SCOPE_WORKGROUP); } } \
        pv_tile_pre(vf, p0, p1, oc); } } while (0)
    CMP_DMA(0, 0, true); if (nct > 1) CMP_DMA(1, 1, true);
    ATT_WAIT_BAR(0);
    for (int c = 0, pb = 0; c < nct; c += 2, pb ^= 1) {
        const int cs = pb ? 2 : 0, ns = pb ? 0 : 2;
        if (c + 2 < nct) CMP_DMA(c + 2, ns, true); if (c + 3 < nct) CMP_DMA(c + 3, ns + 1, true);
        CMP_B(c, cs); CMP_B(c + 1, cs + 1);
        ATT_WAIT_BAR(0);
    }
#undef CMP_B
#undef CMP_DMA
    ATP(F, 3);
    for (int pass = 0; pass < 2; ++pass) {
        const int q = 8 * w + 4 * pass + (lane >> 4), t = lane & 15;
        const f32x4 va = *(const LAS f32x4*)(imp + q * IMP_STR + 8 * t), vb = *(const LAS f32x4*)(imp + q * IMP_STR + 8 * t + 4);
        unsigned key[8];
#pragma unroll
        for (int e = 0; e < 8; ++e) { const int j = 8 * t + e; const float v = e < 4 ? va[e] : vb[e - 4];
            const bool val = j <= qb, fo = (j == 0) || (j == qb) || (j == qb - 1);
            key[e] = !val ? 0u : (fo ? 0x7f000000u : __float_as_uint(v) + 1u); }
        unsigned Tt = 0u; bool fin = false;
        for (int bit = 30; bit >= 0; --bit) {
            const unsigned cand = Tt | (1u << bit); int cnt = 0;
#pragma unroll
            for (int e = 0; e < 8; ++e) cnt += (key[e] >= cand) ? 1 : 0;
            cnt += __builtin_amdgcn_update_dpp(0, cnt, 0x128, 0xf, 0xf, true);
            cnt += __builtin_amdgcn_update_dpp(0, cnt, 0x124, 0xf, 0xf, true);
            cnt += __builtin_amdgcn_update_dpp(0, cnt, 0x122, 0xf, 0xf, true);
            cnt += __builtin_amdgcn_update_dpp(0, cnt, 0x121, 0xf, 0xf, true);
            if (!fin && cnt >= 16) { Tt = cand; fin = (cnt == 16); }
            if (__all(fin)) break;
        }
        int ngt = 0, neq = 0;
#pragma unroll
        for (int e = 0; e < 8; ++e) { ngt += (key[e] > Tt) ? 1 : 0; neq += (key[e] == Tt) ? 1 : 0; }
        ngt += __builtin_amdgcn_update_dpp(0, ngt, 0x128, 0xf, 0xf, true); ngt += __builtin_amdgcn_update_dpp(0, ngt, 0x124, 0xf, 0xf, true);
        ngt += __builtin_amdgcn_update_dpp(0, ngt, 0x122, 0xf, 0xf, true); ngt += __builtin_amdgcn_update_dpp(0, ngt, 0x121, 0xf, 0xf, true);
        const int need = 16 - ngt;
        int inc = neq;
        inc += __builtin_amdgcn_update_dpp(0, inc, 0x111, 0xf, 0xf, true);
        inc += __builtin_amdgcn_update_dpp(0, inc, 0x112, 0xf, 0xf, true);
        inc += __builtin_amdgcn_update_dpp(0, inc, 0x114, 0xf, 0xf, true);
        inc += __builtin_amdgcn_update_dpp(0, inc, 0x118, 0xf, 0xf, true);
        int pre = inc - neq; unsigned bits = 0u;
#pragma unroll
        for (int e = 0; e < 8; ++e) { const bool eq = key[e] == Tt; const bool sel = (key[e] != 0u) && ((key[e] > Tt) || (eq && pre < need)); pre += eq ? 1 : 0; bits |= sel ? (1u << e) : 0u; }
        unsigned word = bits << ((t & 3) * 8);
        word |= (unsigned)__builtin_amdgcn_update_dpp(0, (int)word, 0xB1, 0xf, 0xf, true);
        word |= (unsigned)__builtin_amdgcn_update_dpp(0, (int)word, 0x4E, 0xf, 0xf, true);
        if ((t & 3) == 0) { selm[q * 4 + (t >> 2)] = word; (void)__hip_atomic_fetch_or(&uni[w * 4 + (t >> 2)], word, __ATOMIC_RELAXED, __HIP_MEMORY_SCOPE_WORKGROUP); (void)__hip_atomic_fetch_or(&uni[32 + (t >> 2)], word, __ATOMIC_RELAXED, __HIP_MEMORY_SCOPE_WORKGROUP); }
    }
    __syncthreads();
    { float f[16]; row_to_regs(wsf, gate[0], f, r32, hi);
#pragma unroll
      for (int i = 0; i < 16; ++i) { oaccp[i * 64] = oc[0][i] * f[i]; oaccp[(16 + i) * 64] = oc[1][i] * f[i]; } }
    unsigned mym[4], bu[4], wuv[4];
#pragma unroll
    for (int k = 0; k < 4; ++k) { mym[k] = selm[(8 * w + qi) * 4 + k]; bu[k] = __builtin_amdgcn_readfirstlane(uni[32 + k]); wuv[k] = __builtin_amdgcn_readfirstlane(uni[w * 4 + k]); }
    ATP(F, 4);
#ifndef REP_SEL
#define REP_SEL 1
#endif
#ifndef REP_WIN
#define REP_WIN 1
#endif
#ifndef REP_CMP
#define REP_CMP 1
#endif
    for (int rep_ = 0; rep_ < REP_SEL; ++rep_) {
        f32x16 o[2]; o[0] = f32x16{}; o[1] = f32x16{}; SmState ss; sm_init(ss);
#define NEXT_SEL(from, dst) do { const int f_ = (from); int r_ = -1; for (int j_ = f_; j_ <= qb; ++j_) if ((bu[j_ >> 5] >> (j_ & 31)) & 1u) { r_ = j_; break; } dst = r_; } while (0)
#define SEL_DMA(j, slot) tile_dma(ksb + (size_t)(j) * 4096, vsb + (size_t)(j) * 4096, true, lds0 + L_RING + (slot) * SLOT, w, lane)
#define SEL_DO(j, slot) do { if ((j) >= 0 && (((wuv[(j) >> 5] >> ((j) & 31)) & 1u) != 0u)) { \
            const bool mine = (mym[(j) >> 5] >> ((j) & 31)) & 1u; const bool nearj = qb - (j) < 14; const LAS unsigned char* tb_ = lds + L_RING + (slot) * SLOT; \
            VFrags vf; v_read(vf, tb_, lane, hi); \
            f32x16 p0, p1; qk_tile(tb_, qf, mine ? (nearj ? -ss.m - bfar : -ss.m) : NEG_INF, p0, p1, r32, hi); \
            if (nearj) bias_near_mode(p0, p1, bt + (BT0 - (tpos - 64 * (j))) + 4 * hi, tpos - 64 * (j), hi, (j) == qb ? 1 : 0); \
            sm_rebase<true>(ss, p0, p1, o, wsf, r32, hi); \
            ss.l += exp_sum(p0, p1); \
            pv_tile_pre(vf, p0, p1, o); } } while (0)
        int a0, a1 = -1, nx = -1;
        NEXT_SEL(0, a0); if (a0 >= 0) NEXT_SEL(a0 + 1, a1); if (a1 >= 0) NEXT_SEL(a1 + 1, nx);
        if (a0 >= 0) SEL_DMA(a0, 0); if (a1 >= 0) SEL_DMA(a1, 1);
        ATT_WAIT_BAR(0);
        int pb = 0;
        while (a0 >= 0) {
            int b0 = nx, b1 = -1; if (b0 >= 0) NEXT_SEL(b0 + 1, b1); nx = -1; if (b1 >= 0) NEXT_SEL(b1 + 1, nx);
            const int cs = pb ? 2 : 0, ns = pb ? 0 : 2;
            if (b0 >= 0) SEL_DMA(b0, ns); if (b1 >= 0) SEL_DMA(b1, ns + 1);
            SEL_DO(a0, cs); SEL_DO(a1, cs + 1);
            ATT_WAIT_BAR(0);
            a0 = b0; a1 = b1; pb ^= 1;
        }
#undef SEL_DMA
#undef SEL_DO
#undef NEXT_SEL
        const float ls = xhalf_sum(ss.l);
        float f[16]; row_to_regs(wsf, ls > 0.f ? gate[1] / (ls * REP_SEL) : 0.f, f, r32, hi);
#pragma unroll
        for (int i = 0; i < 16; ++i) { oaccp[i * 64] += o[0][i] * f[i]; oaccp[(16 + i) * 64] += o[1][i] * f[i]; }
    }
    ATP(F, 5);
    {
        f32x16 o[2]; o[0] = f32x16{}; o[1] = f32x16{}; SmState sw; sm_init(sw);
        const int jf = qb >= 8 ? qb - 8 : 0;
#define WIN_DMA(j, slot) tile_dma(kwb + (size_t)(j) * 4096, vwb + (size_t)(j) * 4096, true, lds0 + L_RING + (slot) * SLOT, w, lane)
#define WIN_DO(j, slot) do { if ((j) <= qb) { const LAS unsigned char* tb_ = lds + L_RING + (slot) * SLOT; \
            VFrags vf; v_read(vf, tb_, lane, hi); \
            f32x16 p0, p1; qk_tile(tb_, qf, -sw.m, p0, p1, r32, hi); \
            bias_near_mode(p0, p1, bt + (BT0 - (tpos - 64 * (j))) + 4 * hi, tpos - 64 * (j), hi, (j) == qb ? 1 : ((j) == qb - 8 ? 2 : 0)); \
            sm_rebase<true>(sw, p0, p1, o, wsf, r32, hi); \
            sw.l += exp_sum(p0, p1); \
            pv_tile_pre(vf, p0, p1, o); } } while (0)
        WIN_DMA(jf, 0); if (jf + 1 <= qb) WIN_DMA(jf + 1, 1);
        ATT_WAIT_BAR(0);
        for (int j = jf, pb = 0; j <= qb; j += 2, pb ^= 1) {
            const int cs = pb ? 2 : 0, ns = pb ? 0 : 2;
            if (j + 2 <= qb) WIN_DMA(j + 2, ns); if (j + 3 <= qb) WIN_DMA(j + 3, ns + 1);
            WIN_DO(j, cs); WIN_DO(j + 1, cs + 1);
            ATT_WAIT_BAR(0);
        }
#undef WIN_DMA
#undef WIN_DO
        const float lw = xhalf_sum(sw.l);
        float f[16]; row_to_regs(wsf, lw > 0.f ? gate[2] / lw : 0.f, f, r32, hi);
#pragma unroll
        for (int i = 0; i < 16; ++i) { o[0][i] = oaccp[i * 64] + o[0][i] * f[i]; o[1][i] = oaccp[(16 + i) * 64] + o[1][i] * f[i]; }
        asm volatile("" ::: "memory");
        LAS unsigned short* stg = (LAS unsigned short*)(lds + L_OACC + w * 8192);
#pragma unroll
        for (int i = 0; i < 16; ++i) { const int orow = (i & 3) + 8 * (i >> 2) + 4 * hi;
            stg[orow * 64 + r32] = (unsigned short)f2bf(o[0][i]); stg[orow * 64 + 32 + r32] = (unsigned short)f2bf(o[1][i]); }
        LDS_WAIT();
        bf16* MIX = (bf16*)(F.ws + WS_MIX);
#pragma unroll
        for (int i = 0; i < 4; ++i) { const int row = i * 8 + (lane >> 3), ch = lane & 7; const v4u v = *(const LAS v4u*)(stg + row * 64 + ch * 8);
            *(GAS v4u*)(MIX + (size_t)(b * 8192 + t0 + 8 * w + (row >> 2)) * 1024 + (4 * g + (row & 3)) * 64 + ch * 8) = v; }
    }
    __syncthreads();
    ATP(F, 6);
}
}

__device__ __forceinline__ void p4_phase(Frame& F) {
    ATP(F, 20);
    {
        const bf16* Z = (const bf16*)(F.ws + WS_Z); const bf16* BG = (const bf16*)(F.ws + WS_BG); bf16* MIX = (bf16*)(F.ws + WS_MIX);
        const float* cw = F.in[12];
        const int ch = F.tid & 63, rsub = F.tid >> 6;
        f32x4 w0a = *(const f32x4*)(cw + 8 * ch), w0b = *(const f32x4*)(cw + 8 * ch + 4), w1a = *(const f32x4*)(cw + 512 + 8 * ch), w1b = *(const f32x4*)(cw + 512 + 8 * ch + 4), w2a = *(const f32x4*)(cw + 1024 + 8 * ch), w2b = *(const f32x4*)(cw + 1024 + 8 * ch + 4);
        for (int rb = blockIdx.x; rb < M / 8; rb += F.G) {
            const int row = 8 * rb + rsub, t = row & 8191;
            const v4u z2 = *(const GAS v4u*)(Z + (size_t)row * 512 + 8 * ch);
            v4u z1 = (v4u){0u, 0u, 0u, 0u}, z0 = (v4u){0u, 0u, 0u, 0u};
            if (t >= 1) z1 = *(const GAS v4u*)(Z + (size_t)(row - 1) * 512 + 8 * ch);
            if (t >= 2) z0 = *(const GAS v4u*)(Z + (size_t)(row - 2) * 512 + 8 * ch);
            const v4u bg = *(const GAS v4u*)(BG + (size_t)row * 512 + 8 * ch);
            float o[8];
#define CV(k, comp, sh, wa, wi) o[k] = bf2f((unsigned short)((bg.comp >> sh) & 0xffff)) * (w0##wa[wi] * bf2f((unsigned short)((z0.comp >> sh) & 0xffff)) + w1##wa[wi] * bf2f((unsigned short)((z1.comp >> sh) & 0xffff)) + w2##wa[wi] * bf2f((unsigned short)((z2.comp >> sh) & 0xffff)))
            CV(0, x, 0, a, 0); CV(1, x, 16, a, 1); CV(2, y, 0, a, 2); CV(3, y, 16, a, 3); CV(4, z, 0, b, 0); CV(5, z, 16, b, 1); CV(6, w, 0, b, 2); CV(7, w, 16, b, 3);
#undef CV
            v4u ov; ov.x = pk2(o[0], o[1]); ov.y = pk2(o[2], o[3]); ov.z = pk2(o[4], o[5]); ov.w = pk2(o[6], o[7]);
            *(GAS v4u*)(MIX + (size_t)row * 1024 + 512 + 8 * ch) = ov;
        }
    }
    asm volatile("s_waitcnt vmcnt(0)" ::: "memory");
    ATP(F, 21);
#ifndef NO_YOUNG_PRIO
    if (F.wave >= 4) __builtin_amdgcn_s_setprio(1);
#endif
    if (F.G == 256) {
        att::build_btab(F, (int)(blockIdx.x & 1));
        static constexpr unsigned char QBTAB[128] = {118,92,63,0,113,98,58,1,114,91,60,2,125,81,57,4,112,84,64,3,126,69,61,6,127,70,62,5,122,74,56,7,115,67,55,14,124,66,54,12,121,73,53,9,123,68,51,13,120,76,52,8,119,75,50,11,108,79,44,18,116,78,43,16,107,71,48,21,110,77,46,17,111,72,47,19,109,82,45,15,117,65,49,20,103,101,42,10,97,87,41,22,104,83,37,24,102,80,36,28,106,59,40,38,100,86,35,26,105,96,27,25,99,85,39,23,93,90,34,29,94,89,33,30,95,88,32,31};
        const int bg = blockIdx.x & 7, s_ = blockIdx.x >> 3;
#pragma unroll 1
        for (int i = 0; i < 4; ++i) att::attn_item(F, bg >> 1, bg & 1, (int)QBTAB[4 * s_ + i]);
    } else {
        for (int rd = 0; rd * F.G < 1024; ++rd) {
            const int pos = (rd & 1) ? (F.G - 1 - (int)blockIdx.x) : (int)blockIdx.x;
            const int k = rd * F.G + pos; if (k >= 1024) continue;
            att::build_btab(F, k & 1);
            att::attn_item(F, (k & 7) >> 1, k & 1, 127 - (k >> 3));
        }
    }
#ifndef NO_YOUNG_PRIO
    if (F.wave >= 4) __builtin_amdgcn_s_setprio(0);
#endif
}

struct Args { const float* in[20]; float* out; unsigned char* ws; int ph_lo, ph_hi; };
__global__ void __launch_bounds__(NWAVES * 64, 2) mk_fwd(Args args) {
    extern __shared__ __attribute__((aligned(16))) unsigned char lds[];
    Frame F;
    F.lds = (LAS unsigned char*)lds;
    F.MISC = (volatile LAS unsigned*)(F.lds + MISC_OFF);
    F.tid = threadIdx.x; F.lane = F.tid & 63; F.wave = __builtin_amdgcn_readfirstlane(F.tid >> 6);
    F.G = gridDim.x; { const int bx = blockIdx.x; F.vcu = (F.G % 8 == 0) ? (bx % 8) * (F.G / 8) + bx / 8 : bx; }
    F.tp_t0 = 0; F.tp_acc = 0; F.ws = args.ws; F.out = args.out; F.ctl = (gu32*)(args.ws + WS_CTL);
#pragma unroll
    for (int i = 0; i < 20; ++i) F.in[i] = args.in[i];
    for (int u = F.tid; u < (LDS_BYTES - LDSCTL_OFF) / 4; u += NWAVES * 64) ((LAS unsigned*)(F.lds + LDSCTL_OFF))[u] = 0u;
    __syncthreads();
    const int lo = args.ph_lo, hi = args.ph_hi;
    const bool one = (hi - lo) > 1;
    XcdBarrier bar; bar.bar = (unsigned*)(F.ctl + CW_BAR); bar.x = 0; bar.st = nullptr;
    if (one) bar = xcd_barrier_post((unsigned*)(F.ctl + CW_BAR), F.MISC + 8);
#ifdef ONLY_PHASE
#define IN(k) ((k) == ONLY_PHASE && lo <= (k) && (k) < hi)
#else
#define IN(k) (lo <= (k) && (k) < hi)
#endif
#ifndef REP_MASK
#define REP_MASK 0
#endif
#define REPS(k) for (int rep_ = 0; rep_ < 1 + ((REP_MASK >> (k)) & 1); ++rep_)
#define SEAM(k) do { if (IN(k) && IN((k) + 1)) xcd_barrier(bar); } while (0)
    unsigned char* ws = args.ws;
#ifdef PROBE_PHASE
    unsigned long long tp0_ = 0, tp1_ = 0;
#define TPS(k) do { if ((k) == PROBE_PHASE) tp0_ = __builtin_amdgcn_s_memrealtime(); if ((k) == PROBE_END) tp1_ = __builtin_amdgcn_s_memrealtime(); } while (0)
#else
#define TPS(k) do {} while (0)
#endif
#ifdef UBENCH
    if (blockIdx.x == 0 && IN(0)) {
        __syncthreads();
        const unsigned long long t0 = __builtin_amdgcn_s_memrealtime();
        f32x16 a0 = {}, a1 = {}; bf16x8 x = (bf16x8){1, 2, 3, 4, 5, 6, 7, 8}; asm volatile("" : "+v"(x));
        float v0 = (float)F.tid, v1 = v0 + 1.f, v2 = v0 + 2.f, v3 = v0 + 3.f, v4 = v0 * 0.5f, v5 = v0 * 0.25f, v6 = 1.f, v7 = 2.f;
        if (UBENCH == 4) { if (F.wave < 4) { for (int i = 0; i < 2048; ++i) { a0 = __builtin_amdgcn_mfma_f32_32x32x16_bf16(x, x, a0, 0, 0, 0);
                v0 = v0 * 1.0001f + 0.5f; v1 = v1 * 1.0001f + 0.5f; v2 = v2 * 1.0001f + 0.5f; v3 = v3 * 1.0001f + 0.5f; v4 = v4 * 1.0001f + 0.5f; v5 = v5 * 1.0001f + 0.5f; v6 = v6 * 1.0001f + 0.5f; v7 = v7 * 1.0001f + 0.5f;
                __builtin_amdgcn_sched_barrier(0);
                a1 = __builtin_amdgcn_mfma_f32_32x32x16_bf16(x, x, a1, 0, 0, 0);
                v0 = v0 * 1.0001f + 0.5f; v1 = v1 * 1.0001f + 0.5f; v2 = v2 * 1.0001f + 0.5f; v3 = v3 * 1.0001f + 0.5f; v4 = v4 * 1.0001f + 0.5f; v5 = v5 * 1.0001f + 0.5f; v6 = v6 * 1.0001f + 0.5f; v7 = v7 * 1.0001f + 0.5f;
                __builtin_amdgcn_sched_barrier(0); } } }
        else if (F.wave < 4) { if (UBENCH & 1) { for (int i = 0; i < 2048; ++i) { a0 = __builtin_amdgcn_mfma_f32_32x32x16_bf16(x, x, a0, 0, 0, 0); a1 = __builtin_amdgcn_mfma_f32_32x32x16_bf16(x, x, a1, 0, 0, 0); } } }
        else { if (UBENCH & 2) { for (int i = 0; i < 4096; ++i) { v0 = v0 * 1.0001f + 0.5f; v1 = v1 * 1.0001f + 0.5f; v2 = v2 * 1.0001f + 0.5f; v3 = v3 * 1.0001f + 0.5f; v4 = v4 * 1.0001f + 0.5f; v5 = v5 * 1.0001f + 0.5f; v6 = v6 * 1.0001f + 0.5f; v7 = v7 * 1.0001f + 0.5f; } } }
        asm volatile("" :: "v"(a0), "v"(a1), "v"(v0), "v"(v1), "v"(v2), "v"(v3), "v"(v4), "v"(v5), "v"(v6), "v"(v7));
        __syncthreads();
        const unsigned long long t1 = __builtin_amdgcn_s_memrealtime();
        F.tp_acc = t1 - t0;
    }
#endif
    TPS(0);
    if (IN(0)) { REPS(0) p0_phase(F); ATP(F, 62); SEAM(0); ATP(F, 63); }
    TPS(1);
    if (IN(1)) { REPS(1) p1_phase(F); SEAM(1); }
#ifdef XTRA_BAR
    for (int xb_ = 0; xb_ < XTRA_BAR; ++xb_) xcd_barrier(bar);
#endif
    TPS(2);
    if (IN(2)) {
        pg8::Gemm g{(const pg8::bf16_t*)(ws + WS_H), (const pg8::bf16_t*)(ws + WS_WIN), M, NIN, D}; pg8::StaticOrder S; S.init(M, NIN, F.G, (int)blockIdx.x);
        pg8::EpiInProj E{(pg8::bf16_t*)(ws + WS_Q), (pg8::bf16_t*)(ws + WS_KV), (pg8::bf16_t*)(ws + WS_Z), (pg8::bf16_t*)(ws + WS_BG), (float*)(ws + WS_G), F.in[3], F.in[4]};
        pg8::gemm_phase<pg8::EpiInProj, pg8::StaticOrder, true, true>(F.lds, g, S, E);
#ifdef DUP_P2
        pg8::gemm_phase<pg8::EpiInProj, pg8::StaticOrder, true, true>(F.lds, g, S, E);
#endif
        SEAM(2);
    }
    TPS(3);
    if (IN(3)) { REPS(3) p3_phase(F); SEAM(3); }
    TPS(4);
    if (IN(4)) { REPS(4) p4_phase(F); ATP(F, 50); SEAM(4); ATP(F, 51); }
    TPS(5);
    if (IN(5)) {
        pg8::Gemm g{(const pg8::bf16_t*)(ws + WS_MIX), (const pg8::bf16_t*)(ws + WS_WOUT), M, D, D}; pg8::StaticOrder S; S.init(M, D, F.G, (int)blockIdx.x);
        pg8::EpiOutProj E{F.in[0], (pg8::bf16_t*)(ws + WS_X1B), (pg8::bf16_t*)(ws + WS_A2), (float*)(ws + WS_RSS), (const float*)(ws + WS_MOD), F.in[15]};
        REPS(5) pg8::gemm_phase<pg8::EpiOutProj, pg8::StaticOrder, true, true>(F.lds, g, S, E);
        SEAM(5);
    }
    TPS(6);
    if (IN(6)) {
        pg8::Gemm g{(const pg8::bf16_t*)(ws + WS_A2), (const pg8::bf16_t*)(ws + WS_W1), M, FF, D}; pg8::StaticOrder S; S.init(M, FF, F.G, (int)blockIdx.x);
        pg8::EpiFF1 E{(pg8::bf16_t*)(ws + WS_HID), (const float*)(ws + WS_RSS), (const float*)(ws + WS_BFF1)};
        REPS(6) pg8::gemm_phase<pg8::EpiFF1, pg8::StaticOrder, true, true>(F.lds, g, S, E);
        SEAM(6);
    }
    TPS(7);
    if (IN(7)) {
        pg8::Gemm g{(const pg8::bf16_t*)(ws + WS_HID), (const pg8::bf16_t*)(ws + WS_W2), M, D, FF}; pg8::StaticOrder S; S.init(M, D, F.G, (int)blockIdx.x);
#ifdef DUP_P7
        { pg8::EpiFF2 E0{(const pg8::bf16_t*)(ws + WS_X1B), (const float*)(ws + WS_MOD), (float*)(ws + (size_t)100 * MiB)};
          pg8::gemm_phase<pg8::EpiFF2, pg8::StaticOrder, true, true>(F.lds, g, S, E0); }
#endif
        pg8::EpiFF2 E{(const pg8::bf16_t*)(ws + WS_X1B), (const float*)(ws + WS_MOD), F.out};
        pg8::gemm_phase<pg8::EpiFF2, pg8::StaticOrder, true, true>(F.lds, g, S, E);
    }
    TPS(8);
#ifndef PROBE_BLK
#define PROBE_BLK 0
#endif
#if defined(ATP_A) || defined(UBENCH)
#ifndef ATP_MULT
#define ATP_MULT 8
#endif
    if (blockIdx.x == PROBE_BLK && F.tid == 0) { const unsigned long long until = __builtin_amdgcn_s_memrealtime() + (unsigned long long)ATP_MULT * F.tp_acc;
        while (__builtin_amdgcn_s_memrealtime() < until) __builtin_amdgcn_s_sleep(8); }
#endif
#ifdef PROBE_PHASE
    if (blockIdx.x == 0 && F.tid == 0) { const unsigned long long until = __builtin_amdgcn_s_memrealtime() + (unsigned long long)PROBE_MULT * (tp1_ - tp0_);
        while (__builtin_amdgcn_s_memrealtime() < until) __builtin_amdgcn_s_sleep(8); }
#endif
#undef IN
#undef SEAM
}

extern "C" void kernel_launch(void* const* d_in, const int* in_sizes, int n_in, void* d_out, int out_size, void* d_ws, size_t ws_size, hipStream_t stream) {
    static int grid = 0;
    if (grid == 0) {
        if (n_in != 20 || in_sizes[0] != M * D || out_size != M * D || ws_size < WS_END) { fprintf(stderr, "kernel_launch: unexpected problem shape (n_in %d, in0 %d, out %d, ws %zu)\n", n_in, n_in > 0 ? in_sizes[0] : -1, out_size, ws_size); grid = -1; return; }
        int dev = 0, cus = 0, per_cu = 0;
        if (hipGetDevice(&dev) != hipSuccess || hipDeviceGetAttribute(&cus, hipDeviceAttributeMultiprocessorCount, dev) != hipSuccess) { grid = -1; return; }
        if (hipFuncSetAttribute((const void*)mk_fwd, hipFuncAttributeMaxDynamicSharedMemorySize, LDS_BYTES) != hipSuccess) { fprintf(stderr, "kernel_launch: hipFuncSetAttribute failed\n"); grid = -1; return; }
        if (hipOccupancyMaxActiveBlocksPerMultiprocessor(&per_cu, (const void*)mk_fwd, NWAVES * 64, LDS_BYTES) != hipSuccess || per_cu < 1) { fprintf(stderr, "kernel_launch: occupancy query says %d blocks per CU\n", per_cu); (void)hipGetLastError(); per_cu = 1; }
        grid = cus * 1;
        if (per_cu < 1) grid = -1;
    }
    if (grid < 0) return;
    (void)hipMemsetAsync((char*)d_ws + WS_CTL, 0, CTL_ZERO_BYTES, stream);
    Args a{};
    for (int i = 0; i < 20; ++i) a.in[i] = (const float*)d_in[i];
    a.out = (float*)d_out; a.ws = (unsigned char*)d_ws;
    if (MK_N_LAUNCHES == 1) {
        a.ph_lo = 0; a.ph_hi = N_PHASES;
        void* kargs[] = {&a};
        hipError_t e = hipLaunchCooperativeKernel((const void*)mk_fwd, dim3(grid), dim3(NWAVES * 64), kargs, LDS_BYTES, stream);
        if (e != hipSuccess) fprintf(stderr, "kernel_launch: cooperative launch failed: %s (grid %d)\n", hipGetErrorString(e), grid);
    } else {
        for (int p = 0; p < N_PHASES; ++p) { a.ph_lo = p; a.ph_hi = p + 1; hipLaunchKernelGGL(mk_fwd, dim3(grid), dim3(NWAVES * 64), LDS_BYTES, stream, a); }
    }
}
```
